# Optimizing an MI355X kernel written in HIP

```python
import math
import jax, jax.numpy as jnp
from jax import lax
import numpy as np

D_MODEL = 1024
BATCH = 16
SEQ = 256
DEPTH = 4
DEC_BATCH = 2
DEC_SEQ = 2048
PAST_LEN = 256

GRID_W = 64
N_MIXERS = 4
D_FF = 2816
CONV_W = 3
EPS = 1e-6
ROPE_BASE = 10000.0
Q_BLOCK = 128
NEG = -1e30

NA_HEADS = 16
NA_HD = 64
NA_WIN_R = 8
NA_WIN_C = 16
NA_QBLK = NA_WIN_C
NA_KCOLS = 2 * NA_WIN_C

GLA_HEADS = 4
GLA_DK = D_MODEL // 2 // GLA_HEADS
GLA_DV = D_MODEL // GLA_HEADS
GLA_HK = GLA_HEADS * GLA_DK
GLA_HV = GLA_HEADS * GLA_DV
GLA_GATE_RANK = 16
GLA_GATE_NORM = 16.0
GLA_CHUNK = 64

DIFF_HEADS = 8
DIFF_HD = D_MODEL // DIFF_HEADS // 2
DIFF_LAYER = 2
DIFF_LAMBDA_INIT = 0.8 - 0.6 * math.exp(-0.3 * DIFF_LAYER)

MLA_HEADS = 16
MLA_Q_RANK = 384
MLA_KV_RANK = 256
MLA_NOPE = 64
MLA_ROPE = 32
MLA_V = 64
MLA_QK = MLA_NOPE + MLA_ROPE

kernel_name = 'hybrid_diffusion_trunk_step'


def rmsnorm(x, g):
    xf = x.astype(jnp.float32)
    y = xf * lax.rsqrt(jnp.mean(xf * xf, axis=-1, keepdims=True) + EPS)
    return (y * g.astype(jnp.float32)).astype(x.dtype)


def ada_mod(cvec, w, b):
    m = (jax.nn.silu(cvec) @ w + b)[..., None, :]
    return jnp.split(m, 6, axis=-1)


def modulate(h, shift, scale):
    return h * (1 + scale) + shift


def axial_rope_tables(n_tok, rdim):
    nf = rdim // 4
    freqs = ROPE_BASE ** (-jnp.arange(nf, dtype=jnp.float32) / nf)
    t = jnp.arange(n_tok)
    row = (t // GRID_W).astype(jnp.float32)
    col = (t % GRID_W).astype(jnp.float32)
    ang = jnp.stack([row[:, None] * freqs, col[:, None] * freqs], axis=1)
    return jnp.cos(ang), jnp.sin(ang)


def apply_rope(x, cos, sin):
    sh = x.shape
    xr = x.reshape(sh[:-1] + (2, 2, sh[-1] // 4)).astype(jnp.float32)
    x1, x2 = xr[..., 0, :], xr[..., 1, :]
    out = jnp.stack([x1 * cos - x2 * sin, x1 * sin + x2 * cos], axis=-2)
    return out.reshape(sh).astype(x.dtype)


def map_query_blocks(fn, q):
    b, h, n = q.shape[:3]
    qb = jnp.moveaxis(q.reshape((b, h, n // Q_BLOCK, Q_BLOCK) + q.shape[3:]), 2, 0)
    out = jnp.moveaxis(lax.map(fn, qb), 0, 2)
    return out.reshape(out.shape[:2] + (n,) + out.shape[4:])


def dense_attention(q, k, v, scale):
    def blk(qb):
        s = jnp.einsum('bhqd,bhkd->bhqk', qb, k).astype(jnp.float32) * scale
        p = jax.nn.softmax(s, axis=-1).astype(v.dtype)
        return jnp.einsum('bhqk,bhkd->bhqd', p, v)
    return map_query_blocks(blk, q)


def merge_heads(o, w_o):
    b, h, n, d = o.shape
    return jnp.transpose(o, (0, 2, 1, 3)).reshape(b, n, h * d) @ w_o


def conv_ffn(h, w_up, conv_w, conv_b, w_down):
    u = h @ w_up
    up = jnp.pad(u, ((0, 0), (1, 1), (0, 0)))
    u = up[:, :-2] * conv_w[0] + up[:, 1:-1] * conv_w[1] + up[:, 2:] * conv_w[2] + conv_b
    gate, val = jnp.split(u, 2, axis=-1)
    return (jax.nn.silu(gate) * val) @ w_down


def na_qkv(h, w_qkv, gq, gk):
    b, n, _ = h.shape
    qkv = jnp.transpose((h @ w_qkv).reshape(b, n, 3, NA_HEADS, NA_HD), (2, 0, 3, 1, 4))
    return rmsnorm(qkv[0], gq), rmsnorm(qkv[1], gk), qkv[2]


def na_latent(q, k, v, kc, vc, bias_table):
    b, h, n, d = q.shape
    rows = n // GRID_W
    wr = min(NA_WIN_R, rows)
    nb = GRID_W // NA_QBLK
    r = jnp.arange(rows)
    key_rows = jnp.clip(r - wr // 2, 0, rows - wr)[:, None] + jnp.arange(wr)
    c0 = jnp.arange(nb) * NA_QBLK
    key_cols = jnp.clip(c0 - NA_WIN_C // 2, 0, GRID_W - NA_KCOLS)[:, None] + jnp.arange(NA_KCOLS)
    q_cols = c0[:, None] + jnp.arange(NA_QBLK)
    win0 = jnp.clip(q_cols - NA_WIN_C // 2, 0, GRID_W - NA_WIN_C)[..., None]
    kcols_b = key_cols[:, None, :]
    valid = (kcols_b >= win0) & (kcols_b < win0 + NA_WIN_C)
    roff = key_rows - r[:, None] + NA_WIN_R - 1
    coff = jnp.clip(kcols_b - q_cols[..., None] + NA_WIN_C - 1, 0, 2 * NA_WIN_C - 2)
    bias = bias_table[:, roff[:, None, None, :, None], coff[None, :, :, None, :]].astype(jnp.float32)
    kr = key_rows[:, None, :, None]
    kcl = key_cols[None, :, None, :]
    kg = k.reshape(b, h, rows, GRID_W, d)[:, :, kr, kcl]
    vg = v.reshape(b, h, rows, GRID_W, d)[:, :, kr, kcl]
    qg = q.reshape(b, h, rows, nb, NA_QBLK, d)
    scale = d ** -0.5
    n_loc = wr * NA_KCOLS
    s_loc = jnp.einsum('bhrnqd,bhrnikd->bhrnqik', qg, kg).astype(jnp.float32) * scale + bias
    s_loc = jnp.where(valid[:, :, None, :], s_loc, NEG).reshape(b, h, rows, nb, NA_QBLK, n_loc)
    s_ctx = jnp.einsum('bhrnqd,bhld->bhrnql', qg, kc).astype(jnp.float32) * scale
    p = jax.nn.softmax(jnp.concatenate([s_loc, s_ctx], axis=-1), axis=-1).astype(v.dtype)
    o = (jnp.einsum('bhrnqk,bhrnkd->bhrnqd', p[..., :n_loc], vg.reshape(b, h, rows, nb, n_loc, d))
         + jnp.einsum('bhrnql,bhld->bhrnqd', p[..., n_loc:], vc))
    return o.reshape(b, h, n, d)


def gla_project(h, w_qkvg, w_g1, w_g2, b_g):
    b, n, _ = h.shape
    q, k, v, g = jnp.split(h @ w_qkvg, [GLA_HK, 2 * GLA_HK, 2 * GLA_HK + GLA_HV], axis=-1)
    heads = lambda x, dh: jnp.transpose(x.reshape(b, n, GLA_HEADS, dh), (0, 2, 1, 3))
    q = heads(q, GLA_DK) * (GLA_DK ** -0.5)
    k = heads(k, GLA_DK)
    v = heads(v, GLA_DV)
    lg = jnp.einsum('zbnr,zre->zbne', jnp.einsum('bnd,zdr->zbnr', h, w_g1), w_g2) + b_g[:, None, None, :]
    lg = jax.nn.log_sigmoid(lg.astype(jnp.float32)) / GLA_GATE_NORM
    lg = jnp.transpose(lg.reshape(2, b, n, GLA_HEADS, GLA_DK), (0, 1, 3, 2, 4))
    return q, k, v, g, lg


def gla_scan(q, k, v, lg, s0):
    b, h, n, _ = q.shape
    nc = n // GLA_CHUNK
    chunks = lambda x: jnp.moveaxis(x.reshape(b, h, nc, GLA_CHUNK, x.shape[-1]), 2, 0)
    lower = jnp.tril(jnp.ones((GLA_CHUNK, GLA_CHUNK), dtype=bool))[..., None]

    def step(s, inp):
        qc, kc, vc, gc = inp
        qf, kf, vf = qc.astype(jnp.float32), kc.astype(jnp.float32), vc.astype(jnp.float32)
        bcum = jnp.cumsum(gc, axis=2)
        inter = jnp.einsum('bhtk,bhkv->bhtv', qf * jnp.exp(bcum), s)
        dlt = bcum[:, :, :, None, :] - bcum[:, :, None, :, :]
        decay = jnp.where(lower, jnp.exp(jnp.minimum(dlt, 0.0)), 0.0)
        a = jnp.einsum('bhtk,bhsk,bhtsk->bhts', qf, kf, decay)
        intra = jnp.einsum('bhts,bhsv->bhtv', a, vf)
        btot = bcum[:, :, -1:, :]
        s_new = jnp.exp(btot[:, :, 0, :, None]) * s + jnp.einsum('bhsk,bhsv->bhkv', kf * jnp.exp(btot - bcum), vf)
        return s_new, inter + intra

    s_fin, o = lax.scan(step, s0.astype(jnp.float32), (chunks(q), chunks(k), chunks(v), chunks(lg)))
    o = jnp.moveaxis(o, 0, 2).reshape(b, h, n, v.shape[-1]).astype(v.dtype)
    return o, s_fin


def gla_bidir(q, k, v, lg, s_fwd, s_bwd):
    o_f, sf = gla_scan(q, k, v, lg[0], s_fwd)
    flip = lambda x: jnp.flip(x, axis=2)
    o_b, sb = gla_scan(flip(q), flip(k), flip(v), flip(lg[1]), s_bwd)
    return o_f + flip(o_b), sf, sb


def gla_out(o, g, g_norm, w_o):
    b, h, n, d = o.shape
    o = jnp.transpose(rmsnorm(o, g_norm), (0, 2, 1, 3)).reshape(b, n, h * d)
    return (o * jax.nn.silu(g)) @ w_o


def diff_qkv(h, w_qkv, gq, gk):
    b, n, _ = h.shape
    q, k, v = jnp.split(h @ w_qkv, 3, axis=-1)
    two = lambda x: jnp.transpose(x.reshape(b, n, 2, DIFF_HEADS, DIFF_HD), (0, 2, 3, 1, 4)).reshape(b, 2 * DIFF_HEADS, n, DIFF_HD)
    v = jnp.transpose(v.reshape(b, n, DIFF_HEADS, 2 * DIFF_HD), (0, 2, 1, 3))
    return rmsnorm(two(q), gq), rmsnorm(two(k), gk), v


def diff_attention(q, k, v, lam):
    scale = DIFF_HD ** -0.5

    def blk(qb):
        s = jnp.einsum('bhqd,bhkd->bhqk', qb, k).astype(jnp.float32) * scale
        p = jax.nn.softmax(s, axis=-1)
        p = p.reshape(p.shape[0], 2, DIFF_HEADS, p.shape[2], p.shape[3])
        a = (p[:, 0] - lam * p[:, 1]).astype(v.dtype)
        return jnp.einsum('bhqk,bhkd->bhqd', a, v)
    return map_query_blocks(blk, q)


def mla_queries(h, w_dq, g_qa, w_uq, g_q):
    b, n, _ = h.shape
    q = (rmsnorm(h @ w_dq, g_qa) @ w_uq).reshape(b, n, MLA_HEADS, MLA_QK)
    return rmsnorm(jnp.transpose(q, (0, 2, 1, 3)), g_q)


def mla_compress(h, w_dkv, g_kva):
    kv = h @ w_dkv
    return rmsnorm(kv[..., :MLA_KV_RANK], g_kva), kv[..., MLA_KV_RANK:]


def mla_expand(ckv, krope, w_ukv, g_k):
    b, n, _ = ckv.shape
    kv = jnp.transpose((ckv @ w_ukv).reshape(b, n, MLA_HEADS, MLA_NOPE + MLA_V), (0, 2, 1, 3))
    k = jnp.concatenate([kv[..., :MLA_NOPE], jnp.broadcast_to(krope[:, None], (b, MLA_HEADS, n, MLA_ROPE))], axis=-1)
    return rmsnorm(k, g_k), kv[..., MLA_NOPE:]


def rope_tail(x, cos, sin):
    return jnp.concatenate([x[..., :MLA_NOPE], apply_rope(x[..., MLA_NOPE:], cos, sin)], axis=-1)


def setup_inputs(seed: int = 0) -> dict:
    key = jax.random.key(seed)
    ks = iter(jax.random.split(key, 64))
    f32 = jnp.float32
    nrm = lambda shape, s=1.0: jax.random.normal(next(ks), shape, f32) * s
    wt = lambda shape, fan_in: nrm(shape, fan_in ** -0.5)
    gain = lambda shape: 1.0 + nrm(shape, 0.05)
    F2 = 2 * D_FF
    return {
        'x_prompt': nrm((BATCH, SEQ, D_MODEL)),
        'x_sample': nrm((DEC_BATCH, DEC_SEQ, D_MODEL)),
        'cache_l0_k': nrm((DEC_BATCH, NA_HEADS, PAST_LEN, NA_HD)),
        'cache_l0_v': nrm((DEC_BATCH, NA_HEADS, PAST_LEN, NA_HD)),
        'state_l1_fwd': nrm((DEC_BATCH, GLA_HEADS, GLA_DK, GLA_DV)),
        'state_l1_bwd': nrm((DEC_BATCH, GLA_HEADS, GLA_DK, GLA_DV)),
        'cache_l2_k': nrm((DEC_BATCH, 2 * DIFF_HEADS, PAST_LEN, DIFF_HD)),
        'cache_l2_v': nrm((DEC_BATCH, DIFF_HEADS, PAST_LEN, 2 * DIFF_HD)),
        'cache_l3_ckv': nrm((DEC_BATCH, PAST_LEN, MLA_KV_RANK)),
        'cache_l3_krope': nrm((DEC_BATCH, PAST_LEN, MLA_ROPE)),
        'c': nrm((DEC_BATCH, D_MODEL)),
        'c_ctx': nrm((D_MODEL,)),
        'ada_w': wt((DEPTH, D_MODEL, 6 * D_MODEL), D_MODEL) * 0.5,
        'ada_b': nrm((DEPTH, 6 * D_MODEL), 0.02),
        'norm_mix': gain((DEPTH, D_MODEL)),
        'norm_ffn': gain((DEPTH, D_MODEL)),
        'ffn_w_up': wt((DEPTH, D_MODEL, F2), D_MODEL),
        'ffn_conv_w': wt((DEPTH, CONV_W, F2), CONV_W),
        'ffn_conv_b': nrm((DEPTH, F2), 0.02),
        'ffn_w_down': wt((DEPTH, D_FF, D_MODEL), D_FF),
        'na_w_qkv': wt((D_MODEL, 3 * NA_HEADS * NA_HD), D_MODEL),
        'na_q_norm': gain((NA_HD,)),
        'na_k_norm': gain((NA_HD,)),
        'na_bias': nrm((NA_HEADS, 2 * NA_WIN_R - 1, 2 * NA_WIN_C - 1), 0.2),
        'na_w_o': wt((NA_HEADS * NA_HD, D_MODEL), NA_HEADS * NA_HD),
        'gla_w_qkvg': wt((D_MODEL, 2 * GLA_HK + 2 * GLA_HV), D_MODEL),
        'gla_w_gate1': wt((2, D_MODEL, GLA_GATE_RANK), D_MODEL),
        'gla_w_gate2': wt((2, GLA_GATE_RANK, GLA_HK), GLA_GATE_RANK),
        'gla_b_gate': nrm((2, GLA_HK), 0.1),
        'gla_o_norm': gain((GLA_DV,)),
        'gla_w_o': wt((GLA_HV, D_MODEL), GLA_HV),
        'diff_w_qkv': wt((D_MODEL, 3 * D_MODEL), D_MODEL),
        'diff_q_norm': gain((DIFF_HD,)),
        'diff_k_norm': gain((DIFF_HD,)),
        'diff_lambda': nrm((4, DIFF_HD), 0.1),
        'diff_sub_norm': gain((2 * DIFF_HD,)),
        'diff_w_o': wt((D_MODEL, D_MODEL), D_MODEL),
        'mla_w_dq': wt((D_MODEL, MLA_Q_RANK), D_MODEL),
        'mla_q_a_norm': gain((MLA_Q_RANK,)),
        'mla_w_uq': wt((MLA_Q_RANK, MLA_HEADS * MLA_QK), MLA_Q_RANK),
        'mla_w_dkv': wt((D_MODEL, MLA_KV_RANK + MLA_ROPE), D_MODEL),
        'mla_kv_a_norm': gain((MLA_KV_RANK,)),
        'mla_w_ukv': wt((MLA_KV_RANK, MLA_HEADS * (MLA_NOPE + MLA_V)), MLA_KV_RANK),
        'mla_q_norm': gain((MLA_QK,)),
        'mla_k_norm': gain((MLA_QK,)),
        'mla_w_o': wt((MLA_HEADS * MLA_V, D_MODEL), MLA_HEADS * MLA_V),
    }


def reference(x_prompt, x_sample, cache_l0_k, cache_l0_v, state_l1_fwd, state_l1_bwd,
              cache_l2_k, cache_l2_v, cache_l3_ckv, cache_l3_krope, c, c_ctx,
              ada_w, ada_b, norm_mix, norm_ffn, ffn_w_up, ffn_conv_w, ffn_conv_b, ffn_w_down,
              na_w_qkv, na_q_norm, na_k_norm, na_bias, na_w_o,
              gla_w_qkvg, gla_w_gate1, gla_w_gate2, gla_b_gate, gla_o_norm, gla_w_o,
              diff_w_qkv, diff_q_norm, diff_k_norm, diff_lambda, diff_sub_norm, diff_w_o,
              mla_w_dq, mla_q_a_norm, mla_w_uq, mla_w_dkv, mla_kv_a_norm, mla_w_ukv,
              mla_q_norm, mla_k_norm, mla_w_o):
    xp, xs = x_prompt, x_sample
    n_lat = xs.shape[1]
    cos_d, sin_d = axial_rope_tables(n_lat, DIFF_HD)
    cos_m, sin_m = axial_rope_tables(n_lat, MLA_ROPE)
    lam = (jnp.exp(jnp.sum(diff_lambda[0] * diff_lambda[1]).astype(jnp.float32))
           - jnp.exp(jnp.sum(diff_lambda[2] * diff_lambda[3]).astype(jnp.float32)) + DIFF_LAMBDA_INIT)
    for i in range(DEPTH):
        kind = i % N_MIXERS
        mp = ada_mod(c_ctx, ada_w[i], ada_b[i])
        ms = ada_mod(c, ada_w[i], ada_b[i])
        hp = modulate(rmsnorm(xp, norm_mix[i]), mp[0], mp[1])
        hs = modulate(rmsnorm(xs, norm_mix[i]), ms[0], ms[1])
        if kind == 0:
            qp, kp, vp = na_qkv(hp, na_w_qkv, na_q_norm, na_k_norm)
            op = merge_heads(dense_attention(qp, kp, vp, NA_HD ** -0.5), na_w_o)
            new_l0_k, new_l0_v = kp, vp
            qs, ks_, vs = na_qkv(hs, na_w_qkv, na_q_norm, na_k_norm)
            os_ = merge_heads(na_latent(qs, ks_, vs, cache_l0_k, cache_l0_v, na_bias), na_w_o)
        elif kind == 1:
            qp, kp, vp, gp, lgp = gla_project(hp, gla_w_qkvg, gla_w_gate1, gla_w_gate2, gla_b_gate)
            s0 = jnp.zeros((hp.shape[0], GLA_HEADS, GLA_DK, GLA_DV), jnp.float32)
            o, new_l1_fwd, new_l1_bwd = gla_bidir(qp, kp, vp, lgp, s0, s0)
            op = gla_out(o, gp, gla_o_norm, gla_w_o)
            qs, ks_, vs, gs, lgs = gla_project(hs, gla_w_qkvg, gla_w_gate1, gla_w_gate2, gla_b_gate)
            o, _, _ = gla_bidir(qs, ks_, vs, lgs, state_l1_fwd, state_l1_bwd)
            os_ = gla_out(o, gs, gla_o_norm, gla_w_o)
        elif kind == 2:
            qp, kp, vp = diff_qkv(hp, diff_w_qkv, diff_q_norm, diff_k_norm)
            o = diff_attention(qp, kp, vp, lam)
            op = merge_heads(rmsnorm(o, diff_sub_norm) * (1 - DIFF_LAMBDA_INIT), diff_w_o)
            new_l2_k, new_l2_v = kp, vp
            qs, ks_, vs = diff_qkv(hs, diff_w_qkv, diff_q_norm, diff_k_norm)
            qs = apply_rope(qs, cos_d, sin_d)
            ks_ = apply_rope(ks_, cos_d, sin_d)
            o = diff_attention(qs, jnp.concatenate([cache_l2_k, ks_], axis=2),
                               jnp.concatenate([cache_l2_v, vs], axis=2), lam)
            os_ = merge_heads(rmsnorm(o, diff_sub_norm) * (1 - DIFF_LAMBDA_INIT), diff_w_o)
        else:
            qp = mla_queries(hp, mla_w_dq, mla_q_a_norm, mla_w_uq, mla_q_norm)
            cp, krp = mla_compress(hp, mla_w_dkv, mla_kv_a_norm)
            kp, vp = mla_expand(cp, krp, mla_w_ukv, mla_k_norm)
            op = merge_heads(dense_attention(qp, kp, vp, MLA_QK ** -0.5), mla_w_o)
            new_l3_ckv, new_l3_krope = cp, krp
            qs = rope_tail(mla_queries(hs, mla_w_dq, mla_q_a_norm, mla_w_uq, mla_q_norm), cos_m, sin_m)
            cs, krs = mla_compress(hs, mla_w_dkv, mla_kv_a_norm)
            ks_, vs = mla_expand(cs, krs, mla_w_ukv, mla_k_norm)
            ks_ = rope_tail(ks_, cos_m, sin_m)
            kc, vc = mla_expand(cache_l3_ckv, cache_l3_krope, mla_w_ukv, mla_k_norm)
            os_ = merge_heads(dense_attention(qs, jnp.concatenate([kc, ks_], axis=2),
                                              jnp.concatenate([vc, vs], axis=2), MLA_QK ** -0.5), mla_w_o)
        xp = xp + mp[2] * op
        xs = xs + ms[2] * os_
        hp = modulate(rmsnorm(xp, norm_ffn[i]), mp[3], mp[4])
        hs = modulate(rmsnorm(xs, norm_ffn[i]), ms[3], ms[4])
        xp = xp + mp[5] * conv_ffn(hp, ffn_w_up[i], ffn_conv_w[i], ffn_conv_b[i], ffn_w_down[i])
        xs = xs + ms[5] * conv_ffn(hs, ffn_w_up[i], ffn_conv_w[i], ffn_conv_b[i], ffn_w_down[i])
    return (xp, xs, new_l0_k, new_l0_v, new_l1_fwd, new_l1_bwd, new_l2_k, new_l2_v, new_l3_ckv, new_l3_krope)
```

```cpp
#include <hip/hip_runtime.h>
#include <hip/hip_cooperative_groups.h>
#include <stdint.h>
namespace cg = cooperative_groups;

typedef unsigned short bf16_t;
typedef __attribute__((ext_vector_type(8))) short bf16x8;
typedef __attribute__((ext_vector_type(4))) short bf16x4;
typedef __attribute__((ext_vector_type(16))) float f32x16;
#define DI __device__ __forceinline__
#define MFMA32(a, b, c) __builtin_amdgcn_mfma_f32_32x32x16_bf16((a), (b), (c), 0, 0, 0)

#ifndef REPMASK
#define REPMASK 0
#endif
constexpr size_t MB = 1ull << 20;
constexpr size_t W_NA_QKV = 0;
constexpr size_t W_NA_O = W_NA_QKV + 3072ull * 1024;
constexpr size_t W_GLA_QKVG = W_NA_O + 1024ull * 1024;
constexpr size_t W_GLA_O = W_GLA_QKVG + 3328ull * 1024;
constexpr size_t W_DIFF_QKV = W_GLA_O + 1024ull * 1024;
constexpr size_t W_DIFF_O = W_DIFF_QKV + 3072ull * 1024;
constexpr size_t W_MLA_DQKV = W_DIFF_O + 1024ull * 1024;
constexpr size_t W_MLA_UQ = W_MLA_DQKV + 768ull * 1024;
constexpr size_t W_MLA_UKV = W_MLA_UQ + 1536ull * 384;
constexpr size_t W_MLA_O = W_MLA_UKV + 2048ull * 256;
constexpr size_t W_UP = W_MLA_O + 1024ull * 1024;
constexpr size_t W_DOWN = W_UP + 4ull * 5632 * 1024;
constexpr size_t W_END = W_DOWN + 4ull * 1024 * 2816;
constexpr size_t OFF_H = ((W_END * 2 + 255) / 256) * 256;
constexpr size_t OFF_BIG = OFF_H + 8192ull * 1024 * 2;
constexpr size_t OFF_O = OFF_BIG + 8192ull * 5632 * 2;
constexpr size_t OFF_MODS = OFF_O + 8192ull * 1024 * 2;
constexpr size_t OFF_MIX = OFF_MODS + 512 * 1024;
constexpr size_t OFF_BAR = OFF_MIX + 100 * MB;
constexpr size_t O_L0K = 8388608, O_L0V = 12582912, O_L1F = 16777216, O_L1B = 18874368;
constexpr size_t O_L2K = 20971520, O_L2V = 25165824, O_L3C = 29360128, O_L3R = 30408704;

struct Params {
  const float* in[46];
  float* out;
  char* ws;
};
typedef const __attribute__((address_space(4))) Params& CPR;
typedef const __attribute__((address_space(4))) Params* CPP;
enum { I_XP = 0, I_XS, I_C0K, I_C0V, I_SF, I_SB, I_C2K, I_C2V, I_C3C, I_C3R, I_C, I_CCTX, I_ADAW, I_ADAB, I_NMIX, I_NFFN,
       I_WUP, I_CONVW, I_CONVB, I_WDOWN, I_NAQKV, I_NAQN, I_NAKN, I_NABIAS, I_NAO, I_GQKVG, I_GG1, I_GG2, I_GBG, I_GON, I_GO,
       I_DQKV, I_DQN, I_DKN, I_DLAM, I_DSUB, I_DO, I_MDQ, I_MQAN, I_MUQ, I_MDKV, I_MKVAN, I_MUKV, I_MQN, I_MKN, I_MO };

DI unsigned short f2bf(float x) {
  unsigned u = __float_as_uint(x);
  u += 0x7fffu + ((u >> 16) & 1u);
  return (unsigned short)(u >> 16);
}
DI float bf2f(unsigned short b) { return __uint_as_float(((unsigned)b) << 16); }
typedef __bf16 bf16v2_t __attribute__((ext_vector_type(2)));
typedef float f32v2_t __attribute__((ext_vector_type(2)));
DI unsigned pack2(float a, float b) { f32v2_t f = {a, b}; bf16v2_t h = __builtin_convertvector(f, bf16v2_t); return __builtin_bit_cast(unsigned, h); }
DI int crow(int i, int hh) { return (i & 3) + 8 * (i >> 2) + 4 * hh; }
DI float siluf(float x) { return x / (1.f + __expf(-x)); }
DI int otid() { int t = __builtin_amdgcn_workitem_id_x(); asm volatile("" : "+v"(t)); return t; }
DI int obid() { int b = __builtin_amdgcn_workgroup_id_x(); asm volatile("" : "+s"(b)); return b; }
DI int gtid() { return obid() * 512 + otid(); }
DI int gthreads() { return gridDim.x * 512; }
DI int vtid() { return otid() & 255; }
DI int vbid() { return obid() * 2 + (otid() >> 8); }
DI int nvb() { return gridDim.x * 2; }

template <int D> DI void load_bf16_row(const bf16_t* p, float (&v)[D]) {
#pragma unroll
  for (int j = 0; j < D / 8; ++j) {
    uint4 q = *(const uint4*)(p + j * 8);
    unsigned w[4] = {q.x, q.y, q.z, q.w};
#pragma unroll
    for (int e = 0; e < 4; ++e) { v[j * 8 + 2 * e] = __uint_as_float(w[e] << 16); v[j * 8 + 2 * e + 1] = __uint_as_float(w[e] & 0xffff0000u); }
  }
}
template <int D> DI void store_bf16_row(bf16_t* p, const float (&v)[D]) {
#pragma unroll
  for (int j = 0; j < D / 8; ++j) {
    uint4 q;
    q.x = pack2(v[j * 8 + 0], v[j * 8 + 1]); q.y = pack2(v[j * 8 + 2], v[j * 8 + 3]);
    q.z = pack2(v[j * 8 + 4], v[j * 8 + 5]); q.w = pack2(v[j * 8 + 6], v[j * 8 + 7]);
    *(uint4*)(p + j * 8) = q;
  }
}
template <int D> DI void store_f32_row(float* p, const float (&v)[D]) {
#pragma unroll
  for (int j = 0; j < D / 4; ++j) *(float4*)(p + j * 4) = make_float4(v[j * 4], v[j * 4 + 1], v[j * 4 + 2], v[j * 4 + 3]);
}
template <int D> DI void rms_apply(float (&v)[D], const float* g) {
  float ss = 0.f;
#pragma unroll
  for (int j = 0; j < D; ++j) ss += v[j] * v[j];
  float rs = rsqrtf(ss * (1.f / D) + 1e-6f);
#pragma unroll
  for (int j = 0; j < D; ++j) v[j] = v[j] * rs * g[j];
}
template <int D, int BASE, int R> DI void rope_apply(float (&v)[D], int t) {
  constexpr int NF = R / 4;
  float rowf = (float)(t >> 6), colf = (float)(t & 63);
#pragma unroll
  for (int a = 0; a < 2; ++a) {
#pragma unroll
    for (int f = 0; f < NF; ++f) {
      float freq = exp2f(-(float)f * (13.287712379549449f / NF));
      float ang = (a == 0 ? rowf : colf) * freq;
      float c = __cosf(ang), s = __sinf(ang);
      int i1 = BASE + a * 2 * NF + f, i2 = i1 + NF;
      float x1 = v[i1], x2 = v[i2];
      v[i1] = x1 * c - x2 * s;
      v[i2] = x1 * s + x2 * c;
    }
  }
}
template <bool PERMK, int DVH = 0, class F> DI void transpose_gen(int ncols, int nrows, bf16_t* dst, size_t dstride, F srcf, int koff = 0) {
  int total = ncols * (nrows >> 3);
  for (int idx = gtid(); idx < total; idx += gthreads()) {
    int c = idx % ncols, r0 = (idx / ncols) << 3;
    unsigned short e[8];
#pragma unroll
    for (int j = 0; j < 8; ++j) e[j] = srcf(r0 + j, c);
    const int k0 = koff + r0;
    bf16_t* drow = (DVH > 0) ? dst + (size_t)(c / (DVH > 0 ? DVH : 1)) * dstride + (size_t)(k0 >> 5) * (DVH * 32) + (c % (DVH > 0 ? DVH : 1)) * 32 + (k0 & 16)
                             : dst + (size_t)c * dstride + (k0 & ~15);
    if (PERMK) {
      uint2 q0, q1;
      q0.x = e[0] | ((unsigned)e[1] << 16); q0.y = e[2] | ((unsigned)e[3] << 16);
      q1.x = e[4] | ((unsigned)e[5] << 16); q1.y = e[6] | ((unsigned)e[7] << 16);
      bf16_t* d = drow + ((k0 & 8) ? 4 : 0);
      *(uint2*)d = q0;
      *(uint2*)(d + 8) = q1;
    } else {
      uint4 q;
      q.x = e[0] | ((unsigned)e[1] << 16); q.y = e[2] | ((unsigned)e[3] << 16);
      q.z = e[4] | ((unsigned)e[5] << 16); q.w = e[6] | ((unsigned)e[7] << 16);
      *(uint4*)(drow + (k0 & 8)) = q;
    }
  }
}

namespace pg8 {
#define PG8_LAS __attribute__((address_space(3)))
typedef float f32x4 __attribute__((ext_vector_type(4)));
typedef unsigned u32x4 __attribute__((ext_vector_type(4)));
constexpr int BM = 256, BK = 64, HALF = 128, HTB = HALF * BK * 2, STAGE_BYTES = 8 * HTB, NXCD = 8, WGM = 4;
DI int lds_byte(int r, int c) { const int st = (r >> 4) * 2 + (c >> 5), rr = r & 15, cc = c & 31, ob = rr * 64 + cc * 2; return st * 1024 + (ob ^ (((ob >> 9) & 1) << 5)); }
DI void stage_rc(int b, int& R, int& C) { const int st = b / 1024, sb = b % 1024, swz = sb ^ (((sb >> 9) & 1) << 5); R = (st >> 1) * 16 + swz / 64; C = (st & 1) * 32 + (swz % 64) / 2; }
DI int perm32(int rho) { const int n = rho >> 4, i = rho & 15; return 8 * (i >> 2) + 4 * n + (i & 3); }
struct Unit { int pm, pn, ks; };
struct Gemm { const bf16_t* A; const bf16_t* Bt; int M, N, K; int Kext; };
struct StaticOrder {
  int nM, nN, nwg, G, c;
  DI void init(int M, int N, int G_, int c_) { nM = M / BM; nN = N / BM; nwg = nM * nN; G = G_; c = c_; }
  DI bool next(int i, Unit& u) const {
    const long L = (long)i * G + c; if (L >= nwg) return false;
    int wgid = (int)L; { const int q = nwg / NXCD, r = nwg % NXCD, xcd = wgid % NXCD, off = wgid / NXCD; wgid = (xcd < r ? xcd * (q + 1) : r * (q + 1) + (xcd - r) * q) + off; }
    const int nig = WGM * nN, gid = wgid / nig, fm = gid * WGM, gsz = (nM - fm) < WGM ? (nM - fm) : WGM;
    u.pm = fm + ((wgid % nig) % gsz); u.pn = (wgid % nig) / gsz; u.ks = 0; return true;
  }
  DI void a_ready(const Unit&) const {}
  DI void done(const Unit&) const {}
};
struct SplitK2Order : StaticOrder {
  DI bool next(int i, Unit& u) const {
    const long L = (long)i * G + c; if (L >= 2 * nwg) return false;
    int wgid = (int)(L >> 1); { const int q = nwg / NXCD, r = nwg % NXCD, xcd = wgid % NXCD, off = wgid / NXCD; wgid = (xcd < r ? xcd * (q + 1) : r * (q + 1) + (xcd - r) * q) + off; }
    const int nig = WGM * nN, gid = wgid / nig, fm = gid * WGM, gsz = (nM - fm) < WGM ? (nM - fm) : WGM;
    u.pm = fm + ((wgid % nig) % gsz); u.pn = (wgid % nig) / gsz; u.ks = (int)(L & 1); return true;
  }
};
DI unsigned cvt_pk_bf16(float lo, float hi) { unsigned r; asm volatile("v_cvt_pk_bf16_f32 %0, %1, %2" : "=v"(r) : "v"(lo), "v"(hi)); return r; }
struct EpiStore {
  static constexpr bool PERM = true;
  bf16_t* O; int ldc; bf16_t* O1;
  DI void operator()(const f32x4 (&acc)[2][2][4][2], const Unit& u, int wr, int wc, int fr, int fq) const {
    const int row0 = u.pm * BM + wr * 64 + fr, col0 = u.pn * BM + wc * 32 + 8 * fq;
#pragma unroll
    for (int ai = 0; ai < 2; ++ai)
#pragma unroll
      for (int m = 0; m < 4; ++m) {
        bf16_t* rowp = (u.ks ? O1 : O) + (size_t)(row0 + ai * HALF + m * 16) * ldc + col0;
#pragma unroll
        for (int bj = 0; bj < 2; ++bj) {
          const f32x4 v0 = acc[ai][bj][m][0], v1 = acc[ai][bj][m][1];
          u32x4 w; w.x = cvt_pk_bf16(v0[0], v0[1]); w.y = cvt_pk_bf16(v0[2], v0[3]); w.z = cvt_pk_bf16(v1[0], v1[1]); w.w = cvt_pk_bf16(v1[2], v1[3]);
          *(u32x4*)(rowp + bj * HALF) = w;
        }
      }
  }
};
struct EpiResid {
  static constexpr bool PERM = false;
  const float* xp; const float* xs; float* out; const float* mods_l; int gate_off; int first; float* p1;
  DI void operator()(const f32x4 (&acc)[2][2][4][2], const Unit& u, int wr, int wc, int fr, int fq) const {
    const int rowb = u.pm * BM;
    const float* xin = first ? (rowb < 4096 ? xp + (size_t)rowb * 1024 : xs + (size_t)(rowb - 4096) * 1024) : out + (size_t)rowb * 1024;
    float* xo = (u.ks ? p1 : out) + (size_t)rowb * 1024;
    const int mr = rowb < 4096 ? 0 : (rowb < 6144 ? 1 : 2);
    const float* gate = mods_l + (size_t)mr * 6144 + gate_off;
    const int col0 = u.pn * BM + wc * 32 + 4 * fq;
    f32x4 gv[2][2];
#pragma unroll
    for (int bj = 0; bj < 2; ++bj)
#pragma unroll
      for (int n = 0; n < 2; ++n) gv[bj][n] = *(const f32x4*)(gate + col0 + bj * HALF + n * 16);
#pragma unroll
    for (int ai = 0; ai < 2; ++ai)
#pragma unroll
      for (int m = 0; m < 4; ++m) {
        const unsigned ro = (unsigned)(wr * 64 + fr + ai * HALF + m * 16) * 1024u + col0;
#pragma unroll
        for (int bj = 0; bj < 2; ++bj)
#pragma unroll
          for (int n = 0; n < 2; ++n) {
            const unsigned o = ro + bj * HALF + n * 16;
            if (u.ks) *(f32x4*)(xo + o) = gv[bj][n] * acc[ai][bj][m][n];
            else *(f32x4*)(xo + o) = *(const f32x4*)(xin + o) + gv[bj][n] * acc[ai][bj][m][n];
          }
      }
  }
};

template <class Epi, class Sched>
DI void gemm_phase(PG8_LAS unsigned char* lds, const Gemm g, const Sched& S, const Epi& E) {
  const int tid = otid(), wid = __builtin_amdgcn_readfirstlane(tid >> 6), lane = tid & 63, wr = wid >> 2, wc = wid & 3, fr = lane & 15, fq = lane >> 4;
  const int K = g.K, nt = g.Kext / BK;
  const size_t ksb = (size_t)g.Kext * 2;
  unsigned voffA[2], voffB[2];
#pragma unroll
  for (int i = 0; i < 2; ++i) { int R, C; stage_rc(tid * 16 + i * 8192, R, C); const int Rb = Epi::PERM ? ((R & ~31) + perm32(R & 31)) : R;
    voffA[i] = (unsigned)(R * K + C) * 2u; voffB[i] = (unsigned)(Rb * K + C) * 2u; }
  const size_t kstep = (size_t)(BK * 2);
  const size_t hstep = (size_t)HALF * K * 2;
  const size_t tstep = 2 * hstep;
  const unsigned ldsw = (unsigned)wid * 1024u;
  const int aoff = lds_byte(wr * 64 + fr, fq * 8), boff = lds_byte(wc * 32 + fr, fq * 8);
#define PG8_SA(b, h) (((b) * 2 + (h)) * HTB)
#define PG8_SB(b, h) ((4 + (b) * 2 + (h)) * HTB)
#define PG8_STAGE(bufoff, gbase, voff) do { _Pragma("unroll") for (int _i = 0; _i < 2; ++_i) \
    __builtin_amdgcn_global_load_lds((const unsigned*)((const char*)(gbase) + (voff)[_i]), (PG8_LAS unsigned*)(lds + (bufoff) + ldsw + _i * 8192), 16, 0, 0); } while (0)
#define PG8_LDA(dst, b, h) do { _Pragma("unroll") for (int m = 0; m < 4; ++m) _Pragma("unroll") for (int k = 0; k < 2; ++k) dst[m][k] = *(const PG8_LAS bf16x8*)(lds + PG8_SA(b, h) + aoff + m * 2048 + k * 1024); } while (0)
#define PG8_LDB(dst, b, h) do { _Pragma("unroll") for (int n = 0; n < 2; ++n) _Pragma("unroll") for (int k = 0; k < 2; ++k) dst[n][k] = *(const PG8_LAS bf16x8*)(lds + PG8_SB(b, h) + boff + n * 2048 + k * 1024); } while (0)
#define PG8_MMA(ai, bj, At, Bt) do { __builtin_amdgcn_s_setprio(1); _Pragma("unroll") for (int m = 0; m < 4; ++m) _Pragma("unroll") for (int n = 0; n < 2; ++n) _Pragma("unroll") for (int k = 0; k < 2; ++k) \
    acc[ai][bj][m][n] = __builtin_amdgcn_mfma_f32_16x16x32_bf16(Bt[n][k], At[m][k], acc[ai][bj][m][n], 0, 0, 0); __builtin_amdgcn_s_setprio(0); } while (0)
#define PG8_WAIT_V(n) asm volatile("s_waitcnt vmcnt(" #n ")" ::: "memory")
#define PG8_WAIT_L(n) asm volatile("s_waitcnt lgkmcnt(" #n ")" ::: "memory")
#define PG8_BAR __builtin_amdgcn_s_barrier()
#define PG8_SCHED __builtin_amdgcn_sched_barrier(0)
  Unit cur, nxt; int ui = 0;
  if (!S.next(0, cur)) return;
  f32x4 acc[2][2][4][2];
#pragma unroll
  for (int a = 0; a < 2; ++a)
#pragma unroll
    for (int b = 0; b < 2; ++b)
#pragma unroll
      for (int m = 0; m < 4; ++m)
#pragma unroll
        for (int n = 0; n < 2; ++n) acc[a][b][m][n] = (f32x4){0.f, 0.f, 0.f, 0.f};
  bf16x8 At[4][2], B0[2][2], B1[2][2];
  const char* cA = (const char*)g.A + (size_t)cur.pm * tstep + cur.ks * ksb; const char* cB = (const char*)g.Bt + (size_t)cur.pn * tstep + cur.ks * ksb;
  S.a_ready(cur);
  PG8_STAGE(PG8_SB(0, 0), cB, voffB); PG8_STAGE(PG8_SA(0, 0), cA, voffA); PG8_STAGE(PG8_SB(0, 1), cB + hstep, voffB); PG8_STAGE(PG8_SA(0, 1), cA + hstep, voffA);
  if (wr == 1) PG8_BAR;
  PG8_WAIT_V(4); PG8_BAR;
  PG8_STAGE(PG8_SB(1, 0), cB + kstep, voffB); PG8_STAGE(PG8_SA(1, 0), cA + kstep, voffA); PG8_STAGE(PG8_SB(1, 1), cB + hstep + kstep, voffB);
  PG8_WAIT_V(6); PG8_BAR;
  for (;;) {
    const bool has_next = S.next(ui + 1, nxt);
    const char* nA = has_next ? (const char*)g.A + (size_t)nxt.pm * tstep + nxt.ks * ksb : cA; const char* nB = has_next ? (const char*)g.Bt + (size_t)nxt.pn * tstep + nxt.ks * ksb : cB;
    for (int t = 0; t < nt; t += 2) {
      const bool last = (t == nt - 2);
      const char* a1 = cA + (size_t)(t + 1) * kstep;
      const char* a2 = last ? nA : cA + (size_t)(t + 2) * kstep; const char* b2 = last ? nB : cB + (size_t)(t + 2) * kstep;
      const char* a3 = a2 + kstep; const char* b3 = b2 + kstep;
      if (last && has_next) S.a_ready(nxt);
      PG8_LDB(B0, 0, 0); PG8_SCHED; PG8_LDA(At, 0, 0); PG8_STAGE(PG8_SA(1, 1), a1 + hstep, voffA);
      PG8_WAIT_L(8); PG8_BAR; PG8_WAIT_L(0); PG8_MMA(0, 0, At, B0); PG8_BAR; PG8_SCHED;
      PG8_LDB(B1, 0, 1); PG8_STAGE(PG8_SB(0, 0), b2, voffB);
      PG8_BAR; PG8_WAIT_L(0); PG8_MMA(0, 1, At, B1); PG8_BAR;
      PG8_LDA(At, 0, 1); PG8_STAGE(PG8_SA(0, 0), a2, voffA);
      PG8_BAR; PG8_WAIT_L(0); PG8_MMA(1, 0, At, B0); PG8_BAR; PG8_SCHED;
      PG8_STAGE(PG8_SB(0, 1), b2 + hstep, voffB);
      PG8_WAIT_V(6); PG8_BAR; PG8_MMA(1, 1, At, B1); PG8_BAR;
      PG8_LDB(B0, 1, 0); PG8_SCHED; PG8_LDA(At, 1, 0); PG8_STAGE(PG8_SA(0, 1), a2 + hstep, voffA);
      PG8_WAIT_L(8); PG8_BAR; PG8_WAIT_L(0); PG8_MMA(0, 0, At, B0); PG8_BAR; PG8_SCHED;
      PG8_LDB(B1, 1, 1); PG8_STAGE(PG8_SB(1, 0), b3, voffB);
      PG8_BAR; PG8_WAIT_L(0); PG8_MMA(0, 1, At, B1); PG8_BAR;
      PG8_LDA(At, 1, 1); PG8_STAGE(PG8_SA(1, 0), a3, voffA);
      PG8_BAR; PG8_WAIT_L(0); PG8_MMA(1, 0, At, B0); PG8_BAR; PG8_SCHED;
      PG8_STAGE(PG8_SB(1, 1), b3 + hstep, voffB);
      PG8_WAIT_V(6); PG8_BAR; PG8_MMA(1, 1, At, B1); PG8_BAR;
    }
    E(acc, cur, wr, wc, fr, fq); S.done(cur);
    if (!has_next) break;
#pragma unroll
    for (int a = 0; a < 2; ++a)
#pragma unroll
      for (int b = 0; b < 2; ++b)
#pragma unroll
        for (int m = 0; m < 4; ++m)
#pragma unroll
          for (int n = 0; n < 2; ++n) acc[a][b][m][n] = (f32x4){0.f, 0.f, 0.f, 0.f};
    cur = nxt; cA = nA; cB = nB; ++ui;
  }
  PG8_WAIT_V(0);
  if (wr == 0) PG8_BAR;
  PG8_BAR;
#undef PG8_SA
#undef PG8_SB
#undef PG8_STAGE
#undef PG8_LDA
#undef PG8_LDB
#undef PG8_MMA
#undef PG8_WAIT_V
#undef PG8_WAIT_L
#undef PG8_BAR
#undef PG8_SCHED
}
}

DI void gemm_store_phase(const bf16_t* A, const bf16_t* Bt, int M, int N, int K, bf16_t* C, int ldc, unsigned char* shm) {
  pg8::Gemm g; g.A = A; g.Bt = Bt; g.M = M; g.N = N; g.K = K; g.Kext = K;
  pg8::StaticOrder S; S.init(M, N, (int)gridDim.x, obid());
  pg8::EpiStore E; E.O = C; E.ldc = ldc; E.O1 = C;
  pg8::gemm_phase(( __attribute__((address_space(3))) unsigned char*)shm, g, S, E);
}
DI void gemm_store_sk_phase(const bf16_t* A, const bf16_t* Bt, int M, int N, int K, bf16_t* C, bf16_t* C1, int ldc, unsigned char* shm) {
  pg8::Gemm g; g.A = A; g.Bt = Bt; g.M = M; g.N = N; g.K = K; g.Kext = K / 2;
  pg8::SplitK2Order S; S.init(M, N, (int)gridDim.x, obid());
  pg8::EpiStore E; E.O = C; E.ldc = ldc; E.O1 = C1;
  pg8::gemm_phase(( __attribute__((address_space(3))) unsigned char*)shm, g, S, E);
}
DI void gemm_resid_phase(CPR p, const bf16_t* A, int K, const bf16_t* Bt, int l, int gate_off, bool first, bool splitk, unsigned char* shm, bool dummy = false) {
  pg8::Gemm g; g.A = A; g.Bt = Bt; g.M = 8192; g.N = 1024; g.K = K; g.Kext = splitk ? K / 2 : K;
  pg8::EpiResid E; E.xp = p.in[I_XP]; E.xs = p.in[I_XS]; E.out = p.out; E.mods_l = (const float*)(p.ws + OFF_MODS) + (size_t)l * 3 * 6144; E.gate_off = gate_off; E.first = first ? 1 : 0;
  E.p1 = (float*)(p.ws + OFF_BIG);
  if (dummy) { E.out = (float*)(p.ws + OFF_BIG) + 8388608; E.p1 = E.out; E.first = 0; }
  if (splitk) {
    pg8::SplitK2Order S; S.init(8192, 1024, (int)gridDim.x, obid());
    pg8::gemm_phase(( __attribute__((address_space(3))) unsigned char*)shm, g, S, E);
  } else {
    pg8::StaticOrder S; S.init(8192, 1024, (int)gridDim.x, obid());
    pg8::gemm_phase(( __attribute__((address_space(3))) unsigned char*)shm, g, S, E);
  }
}

DI void mods_item(CPR p, int it, char* smem) {
  const int tid = vtid();
  const int l = it / 96, n0 = (it % 96) * 64;
  float* sc = (float*)smem;
  float* red = sc + 3072;
  for (int i = tid; i < 3072; i += 256) {
    int rr = i >> 10, k = i & 1023;
    float cv = (rr == 0) ? p.in[I_CCTX][k] : p.in[I_C][(rr - 1) * 1024 + k];
    sc[i] = siluf(cv);
  }
  __syncthreads();
  const int cq = tid & 15, ks = tid >> 4;
  float a0[4] = {0, 0, 0, 0}, a1[4] = {0, 0, 0, 0}, a2[4] = {0, 0, 0, 0};
  const float* w = p.in[I_ADAW] + ((size_t)l * 1024 + ks * 64) * 6144 + n0 + cq * 4;
#pragma unroll 8
  for (int kk = 0; kk < 64; ++kk) {
    float4 w4 = *(const float4*)(w + (size_t)kk * 6144);
    int k = ks * 64 + kk;
    float s0 = sc[k], s1 = sc[1024 + k], s2 = sc[2048 + k];
    a0[0] += s0 * w4.x; a0[1] += s0 * w4.y; a0[2] += s0 * w4.z; a0[3] += s0 * w4.w;
    a1[0] += s1 * w4.x; a1[1] += s1 * w4.y; a1[2] += s1 * w4.z; a1[3] += s1 * w4.w;
    a2[0] += s2 * w4.x; a2[1] += s2 * w4.y; a2[2] += s2 * w4.z; a2[3] += s2 * w4.w;
  }
#pragma unroll
  for (int j = 0; j < 4; ++j) {
    red[(ks * 3 + 0) * 64 + cq * 4 + j] = a0[j];
    red[(ks * 3 + 1) * 64 + cq * 4 + j] = a1[j];
    red[(ks * 3 + 2) * 64 + cq * 4 + j] = a2[j];
  }
  __syncthreads();
  if (tid < 192) {
    int rr = tid >> 6, n = tid & 63;
    float s = 0.f;
#pragma unroll
    for (int k2 = 0; k2 < 16; ++k2) s += red[(k2 * 3 + rr) * 64 + n];
    float* mods = (float*)(p.ws + OFF_MODS);
    mods[(size_t)(l * 3 + rr) * 6144 + n0 + n] = s + p.in[I_ADAB][l * 6144 + n0 + n];
  }
  __syncthreads();
}

DI void conv_tile(CPR p, int t, char* smem) {
  const float* src = nullptr; size_t dsto = 0; int K = 0, N = 0, tt = -1;
  int rem = t;
#define JOB(SRC, DST, KK, NN) { int nt_ = ((KK) / 64) * (((NN) + 63) / 64); if (rem >= 0 && rem < nt_) { src = (SRC); dsto = (DST); K = (KK); N = (NN); tt = rem; } rem -= nt_; }
  JOB(p.in[I_NAQKV], W_NA_QKV, 1024, 3072)
  JOB(p.in[I_NAO], W_NA_O, 1024, 1024)
  JOB(p.in[I_GQKVG], W_GLA_QKVG, 1024, 3072)
  JOB(p.in[I_GG1], W_GLA_QKVG + 3072ull * 1024, 1024, 16)
  JOB(p.in[I_GG1] + 1024 * 16, W_GLA_QKVG + 3088ull * 1024, 1024, 16)
  JOB(p.in[I_GO], W_GLA_O, 1024, 1024)
  JOB(p.in[I_DQKV], W_DIFF_QKV, 1024, 3072)
  JOB(p.in[I_DO], W_DIFF_O, 1024, 1024)
  JOB(p.in[I_MDQ], W_MLA_DQKV, 1024, 384)
  JOB(p.in[I_MDKV], W_MLA_DQKV + 384ull * 1024, 1024, 288)
  JOB(p.in[I_MUQ], W_MLA_UQ, 384, 1536)
  JOB(p.in[I_MUKV], W_MLA_UKV, 256, 2048)
  JOB(p.in[I_MO], W_MLA_O, 1024, 1024)
  JOB(p.in[I_WUP] + 0ull * 1024 * 5632, W_UP + 0ull * 5632 * 1024, 1024, 5632)
  JOB(p.in[I_WUP] + 1ull * 1024 * 5632, W_UP + 1ull * 5632 * 1024, 1024, 5632)
  JOB(p.in[I_WUP] + 2ull * 1024 * 5632, W_UP + 2ull * 5632 * 1024, 1024, 5632)
  JOB(p.in[I_WUP] + 3ull * 1024 * 5632, W_UP + 3ull * 5632 * 1024, 1024, 5632)
  JOB(p.in[I_WDOWN] + 0ull * 2816 * 1024, W_DOWN + 0ull * 2816 * 1024, 2816, 1024)
  JOB(p.in[I_WDOWN] + 1ull * 2816 * 1024, W_DOWN + 1ull * 2816 * 1024, 2816, 1024)
  JOB(p.in[I_WDOWN] + 2ull * 2816 * 1024, W_DOWN + 2ull * 2816 * 1024, 2816, 1024)
  JOB(p.in[I_WDOWN] + 3ull * 2816 * 1024, W_DOWN + 3ull * 2816 * 1024, 2816, 1024)
#undef JOB
  if (tt < 0) return;
  const int tid = vtid();
  const int nnt = (N + 63) / 64;
  const int k0 = (tt / nnt) * 64, n0 = (tt % nnt) * 64;
  float* tl = (float*)smem;
#pragma unroll
  for (int i = 0; i < 4; ++i) {
    int id = tid + 256 * i, kr = id >> 4, c4 = id & 15;
    int n = n0 + c4 * 4;
    float4 v = make_float4(0.f, 0.f, 0.f, 0.f);
    if (n < N) v = *(const float4*)(src + (size_t)(k0 + kr) * N + n);
    tl[kr * 65 + c4 * 4 + 0] = v.x; tl[kr * 65 + c4 * 4 + 1] = v.y; tl[kr * 65 + c4 * 4 + 2] = v.z; tl[kr * 65 + c4 * 4 + 3] = v.w;
  }
  __syncthreads();
  bf16_t* dst = (bf16_t*)p.ws + dsto;
  const int n = tid & 63, kg = tid >> 6;
  if (n0 + n < N) {
#pragma unroll
    for (int g2 = 0; g2 < 2; ++g2) {
      int g = kg + 4 * g2;
      uint4 q;
      q.x = pack2(tl[(g * 8 + 0) * 65 + n], tl[(g * 8 + 1) * 65 + n]);
      q.y = pack2(tl[(g * 8 + 2) * 65 + n], tl[(g * 8 + 3) * 65 + n]);
      q.z = pack2(tl[(g * 8 + 4) * 65 + n], tl[(g * 8 + 5) * 65 + n]);
      q.w = pack2(tl[(g * 8 + 6) * 65 + n], tl[(g * 8 + 7) * 65 + n]);
      *(uint4*)(dst + (size_t)(n0 + n) * K + k0 + g * 8) = q;
    }
  }
  __syncthreads();
}
constexpr int CONV_TILES = 768 + 256 + 768 + 16 + 16 + 256 + 768 + 256 + 96 + 80 + 144 + 128 + 256 + 4 * 1408 + 4 * 704;

DI void phase0(CPR p, char* smem0) {
  char* smem = smem0 + (otid() >> 8) * 65536;
  for (int it = vbid(); it < 384 + 1024; it += nvb()) {
    if (it < 384) mods_item(p, it, smem);
    else conv_tile(p, it - 384, smem);
  }
}
DI void conv_ahead(CPR p, int l, char* smem0, int wg, int nwg) {
  char* smem = smem0 + (otid() >> 8) * 65536;
  const int vb = wg * 2 + (otid() >> 8), nv = nwg * 2;
  const int m0 = l == 0 ? 1024 : l == 1 ? 2080 : 3104, m1 = l == 0 ? 2080 : l == 1 ? 3104 : l == 2 ? 3808 : 3104;
  const int nm = m1 - m0;
  const int nmods = 0;
  const int total = nmods + 1408 + 704 + nm;
  for (int t0 = vb; t0 < total; t0 += nv) {
    if (t0 < nmods) { mods_item(p, 96 + t0, smem); continue; }
    const int t = t0 - nmods;
    int tile = t < 1408 ? 3808 + 1408 * l + t : (t < 2112 ? 9440 + 704 * l + (t - 1408) : m0 + (t - 2112));
    conv_tile(p, tile, smem);
  }
}

DI void norm_phase(CPR p, int l, int which, bool from_input, bool addp1) {
  const int lane = otid() & 63, wave = otid() >> 6;
  const float* g = p.in[which ? I_NFFN : I_NMIX] + l * 1024;
  const float* mods = (const float*)(p.ws + OFF_MODS);
  bf16_t* h = (bf16_t*)(p.ws + OFF_H);
  const int rpw = 8192 / ((int)gridDim.x * 8);
  const int row_begin = (rpw * (int)gridDim.x * 8 == 8192) ? (obid() * 8 + wave) * rpw : obid() * 8 + wave;
  const int row_end = (rpw * (int)gridDim.x * 8 == 8192) ? row_begin + rpw : 8192;
  const int row_step = (rpw * (int)gridDim.x * 8 == 8192) ? 1 : (int)gridDim.x * 8;
  for (int row = row_begin; row < row_end; row += row_step) {
    const float* x = from_input ? (row < 4096 ? p.in[I_XP] + (size_t)row * 1024 : p.in[I_XS] + (size_t)(row - 4096) * 1024) : p.out + (size_t)row * 1024;
    int mr = row < 4096 ? 0 : (row < 6144 ? 1 : 2);
    const float* md = mods + (size_t)(l * 3 + mr) * 6144 + which * 3072;
    float4 v[4];
    float ss = 0.f;
#pragma unroll
    for (int j = 0; j < 4; ++j) {
      v[j] = *(const float4*)(x + j * 256 + lane * 4);
      if (addp1) {
        const float4 q = *(const float4*)((const float*)(p.ws + OFF_BIG) + (size_t)row * 1024 + j * 256 + lane * 4);
        v[j].x += q.x; v[j].y += q.y; v[j].z += q.z; v[j].w += q.w;
        *(float4*)(p.out + (size_t)row * 1024 + j * 256 + lane * 4) = v[j];
      }
      ss += v[j].x * v[j].x + v[j].y * v[j].y + v[j].z * v[j].z + v[j].w * v[j].w;
    }
#pragma unroll
    for (int o = 32; o >= 1; o >>= 1) ss += __shfl_xor(ss, o);
    float rs = rsqrtf(ss * (1.f / 1024.f) + 1e-6f);
#pragma unroll
    for (int j = 0; j < 4; ++j) {
      int col = j * 256 + lane * 4;
      float4 gg = *(const float4*)(g + col), sh = *(const float4*)(md + col), scl = *(const float4*)(md + 1024 + col);
      float y0 = v[j].x * rs * gg.x * (1.f + scl.x) + sh.x;
      float y1 = v[j].y * rs * gg.y * (1.f + scl.y) + sh.y;
      float y2 = v[j].z * rs * gg.z * (1.f + scl.z) + sh.z;
      float y3 = v[j].w * rs * gg.w * (1.f + scl.w) + sh.w;
      uint2 q; q.x = pack2(y0, y1); q.y = pack2(y2, y3);
      *(uint2*)(h + (size_t)row * 1024 + col) = q;
    }
  }
}

DI void final_add_phase(CPR p) {
  const float* p1 = (const float*)(p.ws + OFF_BIG);
  for (int idx = gtid(); idx < 8192 * 256; idx += gthreads()) {
    float4 a = *(const float4*)(p.out + (size_t)idx * 4), b = *(const float4*)(p1 + (size_t)idx * 4);
    a.x += b.x; a.y += b.y; a.z += b.z; a.w += b.w;
    *(float4*)(p.out + (size_t)idx * 4) = a;
  }
}

DI void convgate_phase(CPR p, int l) {
  const bf16_t* u = (const bf16_t*)(p.ws + OFF_BIG);
  bf16_t* a = (bf16_t*)(p.ws + OFF_MIX);
  const float* cw = p.in[I_CONVW] + (size_t)l * 3 * 5632;
  const float* cb = p.in[I_CONVB] + (size_t)l * 5632;
  for (int idx = gtid(); idx < 1024 * 352; idx += gthreads()) {
    int rg = idx / 352, f = (idx % 352) * 8;
    int row0 = rg * 8;
    int T = row0 < 4096 ? 256 : 2048;
    int t0 = row0 < 4096 ? (row0 & 255) : ((row0 - 4096) & 2047);
    float w0g[8], w1g[8], w2g[8], bg[8], w0v[8], w1v[8], w2v[8], bv[8];
#pragma unroll
    for (int e2 = 0; e2 < 8; ++e2) {
      w0g[e2] = cw[f + e2]; w1g[e2] = cw[5632 + f + e2]; w2g[e2] = cw[2 * 5632 + f + e2]; bg[e2] = cb[f + e2];
      w0v[e2] = cw[2816 + f + e2]; w1v[e2] = cw[5632 + 2816 + f + e2]; w2v[e2] = cw[2 * 5632 + 2816 + f + e2]; bv[e2] = cb[2816 + f + e2];
    }
    const bf16_t* ur = u + (size_t)row0 * 5632 + f;
    float gp[8], vp[8], gc[8], vc[8], gn[8], vn[8];
    if (t0 > 0) { load_bf16_row<8>(ur - 5632, gp); load_bf16_row<8>(ur - 5632 + 2816, vp); }
    else {
#pragma unroll
      for (int e2 = 0; e2 < 8; ++e2) { gp[e2] = 0.f; vp[e2] = 0.f; }
    }
    load_bf16_row<8>(ur, gc); load_bf16_row<8>(ur + 2816, vc);
#pragma unroll
    for (int j = 0; j < 8; ++j) {
      if (t0 + j < T - 1) { load_bf16_row<8>(ur + (size_t)(j + 1) * 5632, gn); load_bf16_row<8>(ur + (size_t)(j + 1) * 5632 + 2816, vn); }
      else {
#pragma unroll
        for (int e2 = 0; e2 < 8; ++e2) { gn[e2] = 0.f; vn[e2] = 0.f; }
      }
      float res[8];
#pragma unroll
      for (int e2 = 0; e2 < 8; ++e2) {
        float gg = gp[e2] * w0g[e2] + gc[e2] * w1g[e2] + gn[e2] * w2g[e2] + bg[e2];
        float vv = vp[e2] * w0v[e2] + vc[e2] * w1v[e2] + vn[e2] * w2v[e2] + bv[e2];
        res[e2] = siluf(gg) * vv;
      }
      store_bf16_row<8>(a + (size_t)(row0 + j) * 2816 + f, res);
#pragma unroll
      for (int e2 = 0; e2 < 8; ++e2) { gp[e2] = gc[e2]; vp[e2] = vc[e2]; gc[e2] = gn[e2]; vc[e2] = vn[e2]; }
    }
  }
}

template <int DQK, int DV, class TileF, class ScoreF>
DI void flash_wave(const bf16_t* q0, int ntiles, float scale, TileF tilef, ScoreF scoref, f32x16 (&O)[DV / 32], float& m_run, float& l_run, int r, int hh) {
  constexpr int NK = DQK / 16, NV = DV / 32;
  bf16x8 qf[NK];
#pragma unroll
  for (int kk = 0; kk < NK; ++kk) qf[kk] = *(const bf16x8*)(q0 + (size_t)r * DQK + kk * 16 + hh * 8);
#pragma unroll
  for (int t = 0; t < NV; ++t)
#pragma unroll
    for (int i = 0; i < 16; ++i) O[t][i] = 0.f;
  m_run = 0.f;
  l_run = 0.f;
  constexpr bool PREFV = (DV <= 64);
  bf16x8 kc[NK], vc[2][NV];
  auto loadk = [&](int it, bf16x8 (&k)[NK]) {
    const bf16_t* kp; const bf16_t* vp; int vs;
    tilef(it, kp, vp, vs);
    const unsigned ko = (unsigned)r * DQK + hh * 8;
#pragma unroll
    for (int kk = 0; kk < NK; ++kk) k[kk] = *(const bf16x8*)(kp + (ko + kk * 16));
  };
  auto loadv = [&](int it, bf16x8 (&v)[2][NV]) {
    const bf16_t* kp; const bf16_t* vp; int vs;
    tilef(it, kp, vp, vs);
#pragma unroll
    for (int s2 = 0; s2 < 2; ++s2)
#pragma unroll
      for (int t = 0; t < NV; ++t) v[s2][t] = *(const bf16x8*)(vp + ((unsigned)r * (unsigned)vs + 8u * hh + (unsigned)(t * 32) * (unsigned)vs + 16u * s2));
  };
  loadk(0, kc);
  if (PREFV) loadv(0, vc);
  for (int it = 0; it < ntiles; ++it) {
    bf16x8 kn[NK], vn[2][NV];
    const int nx = min(it + 1, ntiles - 1);
    loadk(nx, kn);
    if (PREFV) loadv(nx, vn); else loadv(it, vc);
    f32x16 s;
#pragma unroll
    for (int i = 0; i < 16; ++i) s[i] = -m_run;
#pragma unroll
    for (int kk = 0; kk < NK; ++kk) s = MFMA32(kc[kk], qf[kk], s);
    float mx = -1e30f;
#pragma unroll
    for (int i = 0; i < 16; ++i) { float v = scoref(it, i, s[i]); s[i] = v; mx = fmaxf(mx, v); }
    if (__any(mx > 8.f)) {
      mx = fmaxf(mx, __shfl_xor(mx, 32));
      const float delta = fmaxf(mx, 0.f);
      const float alpha = __builtin_amdgcn_exp2f(-delta);
      m_run += delta;
      l_run *= alpha;
#pragma unroll
      for (int i = 0; i < 16; ++i) s[i] -= delta;
#pragma unroll
      for (int t = 0; t < NV; ++t)
#pragma unroll
        for (int i = 0; i < 16; ++i) O[t][i] *= alpha;
    }
    float sum = 0.f;
#pragma unroll
    for (int i = 0; i < 16; ++i) { float pv = __builtin_amdgcn_exp2f(s[i]); s[i] = pv; sum += pv; }
    l_run += sum;
#pragma unroll
    for (int s2 = 0; s2 < 2; ++s2) {
      union { uint4 q; bf16x8 v; } pb;
      pb.q.x = pack2(s[8 * s2 + 0], s[8 * s2 + 1]); pb.q.y = pack2(s[8 * s2 + 2], s[8 * s2 + 3]);
      pb.q.z = pack2(s[8 * s2 + 4], s[8 * s2 + 5]); pb.q.w = pack2(s[8 * s2 + 6], s[8 * s2 + 7]);
#pragma unroll
      for (int t = 0; t < NV; ++t) O[t] = MFMA32(vc[s2][t], pb.v, O[t]);
    }
#pragma unroll
    for (int kk = 0; kk < NK; ++kk) kc[kk] = kn[kk];
    if (PREFV) {
#pragma unroll
      for (int s2 = 0; s2 < 2; ++s2)
#pragma unroll
        for (int t = 0; t < NV; ++t) vc[s2][t] = vn[s2][t];
    }
  }
  l_run += __shfl_xor(l_run, 32);
}
template <int DQK, int DV, int NKS, bool PIPE>
DI void flash_block(const bf16_t* q0, int ntiles, float scale, const bf16_t* kb0, const bf16_t* kb1, const bf16_t* vb, int vs, char* lds, int ks,
                    f32x16 (&O)[DV / 32], float& m_run, float& l_run, int tid, int r, int hh) {
  constexpr int NK = DQK / 16, NV = DV / 32;
  constexpr int KROW = DQK * 2 + 16, VROW = 80;
  constexpr int KBYTES = NKS * 32 * KROW, STAGE = KBYTES + DV * VROW;
  constexpr int KCH = 32 * (DQK / 8), NKC = NKS * KCH, TOT = NKC + DV * 4, NJ = (TOT + 255) / 256;
  bf16x8 qf[NK];
#pragma unroll
  for (int kk = 0; kk < NK; ++kk) qf[kk] = *(const bf16x8*)(q0 + (size_t)r * DQK + kk * 16 + hh * 8);
#pragma unroll
  for (int t = 0; t < NV; ++t)
#pragma unroll
    for (int i = 0; i < 16; ++i) O[t][i] = 0.f;
  m_run = 0.f;
  l_run = 0.f;
  static_assert(NJ >= 3 && NJ <= 4, "loader written for 3 or 4 chunks per thread");
  const bf16_t *gp0, *gp1, *gp2, *gp3; int gi0, gi1, gi2, gi3, lo0, lo1, lo2, lo3;
  auto setup = [&](int j, const bf16_t*& gp, int& ginc, int& loff) __attribute__((always_inline)) {
    int c = tid + 256 * j;
    if (c >= TOT) c -= 256;
    if (c < NKC) {
      int s = c / KCH, rem = c % KCH, row = rem / (DQK / 8), c8 = rem % (DQK / 8);
      gp = (s == 0 ? kb0 : kb1) + (size_t)row * DQK + c8 * 8;
      ginc = 32 * DQK;
      loff = s * 32 * KROW + row * KROW + c8 * 16;
    } else {
      int c2 = c - NKC;
      int dv = c2 >> 2, q = c2 & 3;
      gp = vb + c2 * 8;
      ginc = DV * 32;
      loff = KBYTES + dv * VROW + q * 16;
    }
  };
  setup(0, gp0, gi0, lo0); setup(1, gp1, gi1, lo1); setup(2, gp2, gi2, lo2); setup(NJ > 3 ? 3 : 2, gp3, gi3, lo3);
  uint4 sa0, sa1, sa2, sa3, sb0, sb1, sb2, sb3;
#define gload(S, IT) do { S##0 = *(const uint4*)(gp0 + (size_t)(IT) * gi0); S##1 = *(const uint4*)(gp1 + (size_t)(IT) * gi1); S##2 = *(const uint4*)(gp2 + (size_t)(IT) * gi2); \
    if (NJ > 3) S##3 = *(const uint4*)(gp3 + (size_t)(IT) * gi3); } while (0)
#define swrite(S, SI) do { char* sd_ = lds + (SI) * STAGE; *(uint4*)(sd_ + lo0) = S##0; *(uint4*)(sd_ + lo1) = S##1; *(uint4*)(sd_ + lo2) = S##2; if (NJ > 3) *(uint4*)(sd_ + lo3) = S##3; } while (0)
  const int koff = ks * 32 * KROW + r * KROW + hh * 16;
  const int voff = KBYTES + r * VROW + hh * 16;
  int stg = 0;
  if constexpr (PIPE) {
    gload(sa, 0);
    gload(sb, min(1, ntiles - 1));
    __syncthreads();
    swrite(sa, 0);
    swrite(sb, 1);
    gload(sb, min(2, ntiles - 1));
    __syncthreads();
    f32x16 sn;
#pragma unroll
    for (int i = 0; i < 16; ++i) sn[i] = 0.f;
#pragma unroll
    for (int kk = 0; kk < NK; ++kk) { bf16x8 kf = *(const bf16x8*)(lds + koff + kk * 32); sn = MFMA32(kf, qf[kk], sn); }
#define FB_BODY_P(IT, SLOAD, SWRITE) do { \
      gload(SLOAD, min((IT) + 3, ntiles - 1)); \
      const char* sb = lds + stg * STAGE; \
      const int stg1 = (stg == 2) ? 0 : stg + 1; \
      const char* sbnx = lds + stg1 * STAGE; \
      f32x16 s = sn; \
      _Pragma("unroll") for (int i = 0; i < 16; ++i) sn[i] = -m_run; \
      _Pragma("unroll") for (int kk = 0; kk < NK; ++kk) { bf16x8 kf = *(const bf16x8*)(sbnx + koff + kk * 32); sn = MFMA32(kf, qf[kk], sn); } \
      float mx = -1e30f; \
      _Pragma("unroll") for (int i = 0; i < 16; ++i) mx = fmaxf(mx, s[i]); \
      if (__any(mx > 8.f)) { \
        mx = fmaxf(mx, __shfl_xor(mx, 32)); \
        const float delta = fmaxf(mx, 0.f); \
        const float alpha = __builtin_amdgcn_exp2f(-delta); \
        m_run += delta; \
        l_run *= alpha; \
        _Pragma("unroll") for (int i = 0; i < 16; ++i) { s[i] -= delta; sn[i] -= delta; } \
        _Pragma("unroll") for (int t = 0; t < NV; ++t) _Pragma("unroll") for (int i = 0; i < 16; ++i) O[t][i] *= alpha; \
      } \
      float sum = 0.f; \
      _Pragma("unroll") for (int i = 0; i < 16; ++i) { float pv = __builtin_amdgcn_exp2f(s[i]); s[i] = pv; sum += pv; } \
      l_run += sum; \
      _Pragma("unroll") for (int s2 = 0; s2 < 2; ++s2) { \
        union { uint4 q; bf16x8 v; } pb; \
        pb.q.x = pack2(s[8 * s2 + 0], s[8 * s2 + 1]); pb.q.y = pack2(s[8 * s2 + 2], s[8 * s2 + 3]); \
        pb.q.z = pack2(s[8 * s2 + 4], s[8 * s2 + 5]); pb.q.w = pack2(s[8 * s2 + 6], s[8 * s2 + 7]); \
        _Pragma("unroll") for (int t = 0; t < NV; ++t) { bf16x8 vf = *(const bf16x8*)(sb + voff + t * 32 * VROW + s2 * 32); O[t] = MFMA32(vf, pb.v, O[t]); } \
      } \
      swrite(SWRITE, (stg1 == 2) ? 0 : stg1 + 1); \
      stg = stg1; \
      __syncthreads(); \
    } while (0)
    for (int it = 0; it < ntiles; it += 2) {
      FB_BODY_P(it, sa, sb);
      FB_BODY_P(it + 1, sb, sa);
    }
#undef FB_BODY_P
    l_run += __shfl_xor(l_run, 32);
    return;
  }
  gload(sa, 0);
  gload(sb, 1);
  __syncthreads();
  swrite(sa, 0);
  __syncthreads();
#define FB_BODY(IT, SLOAD, SWRITE) do { \
    gload(SLOAD, min((IT) + 2, ntiles - 1)); \
    const char* sb = lds + stg * STAGE; \
    f32x16 s; \
    _Pragma("unroll") for (int i = 0; i < 16; ++i) s[i] = -m_run; \
    _Pragma("unroll") for (int kk = 0; kk < NK; ++kk) { bf16x8 kf = *(const bf16x8*)(sb + koff + kk * 32); s = MFMA32(kf, qf[kk], s); } \
    float mx = -1e30f; \
    _Pragma("unroll") for (int i = 0; i < 16; ++i) mx = fmaxf(mx, s[i]); \
    if (__any(mx > 8.f)) { \
      mx = fmaxf(mx, __shfl_xor(mx, 32)); \
      const float delta = fmaxf(mx, 0.f); \
      const float alpha = __builtin_amdgcn_exp2f(-delta); \
      m_run += delta; \
      l_run *= alpha; \
      _Pragma("unroll") for (int i = 0; i < 16; ++i) s[i] -= delta; \
      _Pragma("unroll") for (int t = 0; t < NV; ++t) _Pragma("unroll") for (int i = 0; i < 16; ++i) O[t][i] *= alpha; \
    } \
    float sum = 0.f; \
    _Pragma("unroll") for (int i = 0; i < 16; ++i) { float pv = __builtin_amdgcn_exp2f(s[i]); s[i] = pv; sum += pv; } \
    l_run += sum; \
    _Pragma("unroll") for (int s2 = 0; s2 < 2; ++s2) { \
      union { uint4 q; bf16x8 v; } pb; \
      pb.q.x = pack2(s[8 * s2 + 0], s[8 * s2 + 1]); pb.q.y = pack2(s[8 * s2 + 2], s[8 * s2 + 3]); \
      pb.q.z = pack2(s[8 * s2 + 4], s[8 * s2 + 5]); pb.q.w = pack2(s[8 * s2 + 6], s[8 * s2 + 7]); \
      _Pragma("unroll") for (int t = 0; t < NV; ++t) { bf16x8 vf = *(const bf16x8*)(sb + voff + t * 32 * VROW + s2 * 32); O[t] = MFMA32(vf, pb.v, O[t]); } \
    } \
    stg = (stg == 2) ? 0 : stg + 1; \
    swrite(SWRITE, stg); \
    __syncthreads(); \
  } while (0)
  for (int it = 0; it < ntiles; it += 2) {
    FB_BODY(it, sa, sb);
    FB_BODY(it + 1, sb, sa);
  }
#undef FB_BODY
  l_run += __shfl_xor(l_run, 32);
}
#undef gload
#undef swrite
template <int NT> DI void store_o(bf16_t* o, int ldo, f32x16 (&O)[NT], float linv, int r, int hh) {
#pragma unroll
  for (int t = 0; t < NT; ++t)
#pragma unroll
    for (int ig = 0; ig < 4; ++ig) {
      uint2 q;
      q.x = pack2(O[t][ig * 4 + 0] * linv, O[t][ig * 4 + 1] * linv);
      q.y = pack2(O[t][ig * 4 + 2] * linv, O[t][ig * 4 + 3] * linv);
      *(uint2*)(o + (size_t)r * ldo + t * 32 + 8 * ig + 4 * hh) = q;
    }
}

template <bool ROPE> DI void headnorm8(float (&v)[8], const float* g, int sub, float extra, int t) {
  float ss = 0.f;
#pragma unroll
  for (int e = 0; e < 8; ++e) ss += v[e] * v[e];
  ss += __shfl_xor(ss, 1); ss += __shfl_xor(ss, 2); ss += __shfl_xor(ss, 4);
  const float rs = rsqrtf(ss * (1.f / 64.f) + 1e-6f) * extra;
  const float4 g0 = *(const float4*)(g + sub * 8), g1 = *(const float4*)(g + sub * 8 + 4);
  v[0] *= rs * g0.x; v[1] *= rs * g0.y; v[2] *= rs * g0.z; v[3] *= rs * g0.w;
  v[4] *= rs * g1.x; v[5] *= rs * g1.y; v[6] *= rs * g1.z; v[7] *= rs * g1.w;
  if (ROPE) {
    const float pos = (sub & 4) ? (float)(t & 63) : (float)(t >> 6);
    const bool second = (sub >> 1) & 1;
#pragma unroll
    for (int e = 0; e < 8; ++e) {
      const float other = __shfl_xor(v[e], 2);
      const int f = (sub & 1) * 8 + e;
      const float ang = pos * exp2f(-(float)f * (13.287712379549449f / 16.f));
      const float c = __cosf(ang), s = __sinf(ang);
      v[e] = second ? (other * s + v[e] * c) : (v[e] * c - other * s);
    }
  }
}

constexpr size_t L0_QB = 0, L0_KB = 16 * MB, L0_VT = 32 * MB, L0_KC = 48 * MB, L0_VCT = 49 * MB;
DI void prep0_phase(CPR p) {
  const bf16_t* big = (const bf16_t*)(p.ws + OFF_BIG);
  char* mix = p.ws + OFF_MIX;
  bf16_t* qb = (bf16_t*)(mix + L0_QB); bf16_t* kb = (bf16_t*)(mix + L0_KB); bf16_t* vT = (bf16_t*)(mix + L0_VT);
  bf16_t* kc = (bf16_t*)(mix + L0_KC); bf16_t* vcT = (bf16_t*)(mix + L0_VCT);
  for (int idx = gtid(); idx < 2 * 8192 * 16 * 8; idx += gthreads()) {
    int sub = idx & 7, hd = (idx >> 3) & 15, row = (idx >> 7) & 8191, which = idx >> 20;
    float v[8];
    load_bf16_row<8>(big + (size_t)row * 3072 + which * 1024 + hd * 64 + sub * 8, v);
    headnorm8<false>(v, p.in[which ? I_NAKN : I_NAQN], sub, which ? 1.f : 0.125f * 1.4426950408889634f, 0);
    store_bf16_row<8>((which ? kb : qb) + ((size_t)hd * 8192 + row) * 64 + sub * 8, v);
    if (which && row < 4096) store_f32_row<8>(p.out + O_L0K + (((size_t)(row >> 8) * 16 + hd) * 256 + (row & 255)) * 64 + sub * 8, v);
  }
  for (int idx = gtid(); idx < 4096 * 128; idx += gthreads()) {
    int row = idx >> 7, c = (idx & 127) * 8;
    float v[8];
    load_bf16_row<8>(big + (size_t)row * 3072 + 2048 + c, v);
    int hd = c >> 6, d = c & 63;
    store_f32_row<8>(p.out + O_L0V + (((size_t)(row >> 8) * 16 + hd) * 256 + (row & 255)) * 64 + d, v);
  }
  transpose_gen<true>(1024, 8192, vT, 8192, [&](int rr, int c) { return big[(size_t)rr * 3072 + 2048 + c]; });
  const float* ck = p.in[I_C0K]; const float* cv = p.in[I_C0V];
  for (int idx = gtid(); idx < 2 * 16 * 256 * 64 / 8; idx += gthreads()) {
    float v[8];
#pragma unroll
    for (int e = 0; e < 8; ++e) v[e] = ck[(size_t)idx * 8 + e];
    store_bf16_row<8>(kc + (size_t)idx * 8, v);
  }
  transpose_gen<true>(2048, 256, vcT, 256, [&](int l_, int c) { return f2bf(cv[((size_t)(c >> 6) * 256 + l_) * 64 + (c & 63)]); });
}

DI void attn0_phase(CPR p, char* smem0) {
  char* smem = smem0 + (otid() >> 8) * 65536;
  const int tid = vtid(), lane = tid & 63, wave = tid >> 6, r = lane & 31, hh = lane >> 5;
  char* mix = p.ws + OFF_MIX;
  const bf16_t* qb = (const bf16_t*)(mix + L0_QB); const bf16_t* kb = (const bf16_t*)(mix + L0_KB); const bf16_t* vT = (const bf16_t*)(mix + L0_VT);
  const bf16_t* kc = (const bf16_t*)(mix + L0_KC); const bf16_t* vcT = (const bf16_t*)(mix + L0_VCT);
  bf16_t* o = (bf16_t*)(p.ws + OFF_O);
  float* sbias = (float*)smem;
  for (int it = vbid(); it < 1024; it += nvb()) {
    f32x16 O[2];
    float m_run, l_run;
    if (it < 512) {
      int b = it >> 8, hd = (it >> 4) & 15, blk = it & 15;
      __syncthreads();
      for (int i = tid; i < 465; i += 256) sbias[i] = p.in[I_NABIAS][hd * 465 + i] * 1.4426950408889634f;
      __syncthreads();
      int gr = blk * 2 + (wave >> 1), cq0 = (wave & 1) * 32;
      int grow_q = 4096 + b * 2048 + gr * 64 + cq0;
      int kr0 = min(max(gr - 4, 0), 24);
      int qc = cq0 + r;
      int win0 = min(max(qc - 8, 0), 48);
      const bf16_t* kcb = kc + (size_t)(b * 16 + hd) * 256 * 64;
      const bf16_t* vcb = vcT + (size_t)(b * 16 + hd) * 64 * 256;
      const bf16_t* kbb = kb + ((size_t)hd * 8192 + 4096 + b * 2048) * 64;
      const bf16_t* vtb = vT + (size_t)hd * 64 * 8192 + 4096 + b * 2048;
      flash_wave<64, 64>(qb + ((size_t)hd * 8192 + grow_q) * 64, 24, 0.125f * 1.4426950408889634f,
        [&](int ti, const bf16_t*& kp, const bf16_t*& vp, int& vs) {
          if (ti < 8) { kp = kcb + ti * 32 * 64; vp = vcb + ti * 32; vs = 256; }
          else { int lt = ti - 8; int tok = (kr0 + (lt >> 1)) * 64 + (lt & 1) * 32; kp = kbb + (size_t)tok * 64; vp = vtb + tok; vs = 8192; }
        },
        [&](int ti, int i, float s) {
          if (ti < 8) return s;
          int lt = ti - 8;
          int kcol = (lt & 1) * 32 + crow(i, hh);
          int roff = kr0 + (lt >> 1) - gr + 7;
          int coff = min(max(kcol - qc + 15, 0), 30);
          bool valid = (kcol >= win0) && (kcol < win0 + 16);
          return valid ? s + sbias[roff * 31 + coff] : -1e30f;
        },
        O, m_run, l_run, r, hh);
      store_o<2>(o + (size_t)grow_q * 1024 + hd * 64, 1024, O, 1.f / l_run, r, hh);
    } else {
      int pi = it - 512;
      int b = pi >> 5, hd = (pi >> 1) & 15, qbk = pi & 1;
      int grow_q = b * 256 + qbk * 128 + wave * 32;
      const bf16_t* kbb = kb + ((size_t)hd * 8192 + b * 256) * 64;
      const bf16_t* vtb = vT + (size_t)hd * 64 * 8192 + b * 256;
      flash_wave<64, 64>(qb + ((size_t)hd * 8192 + grow_q) * 64, 8, 0.125f * 1.4426950408889634f,
        [&](int ti, const bf16_t*& kp, const bf16_t*& vp, int& vs) { kp = kbb + ti * 32 * 64; vp = vtb + ti * 32; vs = 8192; },
        [&](int, int, float s) { return s; }, O, m_run, l_run, r, hh);
      store_o<2>(o + (size_t)grow_q * 1024 + hd * 64, 1024, O, 1.f / l_run, r, hh);
    }
  }
}

constexpr size_t L1_QE = 0, L1_KE = 16 * MB, L1_KDT = 32 * MB, L1_VT = 48 * MB, L1_DTOT = 64 * MB;
constexpr size_t L1_ODIR = 8192ull * 3328 * 2;
DI void prep1_phase(CPR p, char* smem0) {
  char* smem = smem0 + (otid() >> 8) * 65536;
  const int tid = vtid();
  const bf16_t* big = (const bf16_t*)(p.ws + OFF_BIG);
  char* mix = p.ws + OFF_MIX;
  bf16_t* qe = (bf16_t*)(mix + L1_QE); bf16_t* ke = (bf16_t*)(mix + L1_KE); bf16_t* kdT = (bf16_t*)(mix + L1_KDT);
  bf16_t* vT = (bf16_t*)(mix + L1_VT); float* dtot = (float*)(mix + L1_DTOT);
  float* rr = (float*)smem;
  bf16_t* qs = (bf16_t*)(smem + 8192);
  bf16_t* ks = (bf16_t*)(smem + 8192 + 16384);
  for (int it = vbid(); it < 128 * 4; it += nvb()) {
    int ch = it >> 2, hd = it & 3;
    int grow0 = ch * 64;
    __syncthreads();
    for (int i = tid; i < 64 * 32; i += 256) rr[i] = bf2f(big[(size_t)(grow0 + (i >> 5)) * 3328 + 3072 + (i & 31)]);
#pragma unroll
    for (int j = 0; j < 4; ++j) {
      int c = tid + 256 * j, row = c >> 4, pc = c & 15;
      *(uint4*)(qs + row * 128 + pc * 8) = *(const uint4*)(big + (size_t)(grow0 + row) * 3328 + hd * 128 + pc * 8);
      *(uint4*)(ks + row * 128 + pc * 8) = *(const uint4*)(big + (size_t)(grow0 + row) * 3328 + 512 + hd * 128 + pc * 8);
    }
    __syncthreads();
    int dir = tid >> 7, k = tid & 127;
    float w2[16];
#pragma unroll
    for (int j = 0; j < 16; ++j) w2[j] = p.in[I_GG2][((size_t)dir * 16 + j) * 512 + hd * 128 + k];
    float bg = p.in[I_GBG][dir * 512 + hd * 128 + k];
    float lgv[64];
    float btot = 0.f;
#pragma unroll
    for (int t = 0; t < 64; ++t) {
      float x = bg;
      const float4* r4 = (const float4*)(rr + t * 32 + dir * 16);
#pragma unroll
      for (int j4 = 0; j4 < 4; ++j4) { float4 rv = r4[j4]; x += rv.x * w2[j4 * 4] + rv.y * w2[j4 * 4 + 1] + rv.z * w2[j4 * 4 + 2] + rv.w * w2[j4 * 4 + 3]; }
      float ls = fminf(x, 0.f) - __logf(1.f + __expf(-fabsf(x)));
      lgv[t] = ls * (1.f / 16.f);
      btot += lgv[t];
    }
    float bc = 0.f;
    size_t dbase = ((size_t)dir * 4 + hd) * 8192;
    bf16_t* kdt_row = kdT + ((((size_t)dir * 4 + hd) * 128 + ch) * 128 + k) * 64;
#pragma unroll
    for (int tt = 0; tt < 64; ++tt) {
      const int tf = tt, tb = 63 - tt;
      bc += dir ? lgv[tb] : lgv[tf];
      const int t = dir ? tb : tf;
      float qv = bf2f(qs[t * 128 + k]);
      float kv = bf2f(ks[t * 128 + k]);
      qe[(dbase + grow0 + t) * 128 + k] = f2bf(qv * 0.08838834764831845f * __expf(bc));
      ke[(dbase + grow0 + t) * 128 + k] = f2bf(kv * __expf(-bc));
      kdt_row[t] = f2bf(kv * __expf(btot - bc));
    }
    dtot[(((size_t)dir * 4 + hd) * 128 + ch) * 128 + k] = __expf(btot);
  }
  transpose_gen<false>(1024, 8192, vT, 8192, [&](int r_, int c) { return big[(size_t)r_ * 3328 + 1024 + c]; });
}

DI void scan1_phase(CPR p, char* smem0) {
  char* smem = smem0 + (otid() >> 8) * 65536;
  const int tid = vtid(), lane = tid & 63, wave = tid >> 6, r = lane & 31, hh = lane >> 5;
  char* mix = p.ws + OFF_MIX;
  const bf16_t* qe = (const bf16_t*)(mix + L1_QE); const bf16_t* ke = (const bf16_t*)(mix + L1_KE); const bf16_t* kdT = (const bf16_t*)(mix + L1_KDT);
  const bf16_t* vT = (const bf16_t*)(mix + L1_VT); const float* dtot = (const float*)(mix + L1_DTOT);
  bf16_t* odir = (bf16_t*)(p.ws + OFF_BIG + L1_ODIR);
  bf16_t* St = (bf16_t*)smem;
  bf16_t* al = (bf16_t*)(smem + 8704);
  char* vls = smem + 17920;
  float* dts = (float*)(smem + 27136);
  char* qes = smem + 28160;
  char* kes = smem + 45568;
  const int wg_ = obid(), half_ = otid() >> 8, nwg_ = (int)gridDim.x;
  const bool spread = nwg_ >= 256;
  int it0, itstep, nsync_target = 0;
  if (spread) {
    if (wg_ < 128 && half_ == 0) { it0 = wg_; itstep = 1 << 20; }
    else {
      const int lam = wg_ < 128 ? wg_ : 128 + 2 * (wg_ - 128) + half_;
      it0 = 128 + lam; itstep = 128 + 2 * (nwg_ - 128);
    }
    if (wg_ < 128) nsync_target = 1 + 3 * 32;
  } else { it0 = vbid(); itstep = nvb(); }
  int nsync_done = 0;
  for (int it = it0; it < 1152; it += itstep) {
    bool samp = it < 128;
    int q_ = samp ? it : it - 128;
    int b = q_ >> 6, hd = (q_ >> 4) & 3, dir = (q_ >> 3) & 1, vsl = q_ & 7;
    int grow0 = samp ? 4096 + b * 2048 : b * 256;
    int nc = samp ? 32 : 4;
    const int ti = wave >> 1, xi = wave & 1;
    f32x16 S;
    if (samp) {
      const float* s0 = p.in[dir ? I_SB : I_SF] + ((size_t)(b * 4 + hd) * 128) * 256;
#pragma unroll
      for (int i = 0; i < 16; ++i) S[i] = s0[(size_t)(wave * 32 + crow(i, hh)) * 256 + vsl * 32 + r];
    } else {
#pragma unroll
      for (int i = 0; i < 16; ++i) S[i] = 0.f;
    }
    auto write_St = [&]() {
#pragma unroll
      for (int ig = 0; ig < 4; ++ig) {
        uint2 q;
        q.x = pack2(S[ig * 4 + 0], S[ig * 4 + 1]);
        q.y = pack2(S[ig * 4 + 2], S[ig * 4 + 3]);
        *(uint2*)(St + r * 136 + wave * 32 + 8 * ig + 4 * hh) = q;
      }
    };
    const size_t dbase = ((size_t)dir * 4 + hd) * 8192;
    const bf16_t* vsrc = vT + ((size_t)hd * 256 + vsl * 32 + (tid >> 3)) * 8192 + (tid & 7) * 8;
    const int vdst = (tid >> 3) * 144 + (tid & 7) * 16;
    const float* dsrc = dtot + (((size_t)dir * 4 + hd) * 128) * 128 + (tid & 127);
    const bf16_t* qsrc = qe + dbase * 128 + tid * 8;
    const bf16_t* ksrc = ke + dbase * 128 + tid * 8;
    const int tdst = (tid >> 4) * 272 + (tid & 15) * 16;
    bf16x8 kd[4], kdN[4];
    uint4 vst, qst0, qst1, qst2, qst3, kst0, kst1, kst2, kst3; float dtst;
#define SC_GROW(CC) (grow0 + ((dir ? nc - 1 - (CC) : (CC)) << 6))
#define SC_LOADKD(CC, KD) do { const bf16_t* kd_p = kdT + ((((size_t)dir * 4 + hd) * 128 + (SC_GROW(CC) >> 6)) * 128 + wave * 32 + r) * 64 + hh * 8; \
      _Pragma("unroll") for (int kk = 0; kk < 4; ++kk) KD[kk] = *(const bf16x8*)(kd_p + kk * 16); } while (0)
#define SC_LOADST(CC) do { const int g_ = SC_GROW(CC); vst = *(const uint4*)(vsrc + g_); dtst = dsrc[(size_t)(g_ >> 6) * 128]; \
      const bf16_t* q_p = qsrc + (size_t)g_ * 128; const bf16_t* k_p = ksrc + (size_t)g_ * 128; \
      qst0 = *(const uint4*)(q_p); qst1 = *(const uint4*)(q_p + 2048); qst2 = *(const uint4*)(q_p + 4096); qst3 = *(const uint4*)(q_p + 6144); \
      kst0 = *(const uint4*)(k_p); kst1 = *(const uint4*)(k_p + 2048); kst2 = *(const uint4*)(k_p + 4096); kst3 = *(const uint4*)(k_p + 6144); } while (0)
#define SC_WRITEST(BUF) do { *(uint4*)(vls + (BUF) * 4608 + vdst) = vst; if (tid < 128) dts[(BUF) * 128 + tid] = dtst; \
      *(uint4*)(qes + tdst) = qst0; *(uint4*)(qes + tdst + 16 * 272) = qst1; *(uint4*)(qes + tdst + 32 * 272) = qst2; *(uint4*)(qes + tdst + 48 * 272) = qst3; \
      *(uint4*)(kes + tdst) = kst0; *(uint4*)(kes + tdst + 16 * 272) = kst1; *(uint4*)(kes + tdst + 32 * 272) = kst2; *(uint4*)(kes + tdst + 48 * 272) = kst3; } while (0)
    SC_LOADST(0);
    SC_LOADKD(0, kd);
    __syncthreads();
    write_St();
    SC_WRITEST(0);
    for (int cc = 0; cc < nc; ++cc) {
      const int ccn = min(cc + 1, nc - 1);
      const int growc = SC_GROW(cc);
      const char* vcur = vls + (cc & 1) * 4608;
      const float* dcur = dts + (cc & 1) * 128;
      SC_LOADST(ccn);
      SC_LOADKD(ccn, kdN);
      __syncthreads();
      bf16x8 qf[8];
      f32x16 acc;
#pragma unroll
      for (int i = 0; i < 16; ++i) acc[i] = 0.f;
#pragma unroll
      for (int kk = 0; kk < 8; ++kk) {
        qf[kk] = *(const bf16x8*)(qes + (ti * 32 + r) * 272 + kk * 32 + hh * 16);
        bf16x8 kf = *(const bf16x8*)(kes + (xi * 32 + r) * 272 + kk * 32 + hh * 16);
        acc = MFMA32(kf, qf[kk], acc);
      }
#pragma unroll
      for (int ig = 0; ig < 4; ++ig) {
        const int t = ti * 32 + r, s0 = xi * 32 + 8 * ig + 4 * hh;
        float e0 = acc[ig * 4 + 0], e1 = acc[ig * 4 + 1], e2 = acc[ig * 4 + 2], e3 = acc[ig * 4 + 3];
        e0 = (dir ? (s0 + 0 >= t) : (s0 + 0 <= t)) ? e0 : 0.f;
        e1 = (dir ? (s0 + 1 >= t) : (s0 + 1 <= t)) ? e1 : 0.f;
        e2 = (dir ? (s0 + 2 >= t) : (s0 + 2 <= t)) ? e2 : 0.f;
        e3 = (dir ? (s0 + 3 >= t) : (s0 + 3 <= t)) ? e3 : 0.f;
        uint2 q; q.x = pack2(e0, e1); q.y = pack2(e2, e3);
        *(uint2*)(al + t * 72 + s0) = q;
      }
      __syncthreads();
      if (xi == 0) {
#pragma unroll
        for (int i = 0; i < 16; ++i) acc[i] = 0.f;
#pragma unroll
        for (int kk = 0; kk < 8; ++kk) {
          bf16x8 sf = *(const bf16x8*)(St + r * 136 + kk * 16 + hh * 8);
          acc = MFMA32(sf, qf[kk], acc);
        }
#pragma unroll
        for (int kk = 0; kk < 4; ++kk) {
          bf16x8 af = *(const bf16x8*)(al + (ti * 32 + r) * 72 + kk * 16 + hh * 8);
          bf16x8 vf = *(const bf16x8*)(vcur + r * 144 + kk * 32 + hh * 16);
          acc = MFMA32(vf, af, acc);
        }
        bf16_t* orow = odir + ((size_t)dir * 8192 + growc + ti * 32 + r) * 1024 + hd * 256 + vsl * 32 + 4 * hh;
#pragma unroll
        for (int ig = 0; ig < 4; ++ig) {
          uint2 q; q.x = pack2(acc[ig * 4 + 0], acc[ig * 4 + 1]); q.y = pack2(acc[ig * 4 + 2], acc[ig * 4 + 3]);
          *(uint2*)(orow + 8 * ig) = q;
        }
      }
#pragma unroll
      for (int i = 0; i < 16; ++i) S[i] *= dcur[wave * 32 + crow(i, hh)];
#pragma unroll
      for (int kk = 0; kk < 4; ++kk) {
        bf16x8 vf = *(const bf16x8*)(vcur + r * 144 + kk * 32 + hh * 16);
        S = MFMA32(kd[kk], vf, S);
      }
      __syncthreads();
      write_St();
      SC_WRITEST((cc + 1) & 1);
#pragma unroll
      for (int kk = 0; kk < 4; ++kk) kd[kk] = kdN[kk];
    }
#undef SC_GROW
#undef SC_LOADKD
#undef SC_LOADST
#undef SC_WRITEST
    nsync_done += 1 + 3 * nc;
    if (!samp) {
      const int t2 = vtid(), r2 = t2 & 31, h2 = (t2 >> 5) & 1, w2 = t2 >> 6;
      float* so = p.out + (dir ? O_L1B : O_L1F) + ((size_t)(b * 4 + hd) * 128) * 256 + (size_t)(w2 * 32 + 4 * h2) * 256 + vsl * 32 + r2;
#pragma unroll
      for (int i = 0; i < 16; ++i) so[((i & 3) + 8 * (i >> 2)) * 256] = S[i];
    }
  }
  for (; nsync_done < nsync_target; ++nsync_done) __syncthreads();
}

DI void gla_out_phase(CPR p) {
  const bf16_t* big = (const bf16_t*)(p.ws + OFF_BIG);
  const bf16_t* odir = (const bf16_t*)(p.ws + OFF_BIG + L1_ODIR);
  bf16_t* o = (bf16_t*)(p.ws + OFF_O);
  const float* gn = p.in[I_GON];
  for (int idx = gtid(); idx < 8192 * 4 * 32; idx += gthreads()) {
    int sub = idx & 31, hd = (idx >> 5) & 3, row = idx >> 7;
    int col = hd * 256 + sub * 8;
    float a[8], b2[8], g[8];
    load_bf16_row<8>(odir + (size_t)row * 1024 + col, a);
    load_bf16_row<8>(odir + ((size_t)8192 + row) * 1024 + col, b2);
    load_bf16_row<8>(big + (size_t)row * 3328 + 2048 + col, g);
    float ss = 0.f;
#pragma unroll
    for (int e = 0; e < 8; ++e) { a[e] += b2[e]; ss += a[e] * a[e]; }
#pragma unroll
    for (int ofs = 16; ofs >= 1; ofs >>= 1) ss += __shfl_xor(ss, ofs);
    float rs = rsqrtf(ss * (1.f / 256.f) + 1e-6f);
#pragma unroll
    for (int e = 0; e < 8; ++e) a[e] = a[e] * rs * gn[sub * 8 + e] * siluf(g[e]);
    store_bf16_row<8>(o + (size_t)row * 1024 + col, a);
  }
}

constexpr size_t L2_QD = 0, L2_KDP = 16 * MB, L2_KDS = 24 * MB, L2_VTP = 34 * MB, L2_VTS = 42 * MB;
DI void prep2_phase(CPR p) {
  const bf16_t* big = (const bf16_t*)(p.ws + OFF_BIG);
  char* mix = p.ws + OFF_MIX;
  bf16_t* qd = (bf16_t*)(mix + L2_QD); bf16_t* kdp = (bf16_t*)(mix + L2_KDP); bf16_t* kds = (bf16_t*)(mix + L2_KDS);
  bf16_t* vtp = (bf16_t*)(mix + L2_VTP); bf16_t* vts = (bf16_t*)(mix + L2_VTS);
  for (int idx = gtid(); idx < 2 * 8192 * 16 * 8; idx += gthreads()) {
    int sub = idx & 7, hd = (idx >> 3) & 15, row = (idx >> 7) & 8191, which = idx >> 20;
    float v[8];
    load_bf16_row<8>(big + (size_t)row * 3072 + which * 1024 + hd * 64 + sub * 8, v);
    const float extra = which ? 1.f : 0.125f * 1.4426950408889634f;
    if (row >= 4096) headnorm8<true>(v, p.in[which ? I_DKN : I_DQN], sub, extra, (row - 4096) & 2047);
    else headnorm8<false>(v, p.in[which ? I_DKN : I_DQN], sub, extra, 0);
    if (!which) store_bf16_row<8>(qd + ((size_t)hd * 8192 + row) * 64 + sub * 8, v);
    else if (row < 4096) {
      store_bf16_row<8>(kdp + ((size_t)hd * 4096 + row) * 64 + sub * 8, v);
      store_f32_row<8>(p.out + O_L2K + (((size_t)(row >> 8) * 16 + hd) * 256 + (row & 255)) * 64 + sub * 8, v);
    } else {
      int b = (row - 4096) >> 11, t = (row - 4096) & 2047;
      store_bf16_row<8>(kds + (((size_t)b * 16 + hd) * 2304 + 256 + t) * 64 + sub * 8, v);
    }
  }
  for (int idx = gtid(); idx < 4096 * 128; idx += gthreads()) {
    int row = idx >> 7, c = (idx & 127) * 8;
    float v[8];
    load_bf16_row<8>(big + (size_t)row * 3072 + 2048 + c, v);
    int hd = c >> 7, d = c & 127;
    store_f32_row<8>(p.out + O_L2V + (((size_t)(row >> 8) * 8 + hd) * 256 + (row & 255)) * 128 + d, v);
  }
  transpose_gen<true, 128>(1024, 4096, vtp, (size_t)128 * 4096, [&](int r_, int c) { return big[(size_t)r_ * 3072 + 2048 + c]; }, 0);
  for (int b = 0; b < 2; ++b)
    transpose_gen<true, 128>(1024, 2048, vts + (size_t)b * 1024 * 2304, (size_t)128 * 2304, [&](int r_, int c) { return big[(size_t)(4096 + b * 2048 + r_) * 3072 + 2048 + c]; }, 256);
  const float* ck = p.in[I_C2K]; const float* cv = p.in[I_C2V];
  for (int idx = gtid(); idx < 2 * 16 * 256 * 8; idx += gthreads()) {
    int bh = idx >> 11, rem = idx & 2047;
    float v[8];
#pragma unroll
    for (int e = 0; e < 8; ++e) v[e] = ck[(size_t)idx * 8 + e];
    store_bf16_row<8>(kds + (size_t)bh * 2304 * 64 + (size_t)rem * 8, v);
  }
  transpose_gen<true, 128>(2048, 256, vts, (size_t)128 * 2304, [&](int l_, int c) { return f2bf(cv[((size_t)(c >> 7) * 256 + l_) * 128 + (c & 127)]); }, 0);
}

DI void attn2_phase(CPR p, char* smem0) {
  char* smem = smem0 + (otid() >> 8) * 65536;
  const int tid = vtid(), lane = tid & 63, wave = tid >> 6, r = lane & 31, hh = lane >> 5;
  float* xch = (float*)smem;
  float lam;
  {
    const float* dl = p.in[I_DLAM];
    float a = dl[lane] * dl[64 + lane], b2 = dl[128 + lane] * dl[192 + lane];
#pragma unroll
    for (int ofs = 32; ofs >= 1; ofs >>= 1) { a += __shfl_xor(a, ofs); b2 += __shfl_xor(b2, ofs); }
    lam = __expf(a) - __expf(b2) + 0.47071301834435835f;
  }
  const int qs = wave >> 1, comp = wave & 1;
  for (int it = vbid(); it < 1024; it += nvb()) {
    CPP pl = (CPP)__builtin_amdgcn_kernarg_segment_ptr();
    asm volatile("" : "+s"(pl));
    char* mix = pl->ws + OFF_MIX;
    const bf16_t* qd = (const bf16_t*)(mix + L2_QD); const bf16_t* kdp = (const bf16_t*)(mix + L2_KDP); const bf16_t* kds = (const bf16_t*)(mix + L2_KDS);
    const bf16_t* vtp = (const bf16_t*)(mix + L2_VTP); const bf16_t* vts = (const bf16_t*)(mix + L2_VTS);
    bf16_t* o = (bf16_t*)(pl->ws + OFF_O);
    f32x16 O[4];
    float m_run, l_run;
    int grow_q, hd;
    {
      const bf16_t *k0, *k1, *vb_; int vs_, nt_;
      if (it < 512) {
        int b = it >> 8; hd = (it >> 5) & 7; int blk = it & 31;
        grow_q = 4096 + b * 2048 + blk * 64 + qs * 32;
        k0 = kds + ((size_t)b * 16 + hd) * 2304 * 64; k1 = kds + ((size_t)b * 16 + 8 + hd) * 2304 * 64;
        vb_ = vts + ((size_t)b * 8 + hd) * 128 * 2304; vs_ = 2304; nt_ = 72;
      } else {
        int pi = it - 512;
        int b = pi >> 5; hd = (pi >> 2) & 7; int blk = pi & 3;
        grow_q = b * 256 + blk * 64 + qs * 32;
        k0 = kdp + ((size_t)hd * 4096 + b * 256) * 64; k1 = kdp + ((size_t)(8 + hd) * 4096 + b * 256) * 64;
        vb_ = vtp + (size_t)hd * 128 * 4096 + (size_t)b * 256 * 128; vs_ = 4096; nt_ = 8;
      }
      flash_block<64, 128, 2, false>(qd + ((size_t)(comp * 8 + hd) * 8192 + grow_q) * 64, nt_, 0.125f * 1.4426950408889634f, k0, k1, vb_, vs_, smem, comp, O, m_run, l_run, tid, r, hh);
    }
    float linv = 1.f / l_run;
    __syncthreads();
    if (comp == 1) {
#pragma unroll
      for (int t = 0; t < 4; ++t)
#pragma unroll
        for (int i = 0; i < 16; ++i) xch[(qs * 64 + t * 16 + i) * 64 + lane] = O[t][i] * linv;
    }
    __syncthreads();
    if (comp == 0) {
      float ss = 0.f;
#pragma unroll
      for (int t = 0; t < 4; ++t)
#pragma unroll
        for (int i = 0; i < 16; ++i) {
          float v = O[t][i] * linv - lam * xch[(qs * 64 + t * 16 + i) * 64 + lane];
          O[t][i] = v;
          ss += v * v;
        }
      ss += __shfl_xor(ss, 32);
      float rs = rsqrtf(ss * (1.f / 128.f) + 1e-6f) * 0.52928698165564165f;
      const float* gs = p.in[I_DSUB];
#pragma unroll
      for (int t = 0; t < 4; ++t)
#pragma unroll
        for (int i = 0; i < 16; ++i) O[t][i] *= rs * gs[t * 32 + crow(i, hh)];
      store_o<4>(o + (size_t)grow_q * 1024 + hd * 128, 1024, O, 1.f, r, hh);
    }
  }
}

constexpr size_t L3_QAN = 0, L3_CKVN = 6 * MB, L3_QM = 11 * MB, L3_KMP = 35 * MB, L3_KMS = 47 * MB, L3_VTP = 61 * MB, L3_VTS = 69 * MB;
constexpr size_t L3_Q1 = 8192ull * 768 * 2, L3_KV1 = L3_Q1 + 8192ull * 1536 * 2, L3_DQ2 = L3_KV1 + 8704ull * 2048 * 2;
DI void prep3a_phase(CPR p) {
  const int lane = otid() & 63, wave = otid() >> 6;
  const bf16_t* big = (const bf16_t*)(p.ws + OFF_BIG);
  char* mix = p.ws + OFF_MIX;
  bf16_t* qan = (bf16_t*)(mix + L3_QAN); bf16_t* ckvn = (bf16_t*)(mix + L3_CKVN);
  for (int row = obid() * 8 + wave; row < 8192; row += gridDim.x * 8) {
    bf16_t* br = (bf16_t*)(p.ws + OFF_BIG) + (size_t)row * 768;
    const bf16_t* br2 = (const bf16_t*)(p.ws + OFF_BIG + L3_DQ2) + (size_t)row * 768;
    float q[6], ss = 0.f;
#pragma unroll
    for (int j = 0; j < 6; ++j) { q[j] = bf2f(br[j * 64 + lane]) + bf2f(br2[j * 64 + lane]); ss += q[j] * q[j]; }
#pragma unroll
    for (int ofs = 32; ofs >= 1; ofs >>= 1) ss += __shfl_xor(ss, ofs);
    float rs = rsqrtf(ss * (1.f / 384.f) + 1e-6f);
#pragma unroll
    for (int j = 0; j < 6; ++j) qan[(size_t)row * 384 + j * 64 + lane] = f2bf(q[j] * rs * p.in[I_MQAN][j * 64 + lane]);
    float c[4]; ss = 0.f;
#pragma unroll
    for (int j = 0; j < 4; ++j) { c[j] = bf2f(br[384 + j * 64 + lane]) + bf2f(br2[384 + j * 64 + lane]); ss += c[j] * c[j]; }
#pragma unroll
    for (int ofs = 32; ofs >= 1; ofs >>= 1) ss += __shfl_xor(ss, ofs);
    rs = rsqrtf(ss * (1.f / 256.f) + 1e-6f);
#pragma unroll
    for (int j = 0; j < 4; ++j) {
      float y = c[j] * rs * p.in[I_MKVAN][j * 64 + lane];
      ckvn[(size_t)row * 256 + j * 64 + lane] = f2bf(y);
      if (row < 4096) p.out[O_L3C + (size_t)row * 256 + j * 64 + lane] = y;
    }
    if (lane < 32) {
      const float kr = bf2f(br[640 + lane]) + bf2f(br2[640 + lane]);
      br[640 + lane] = f2bf(kr);
      if (row < 4096) p.out[O_L3R + (size_t)row * 32 + lane] = kr;
    }
  }
  for (int idx = gtid(); idx < 512 * 256; idx += gthreads()) ckvn[(size_t)8192 * 256 + idx] = f2bf(p.in[I_C3C][idx]);
}

DI void prep3b_phase(CPR p) {
  const bf16_t* big = (const bf16_t*)(p.ws + OFF_BIG);
  const bf16_t* q1 = (const bf16_t*)(p.ws + OFF_BIG + L3_Q1);
  const bf16_t* kv1 = (const bf16_t*)(p.ws + OFF_BIG + L3_KV1);
  char* mix = p.ws + OFF_MIX;
  bf16_t* qm = (bf16_t*)(mix + L3_QM); bf16_t* kmp = (bf16_t*)(mix + L3_KMP); bf16_t* kms = (bf16_t*)(mix + L3_KMS);
  bf16_t* vtp = (bf16_t*)(mix + L3_VTP); bf16_t* vts = (bf16_t*)(mix + L3_VTS);
  for (int idx = gtid(); idx < 8192 * 16 * 2; idx += gthreads()) {
    int half = idx & 1, hd = (idx >> 1) & 15, row = idx >> 5;
    float v[48];
    load_bf16_row<48>(q1 + (size_t)row * 1536 + hd * 96 + half * 48, v);
    float ss = 0.f;
#pragma unroll
    for (int j = 0; j < 48; ++j) ss += v[j] * v[j];
    ss += __shfl_xor(ss, 1);
    float rs = rsqrtf(ss * (1.f / 96.f) + 1e-6f);
    const float* g = p.in[I_MQN] + half * 48;
    rs *= 0.10206207261596577f * 1.4426950408889634f;
#pragma unroll
    for (int j = 0; j < 48; ++j) v[j] = v[j] * rs * g[j];
    if (half && row >= 4096) rope_apply<48, 16, 32>(v, (row - 4096) & 2047);
    store_bf16_row<48>(qm + ((size_t)hd * 8192 + row) * 96 + half * 48, v);
  }
  for (int idx = gtid(); idx < 8704 * 16 * 2; idx += gthreads()) {
    int half = idx & 1, hd = (idx >> 1) & 15, row = idx >> 5;
    float v[48];
    if (!half) {
      load_bf16_row<48>(kv1 + (size_t)row * 2048 + hd * 128, v);
    } else {
      float t16[16];
      load_bf16_row<16>(kv1 + (size_t)row * 2048 + hd * 128 + 48, t16);
#pragma unroll
      for (int j = 0; j < 16; ++j) v[j] = t16[j];
      if (row < 8192) {
        float t32[32];
        load_bf16_row<32>(big + (size_t)row * 768 + 640, t32);
#pragma unroll
        for (int j = 0; j < 32; ++j) v[16 + j] = t32[j];
      } else {
#pragma unroll
        for (int j = 0; j < 32; ++j) v[16 + j] = p.in[I_C3R][(size_t)(row - 8192) * 32 + j];
      }
    }
    float ss = 0.f;
#pragma unroll
    for (int j = 0; j < 48; ++j) ss += v[j] * v[j];
    ss += __shfl_xor(ss, 1);
    float rs = rsqrtf(ss * (1.f / 96.f) + 1e-6f);
    const float* g = p.in[I_MKN] + half * 48;
#pragma unroll
    for (int j = 0; j < 48; ++j) v[j] = v[j] * rs * g[j];
    if (row < 4096) store_bf16_row<48>(kmp + ((size_t)hd * 4096 + row) * 96 + half * 48, v);
    else if (row < 8192) {
      int b = (row - 4096) >> 11, t = (row - 4096) & 2047;
      if (half) rope_apply<48, 16, 32>(v, t);
      store_bf16_row<48>(kms + (((size_t)b * 16 + hd) * 2304 + 256 + t) * 96 + half * 48, v);
    } else {
      int b = (row - 8192) >> 8, l_ = (row - 8192) & 255;
      store_bf16_row<48>(kms + (((size_t)b * 16 + hd) * 2304 + l_) * 96 + half * 48, v);
    }
  }
  transpose_gen<true, 64>(1024, 4096, vtp, (size_t)64 * 4096, [&](int r_, int c) { return kv1[(size_t)r_ * 2048 + (c >> 6) * 128 + 64 + (c & 63)]; }, 0);
  for (int b = 0; b < 2; ++b) {
    transpose_gen<true, 64>(1024, 2048, vts + (size_t)b * 1024 * 2304, (size_t)64 * 2304, [&](int r_, int c) { return kv1[(size_t)(4096 + b * 2048 + r_) * 2048 + (c >> 6) * 128 + 64 + (c & 63)]; }, 256);
    transpose_gen<true, 64>(1024, 256, vts + (size_t)b * 1024 * 2304, (size_t)64 * 2304, [&](int r_, int c) { return kv1[(size_t)(8192 + b * 256 + r_) * 2048 + (c >> 6) * 128 + 64 + (c & 63)]; }, 0);
  }
}

DI void attn3_phase(CPR p, char* smem0) {
  char* smem = smem0 + (otid() >> 8) * 65536;
  const int tid = vtid(), lane = tid & 63, wave = tid >> 6, r = lane & 31, hh = lane >> 5;
  char* mix = p.ws + OFF_MIX;
  const bf16_t* qm = (const bf16_t*)(mix + L3_QM); const bf16_t* kmp = (const bf16_t*)(mix + L3_KMP); const bf16_t* kms = (const bf16_t*)(mix + L3_KMS);
  const bf16_t* vtp = (const bf16_t*)(mix + L3_VTP); const bf16_t* vts = (const bf16_t*)(mix + L3_VTS);
  bf16_t* o = (bf16_t*)(p.ws + OFF_O);
  const float scale = 0.10206207261596577f * 1.4426950408889634f;
  for (int it = vbid(); it < 1024; it += nvb()) {
    f32x16 O[2];
    float m_run, l_run;
    int grow_q, hd;
    const bf16_t *k0, *vb_; int vs_, nt_;
    if (it < 512) {
      int b = it >> 8; hd = (it >> 4) & 15; int blk = it & 15;
      grow_q = 4096 + b * 2048 + blk * 128 + wave * 32;
      k0 = kms + ((size_t)b * 16 + hd) * 2304 * 96;
      vb_ = vts + ((size_t)b * 16 + hd) * 64 * 2304; vs_ = 2304; nt_ = 72;
    } else {
      int pi = it - 512;
      int b = pi >> 5; hd = (pi >> 1) & 15; int blk = pi & 1;
      grow_q = b * 256 + blk * 128 + wave * 32;
      k0 = kmp + ((size_t)hd * 4096 + b * 256) * 96;
      vb_ = vtp + (size_t)hd * 64 * 4096 + (size_t)b * 256 * 64; vs_ = 4096; nt_ = 8;
    }
    flash_block<96, 64, 1, true>(qm + ((size_t)hd * 8192 + grow_q) * 96, nt_, scale, k0, k0, vb_, vs_, smem, 0, O, m_run, l_run, tid, r, hh);
    store_o<2>(o + (size_t)grow_q * 1024 + hd * 64, 1024, O, 1.f / l_run, r, hh);
  }
}

#define XB_TMO      128
#define XB_XCNT(j)  (256  + 64 * (j))
#define XB_XSUB(j)  (1280 + 64 * (j))
#define XB_XGEN(j)  (2304 + 64 * (j))
#define XB_TOP      3328
#define XB_TOPGEN   3392
#define XCD_BAR_WORDS 3456
#define XB_SPIN_CAP (1u << 18)
#define LAS __attribute__((address_space(3)))
DI unsigned xb_ld(unsigned* p) { return __hip_atomic_load(p, __ATOMIC_RELAXED, __HIP_MEMORY_SCOPE_AGENT); }
DI unsigned xb_add(unsigned* p, unsigned v) { return __hip_atomic_fetch_add(p, v, __ATOMIC_RELAXED, __HIP_MEMORY_SCOPE_AGENT); }
DI unsigned xb_xcc_id() { return (unsigned)__builtin_amdgcn_s_getreg((3 << 11) | 20) & 0xFu; }
#define XB_SPIN(cond, bar) do { unsigned _sp = 0; while (cond) { __builtin_amdgcn_s_sleep(1); \
    if ((++_sp & 255u) == 0u) { if (xb_ld(&(bar)[XB_TMO])) break; if (_sp > XB_SPIN_CAP) { atomicAdd(&(bar)[XB_TMO], 1u); break; } } } } while (0)
DI void xcd_barrier_complete(unsigned* bar, unsigned x, unsigned& nloc, unsigned& nx) {
  const unsigned G = gridDim.x;
  unsigned sum, cnt, mine, sp = 0u;
  for (;;) {
    sum = 0u; cnt = 0u; mine = 0u;
#pragma unroll
    for (unsigned j = 0; j < 16; ++j) { const unsigned c = xb_ld(&bar[XB_XCNT(j)]); sum += c; cnt += (c > 0u) ? 1u : 0u; mine = (j == x) ? c : mine; }
    if (sum == G) break;
    __builtin_amdgcn_s_sleep(1);
    if ((++sp & 255u) == 0u) { if (xb_ld(&bar[XB_TMO])) break; if (sp > XB_SPIN_CAP) { atomicAdd(&bar[XB_TMO], 1u); break; } }
  }
  nloc = mine > 0u ? mine : 1u; nx = cnt > 0u ? cnt : 1u;
}
DI void xcd_barrier(unsigned* bar, volatile LAS unsigned* st) {
  asm volatile("s_waitcnt vmcnt(0)" ::: "memory");
  __syncthreads();
  if (__builtin_amdgcn_workitem_id_x() == 0) {
    const unsigned x = xb_xcc_id();
    __builtin_amdgcn_s_waitcnt(0);
    unsigned nloc = st[0], nx = st[1];
    if (nloc == 0u) { xcd_barrier_complete(bar, x, nloc, nx); st[0] = nloc; st[1] = nx; }
    const unsigned old = xb_add(&bar[XB_XSUB(x)], 1u);
    const unsigned gen = old / nloc;
    if (old + 1u == (gen + 1u) * nloc) {
      __builtin_amdgcn_fence(__ATOMIC_RELEASE, "agent");
      asm volatile("s_waitcnt vmcnt(0)" ::: "memory");
      const unsigned og = xb_add(&bar[XB_TOP], 1u);
      const unsigned tg = og / nx;
      if (og + 1u == (tg + 1u) * nx) xb_add(&bar[XB_TOPGEN], 1u);
      else XB_SPIN(xb_ld(&bar[XB_TOPGEN]) == tg, bar);
      __builtin_amdgcn_fence(__ATOMIC_ACQUIRE, "agent");
      xb_add(&bar[XB_XGEN(x)], 1u);
      asm volatile("s_waitcnt vmcnt(0)" ::: "memory");
    } else {
      XB_SPIN(xb_ld(&bar[XB_XGEN(x)]) == gen, bar);
      __builtin_amdgcn_fence(__ATOMIC_ACQUIRE, "agent");
      asm volatile("s_waitcnt vmcnt(0)" ::: "memory");
    }
  }
  __syncthreads();
}

constexpr int LDS_BYTES = 131072 + 64;
__global__ void __launch_bounds__(512, 2) mega(Params p_unused) {
  extern __shared__ __attribute__((aligned(16))) unsigned char shm[];
  char* smem = (char*)shm;
  volatile LAS unsigned* xbw = (volatile LAS unsigned*)(shm + 131072);
  {
    CPP pq = (CPP)__builtin_amdgcn_kernarg_segment_ptr();
    unsigned* bar0 = (unsigned*)(pq->ws + OFF_BAR);
    const unsigned xid = xb_xcc_id();
    if (__builtin_amdgcn_workitem_id_x() == 0) {
      xbw[0] = 0u; xbw[1] = 0u;
      (void)xb_add(&bar0[XB_XCNT(xid)], 1u);
    }
  }
  __syncthreads();
  for (int ph = 0; ph < 46; ++ph) {
    CPP pp = (CPP)__builtin_amdgcn_kernarg_segment_ptr();
    asm volatile("" : "+s"(pp));
    CPR p = *pp;
    bf16_t* W = (bf16_t*)p.ws;
    bf16_t* H = (bf16_t*)(p.ws + OFF_H);
    bf16_t* BIG = (bf16_t*)(p.ws + OFF_BIG);
    bf16_t* OB = (bf16_t*)(p.ws + OFF_O);
    bf16_t* AB = (bf16_t*)(p.ws + OFF_MIX);
    char* mix = p.ws + OFF_MIX;
    if (ph == 0) {
      phase0(p, smem);
      if (REPMASK & 16) phase0(p, smem);
    } else if (ph == 45) {
      final_add_phase(p);
    } else {
      const int l = (ph - 1) / 11, step = (ph - 1) % 11;
      if ((step == 4 && (l == 0 || l == 2)) || (step == 5 && l != 3)) continue;
      int reps = 1;
      {
        const bool is_attn = (step == 3 && l != 3) || step == 5;
        const bool is_gemm_store = step == 1 || step == 8 || (step == 3 && l == 3);
        const bool is_misc = step == 0 || step == 2 || step == 7 || step == 9 || (step == 4);
        if ((REPMASK & 2) && is_gemm_store) reps = 2;
        if ((REPMASK & 4) && is_attn) reps = 2;
        if ((REPMASK & 8) && is_misc) reps = 2;
        if ((REPMASK & 32) && step == 3 && l == 0) reps = 2;
        if ((REPMASK & 64) && step == 3 && l == 1) reps = 2;
        if ((REPMASK & 128) && step == 3 && l == 2) reps = 2;
        if ((REPMASK & 256) && step == 5) reps = 2;
        if ((REPMASK & 512) && (step == 0 || step == 7)) reps = 2;
        if ((REPMASK & 1024) && step == 9) reps = 2;
        if ((REPMASK & 2048) && (step == 2 || step == 4)) reps = 2;
        if ((REPMASK & 16384) && step == 2 && l == 0) reps = 2;
        if ((REPMASK & 32768) && step == 2 && l == 1) reps = 2;
        if ((REPMASK & 65536) && step == 2 && l == 2) reps = 2;
        if ((REPMASK & 131072) && (step == 2 || step == 4) && l == 3) reps = 2;
        if ((REPMASK & 262144) && step == 4 && l == 1) reps = 2;
      }
      for (int rep = 0; rep < reps; ++rep)
      switch (step) {
        case 0: norm_phase(p, l, 0, l == 0, l > 0); break;
        case 1:
          if (l == 0) gemm_store_phase(H, W + W_NA_QKV, 8192, 3072, 1024, BIG, 3072, shm);
          else if (l == 1) gemm_store_phase(H, W + W_GLA_QKVG, 8192, 3328, 1024, BIG, 3328, shm);
          else if (l == 2) gemm_store_phase(H, W + W_DIFF_QKV, 8192, 3072, 1024, BIG, 3072, shm);
          else gemm_store_sk_phase(H, W + W_MLA_DQKV, 8192, 768, 1024, BIG, (bf16_t*)(p.ws + OFF_BIG + L3_DQ2), 768, shm);
          break;
        case 2:
          if (l == 0) prep0_phase(p);
          else if (l == 1) prep1_phase(p, smem);
          else if (l == 2) prep2_phase(p);
          else prep3a_phase(p);
          break;
        case 3:
          if (l == 0) attn0_phase(p, smem);
          else if (l == 1) scan1_phase(p, smem);
          else if (l == 2) attn2_phase(p, smem);
          else {
            const bf16_t* qan = (const bf16_t*)(mix + L3_QAN); const bf16_t* ckvn = (const bf16_t*)(mix + L3_CKVN);
            bf16_t* q1 = (bf16_t*)(p.ws + OFF_BIG + L3_Q1); bf16_t* kv1 = (bf16_t*)(p.ws + OFF_BIG + L3_KV1);
            gemm_store_phase(qan, W + W_MLA_UQ, 8192, 1536, 384, q1, 1536, shm);
            gemm_store_phase(ckvn, W + W_MLA_UKV, 8704, 2048, 256, kv1, 2048, shm);
          }
          break;
        case 4:
          if (l == 1) gla_out_phase(p);
          else prep3b_phase(p);
          break;
        case 5: attn3_phase(p, smem); break;
        case 6: {
          const bf16_t* wo = W + (l == 0 ? W_NA_O : l == 1 ? W_GLA_O : l == 2 ? W_DIFF_O : W_MLA_O);
          if ((int)gridDim.x >= 256 && obid() >= 128) conv_ahead(p, l, smem, obid() - 128, (int)gridDim.x - 128);
          else {
            if ((int)gridDim.x < 256 ) conv_ahead(p, l, smem, obid(), (int)gridDim.x);
            gemm_resid_phase(p, OB, 1024, wo, l, 2048, l == 0, false, shm);
          }
          if (REPMASK & 4096) gemm_resid_phase(p, OB, 1024, wo, l, 2048, l == 0, false, shm, true);
        } break;
        case 7: norm_phase(p, l, 1, false, false); break;
        case 8: gemm_store_phase(H, W + W_UP + (size_t)l * 5632 * 1024, 8192, 5632, 1024, BIG, 5632, shm); break;
        case 9: convgate_phase(p, l); break;
        default: gemm_resid_phase(p, AB, 2816, W + W_DOWN + (size_t)l * 1024 * 2816, l, 5120, false, true, shm);
          if (REPMASK & 8192) gemm_resid_phase(p, AB, 2816, W + W_DOWN + (size_t)l * 1024 * 2816, l, 5120, false, true, shm, true);
          break;
      }
    }
    if (ph < 45) {
      xcd_barrier((unsigned*)(p.ws + OFF_BAR), xbw);
      if (REPMASK & 1) xcd_barrier((unsigned*)(p.ws + OFF_BAR), xbw);
    }
  }
}

extern "C" void kernel_launch(void* const* d_in, const int* in_sizes, int n_in, void* d_out, int out_size, void* d_ws, size_t ws_size, hipStream_t stream) {
  static int grid_blocks = 0;
  if (!grid_blocks) {
    int dev = 0, cus = 0, per_cu = 0;
    (void)hipGetDevice(&dev);
    (void)hipDeviceGetAttribute(&cus, hipDeviceAttributeMultiprocessorCount, dev);
    (void)hipFuncSetAttribute((const void*)mega, hipFuncAttributeMaxDynamicSharedMemorySize, LDS_BYTES);
    (void)hipOccupancyMaxActiveBlocksPerMultiprocessor(&per_cu, mega, 512, LDS_BYTES);
    (void)hipGetLastError();
    grid_blocks = cus;
    if (per_cu < 1) grid_blocks = cus;
  }
  Params p{};
  for (int i = 0; i < 46; ++i) p.in[i] = (const float*)d_in[i];
  p.out = (float*)d_out;
  p.ws = (char*)d_ws;
  (void)hipMemsetAsync((char*)d_ws + OFF_BAR, 0, XCD_BAR_WORDS * 4, stream);
  void* args[] = {&p};
  (void)hipLaunchCooperativeKernel((void*)mega, dim3(grid_blocks), dim3(512), args, LDS_BYTES, stream);
}
```

```cpp
#include <hip/hip_runtime.h>
#include <hip/hip_cooperative_groups.h>
#include <stdint.h>
namespace cg = cooperative_groups;

typedef unsigned short bf16_t;
typedef __attribute__((ext_vector_type(8))) short bf16x8;
typedef __attribute__((ext_vector_type(4))) short bf16x4;
typedef __attribute__((ext_vector_type(16))) float f32x16;
#define DI __device__ __forceinline__
#define MFMA32(a, b, c) __builtin_amdgcn_mfma_f32_32x32x16_bf16((a), (b), (c), 0, 0, 0)

#ifndef REPMASK
#define REPMASK 0
#endif
constexpr size_t MB = 1ull << 20;
constexpr size_t W_NA_QKV = 0;
constexpr size_t W_NA_O = W_NA_QKV + 3072ull * 1024;
constexpr size_t W_GLA_QKVG = W_NA_O + 1024ull * 1024;
constexpr size_t W_GLA_O = W_GLA_QKVG + 3328ull * 1024;
constexpr size_t W_DIFF_QKV = W_GLA_O + 1024ull * 1024;
constexpr size_t W_DIFF_O = W_DIFF_QKV + 3072ull * 1024;
constexpr size_t W_MLA_DQKV = W_DIFF_O + 1024ull * 1024;
constexpr size_t W_MLA_UQ = W_MLA_DQKV + 768ull * 1024;
constexpr size_t W_MLA_UKV = W_MLA_UQ + 1536ull * 384;
constexpr size_t W_MLA_O = W_MLA_UKV + 2048ull * 256;
constexpr size_t W_UP = W_MLA_O + 1024ull * 1024;
constexpr size_t W_DOWN = W_UP + 4ull * 5632 * 1024;
constexpr size_t W_END = W_DOWN + 4ull * 1024 * 2816;
constexpr size_t OFF_H = ((W_END * 2 + 255) / 256) * 256;
constexpr size_t OFF_BIG = OFF_H + 8192ull * 1024 * 2;
constexpr size_t OFF_O = OFF_BIG + 8192ull * 5632 * 2;
constexpr size_t OFF_MODS = OFF_O + 8192ull * 1024 * 2;
constexpr size_t OFF_MIX = OFF_MODS + 512 * 1024;
constexpr size_t OFF_BAR = OFF_MIX + 100 * MB;
constexpr size_t O_L0K = 8388608, O_L0V = 12582912, O_L1F = 16777216, O_L1B = 18874368;
constexpr size_t O_L2K = 20971520, O_L2V = 25165824, O_L3C = 29360128, O_L3R = 30408704;

struct Params {
  const float* in[46];
  float* out;
  char* ws;
};
typedef const __attribute__((address_space(4))) Params& CPR;
typedef const __attribute__((address_space(4))) Params* CPP;
enum { I_XP = 0, I_XS, I_C0K, I_C0V, I_SF, I_SB, I_C2K, I_C2V, I_C3C, I_C3R, I_C, I_CCTX, I_ADAW, I_ADAB, I_NMIX, I_NFFN,
       I_WUP, I_CONVW, I_CONVB, I_WDOWN, I_NAQKV, I_NAQN, I_NAKN, I_NABIAS, I_NAO, I_GQKVG, I_GG1, I_GG2, I_GBG, I_GON, I_GO,
       I_DQKV, I_DQN, I_DKN, I_DLAM, I_DSUB, I_DO, I_MDQ, I_MQAN, I_MUQ, I_MDKV, I_MKVAN, I_MUKV, I_MQN, I_MKN, I_MO };

DI unsigned short f2bf(float x) {
  unsigned u = __float_as_uint(x);
  u += 0x7fffu + ((u >> 16) & 1u);
  return (unsigned short)(u >> 16);
}
DI float bf2f(unsigned short b) { return __uint_as_float(((unsigned)b) << 16); }
typedef __bf16 bf16v2_t __attribute__((ext_vector_type(2)));
typedef float f32v2_t __attribute__((ext_vector_type(2)));
DI unsigned pack2(float a, float b) { f32v2_t f = {a, b}; bf16v2_t h = __builtin_convertvector(f, bf16v2_t); return __builtin_bit_cast(unsigned, h); }
DI int crow(int i, int hh) { return (i & 3) + 8 * (i >> 2) + 4 * hh; }
DI float siluf(float x) { return x / (1.f + __expf(-x)); }
DI int otid() { int t = __builtin_amdgcn_workitem_id_x(); asm volatile("" : "+v"(t)); return t; }
DI int obid() { int b = __builtin_amdgcn_workgroup_id_x(); asm volatile("" : "+s"(b)); return b; }
DI int gtid() { return obid() * 512 + otid(); }
DI int gthreads() { return gridDim.x * 512; }
DI int vtid() { return otid() & 255; }
DI int vbid() { return obid() * 2 + (otid() >> 8); }
DI int nvb() { return gridDim.x * 2; }

template <int D> DI void load_bf16_row(const bf16_t* p, float (&v)[D]) {
#pragma unroll
  for (int j = 0; j < D / 8; ++j) {
    uint4 q = *(const uint4*)(p + j * 8);
    unsigned w[4] = {q.x, q.y, q.z, q.w};
#pragma unroll
    for (int e = 0; e < 4; ++e) { v[j * 8 + 2 * e] = __uint_as_float(w[e] << 16); v[j * 8 + 2 * e + 1] = __uint_as_float(w[e] & 0xffff0000u); }
  }
}
template <int D> DI void store_bf16_row(bf16_t* p, const float (&v)[D]) {
#pragma unroll
  for (int j = 0; j < D / 8; ++j) {
    uint4 q;
    q.x = pack2(v[j * 8 + 0], v[j * 8 + 1]); q.y = pack2(v[j * 8 + 2], v[j * 8 + 3]);
    q.z = pack2(v[j * 8 + 4], v[j * 8 + 5]); q.w = pack2(v[j * 8 + 6], v[j * 8 + 7]);
    *(uint4*)(p + j * 8) = q;
  }
}
template <int D> DI void store_f32_row(float* p, const float (&v)[D]) {
#pragma unroll
  for (int j = 0; j < D / 4; ++j) *(float4*)(p + j * 4) = make_float4(v[j * 4], v[j * 4 + 1], v[j * 4 + 2], v[j * 4 + 3]);
}
template <int D> DI void rms_apply(float (&v)[D], const float* g) {
  float ss = 0.f;
#pragma unroll
  for (int j = 0; j < D; ++j) ss += v[j] * v[j];
  float rs = rsqrtf(ss * (1.f / D) + 1e-6f);
#pragma unroll
  for (int j = 0; j < D; ++j) v[j] = v[j] * rs * g[j];
}
template <int D, int BASE, int R> DI void rope_apply(float (&v)[D], int t) {
  constexpr int NF = R / 4;
  float rowf = (float)(t >> 6), colf = (float)(t & 63);
#pragma unroll
  for (int a = 0; a < 2; ++a) {
#pragma unroll
    for (int f = 0; f < NF; ++f) {
      float freq = exp2f(-(float)f * (13.287712379549449f / NF));
      float ang = (a == 0 ? rowf : colf) * freq;
      float c = __cosf(ang), s = __sinf(ang);
      int i1 = BASE + a * 2 * NF + f, i2 = i1 + NF;
      float x1 = v[i1], x2 = v[i2];
      v[i1] = x1 * c - x2 * s;
      v[i2] = x1 * s + x2 * c;
    }
  }
}
template <bool PERMK, int DVH = 0, class F> DI void transpose_gen(int ncols, int nrows, bf16_t* dst, size_t dstride, F srcf, int koff = 0) {
  int total = ncols * (nrows >> 3);
  for (int idx = gtid(); idx < total; idx += gthreads()) {
    int c = idx % ncols, r0 = (idx / ncols) << 3;
    unsigned short e[8];
#pragma unroll
    for (int j = 0; j < 8; ++j) e[j] = srcf(r0 + j, c);
    const int k0 = koff + r0;
    bf16_t* drow = (DVH > 0) ? dst + (size_t)(c / (DVH > 0 ? DVH : 1)) * dstride + (size_t)(k0 >> 5) * (DVH * 32) + (c % (DVH > 0 ? DVH : 1)) * 32 + (k0 & 16)
                             : dst + (size_t)c * dstride + (k0 & ~15);
    if (PERMK) {
      uint2 q0, q1;
      q0.x = e[0] | ((unsigned)e[1] << 16); q0.y = e[2] | ((unsigned)e[3] << 16);
      q1.x = e[4] | ((unsigned)e[5] << 16); q1.y = e[6] | ((unsigned)e[7] << 16);
      bf16_t* d = drow + ((k0 & 8) ? 4 : 0);
      *(uint2*)d = q0;
      *(uint2*)(d + 8) = q1;
    } else {
      uint4 q;
      q.x = e[0] | ((unsigned)e[1] << 16); q.y = e[2] | ((unsigned)e[3] << 16);
      q.z = e[4] | ((unsigned)e[5] << 16); q.w = e[6] | ((unsigned)e[7] << 16);
      *(uint4*)(drow + (k0 & 8)) = q;
    }
  }
}

namespace pg8 {
#define PG8_LAS __attribute__((address_space(3)))
typedef float f32x4 __attribute__((ext_vector_type(4)));
typedef unsigned u32x4 __attribute__((ext_vector_type(4)));
constexpr int BM = 256, BK = 64, HALF = 128, HTB = HALF * BK * 2, STAGE_BYTES = 8 * HTB, NXCD = 8, WGM = 4;
DI int lds_byte(int r, int c) { const int st = (r >> 4) * 2 + (c >> 5), rr = r & 15, cc = c & 31, ob = rr * 64 + cc * 2; return st * 1024 + (ob ^ (((ob >> 9) & 1) << 5)); }
DI void stage_rc(int b, int& R, int& C) { const int st = b / 1024, sb = b % 1024, swz = sb ^ (((sb >> 9) & 1) << 5); R = (st >> 1) * 16 + swz / 64; C = (st & 1) * 32 + (swz % 64) / 2; }
DI int perm32(int rho) { const int n = rho >> 4, i = rho & 15; return 8 * (i >> 2) + 4 * n + (i & 3); }
struct Unit { int pm, pn, ks; };
struct Gemm { const bf16_t* A; const bf16_t* Bt; int M, N, K; int Kext; };
struct StaticOrder {
  int nM, nN, nwg, G, c;
  DI void init(int M, int N, int G_, int c_) { nM = M / BM; nN = N / BM; nwg = nM * nN; G = G_; c = c_; }
  DI bool next(int i, Unit& u) const {
    const long L = (long)i * G + c; if (L >= nwg) return false;
    int wgid = (int)L; { const int q = nwg / NXCD, r = nwg % NXCD, xcd = wgid % NXCD, off = wgid / NXCD; wgid = (xcd < r ? xcd * (q + 1) : r * (q + 1) + (xcd - r) * q) + off; }
    const int nig = WGM * nN, gid = wgid / nig, fm = gid * WGM, gsz = (nM - fm) < WGM ? (nM - fm) : WGM;
    u.pm = fm + ((wgid % nig) % gsz); u.pn = (wgid % nig) / gsz; u.ks = 0; return true;
  }
  DI void a_ready(const Unit&) const {}
  DI void done(const Unit&) const {}
};
struct SplitK2Order : StaticOrder {
  DI bool next(int i, Unit& u) const {
    const long L = (long)i * G + c; if (L >= 2 * nwg) return false;
    int wgid = (int)(L >> 1); { const int q = nwg / NXCD, r = nwg % NXCD, xcd = wgid % NXCD, off = wgid / NXCD; wgid = (xcd < r ? xcd * (q + 1) : r * (q + 1) + (xcd - r) * q) + off; }
    const int nig = WGM * nN, gid = wgid / nig, fm = gid * WGM, gsz = (nM - fm) < WGM ? (nM - fm) : WGM;
    u.pm = fm + ((wgid % nig) % gsz); u.pn = (wgid % nig) / gsz; u.ks = (int)(L & 1); return true;
  }
};
DI unsigned cvt_pk_bf16(float lo, float hi) { unsigned r; asm volatile("v_cvt_pk_bf16_f32 %0, %1, %2" : "=v"(r) : "v"(lo), "v"(hi)); return r; }
struct EpiStore {
  static constexpr bool PERM = true;
  bf16_t* O; int ldc; bf16_t* O1;
  DI void operator()(const f32x4 (&acc)[2][2][4][2], const Unit& u, int wr, int wc, int fr, int fq) const {
    const int row0 = u.pm * BM + wr * 64 + fr, col0 = u.pn * BM + wc * 32 + 8 * fq;
#pragma unroll
    for (int ai = 0; ai < 2; ++ai)
#pragma unroll
      for (int m = 0; m < 4; ++m) {
        bf16_t* rowp = (u.ks ? O1 : O) + (size_t)(row0 + ai * HALF + m * 16) * ldc + col0;
#pragma unroll
        for (int bj = 0; bj < 2; ++bj) {
          const f32x4 v0 = acc[ai][bj][m][0], v1 = acc[ai][bj][m][1];
          u32x4 w; w.x = cvt_pk_bf16(v0[0], v0[1]); w.y = cvt_pk_bf16(v0[2], v0[3]); w.z = cvt_pk_bf16(v1[0], v1[1]); w.w = cvt_pk_bf16(v1[2], v1[3]);
          *(u32x4*)(rowp + bj * HALF) = w;
        }
      }
  }
};
struct EpiResid {
  static constexpr bool PERM = false;
  const float* xp; const float* xs; float* out; const float* mods_l; int gate_off; int first; float* p1;
  DI void operator()(const f32x4 (&acc)[2][2][4][2], const Unit& u, int wr, int wc, int fr, int fq) const {
    const int rowb = u.pm * BM;
    const float* xin = first ? (rowb < 4096 ? xp + (size_t)rowb * 1024 : xs + (size_t)(rowb - 4096) * 1024) : out + (size_t)rowb * 1024;
    float* xo = (u.ks ? p1 : out) + (size_t)rowb * 1024;
    const int mr = rowb < 4096 ? 0 : (rowb < 6144 ? 1 : 2);
    const float* gate = mods_l + (size_t)mr * 6144 + gate_off;
    const int col0 = u.pn * BM + wc * 32 + 4 * fq;
    f32x4 gv[2][2];
#pragma unroll
    for (int bj = 0; bj < 2; ++bj)
#pragma unroll
      for (int n = 0; n < 2; ++n) gv[bj][n] = *(const f32x4*)(gate + col0 + bj * HALF + n * 16);
#pragma unroll
    for (int ai = 0; ai < 2; ++ai)
#pragma unroll
      for (int m = 0; m < 4; ++m) {
        const unsigned ro = (unsigned)(wr * 64 + fr + ai * HALF + m * 16) * 1024u + col0;
#pragma unroll
        for (int bj = 0; bj < 2; ++bj)
#pragma unroll
          for (int n = 0; n < 2; ++n) {
            const unsigned o = ro + bj * HALF + n * 16;
            if (u.ks) *(f32x4*)(xo + o) = gv[bj][n] * acc[ai][bj][m][n];
            else *(f32x4*)(xo + o) = *(const f32x4*)(xin + o) + gv[bj][n] * acc[ai][bj][m][n];
          }
      }
  }
};

template <class Epi, class Sched>
DI void gemm_phase(PG8_LAS unsigned char* lds, const Gemm g, const Sched& S, const Epi& E) {
  const int tid = otid(), wid = __builtin_amdgcn_readfirstlane(tid >> 6), lane = tid & 63, wr = wid >> 2, wc = wid & 3, fr = lane & 15, fq = lane >> 4;
  const int K = g.K, nt = g.Kext / BK;
  const size_t ksb = (size_t)g.Kext * 2;
  unsigned voffA[2], voffB[2];
#pragma unroll
  for (int i = 0; i < 2; ++i) { int R, C; stage_rc(tid * 16 + i * 8192, R, C); const int Rb = Epi::PERM ? ((R & ~31) + perm32(R & 31)) : R;
    voffA[i] = (unsigned)(R * K + C) * 2u; voffB[i] = (unsigned)(Rb * K + C) * 2u; }
  const size_t kstep = (size_t)(BK * 2);
  const size_t hstep = (size_t)HALF * K * 2;
  const size_t tstep = 2 * hstep;
  const unsigned ldsw = (unsigned)wid * 1024u;
  const int aoff = lds_byte(wr * 64 + fr, fq * 8), boff = lds_byte(wc * 32 + fr, fq * 8);
#define PG8_SA(b, h) (((b) * 2 + (h)) * HTB)
#define PG8_SB(b, h) ((4 + (b) * 2 + (h)) * HTB)
#define PG8_STAGE(bufoff, gbase, voff) do { _Pragma("unroll") for (int _i = 0; _i < 2; ++_i) \
    __builtin_amdgcn_global_load_lds((const unsigned*)((const char*)(gbase) + (voff)[_i]), (PG8_LAS unsigned*)(lds + (bufoff) + ldsw + _i * 8192), 16, 0, 0); } while (0)
#define PG8_LDA(dst, b, h) do { _Pragma("unroll") for (int m = 0; m < 4; ++m) _Pragma("unroll") for (int k = 0; k < 2; ++k) dst[m][k] = *(const PG8_LAS bf16x8*)(lds + PG8_SA(b, h) + aoff + m * 2048 + k * 1024); } while (0)
#define PG8_LDB(dst, b, h) do { _Pragma("unroll") for (int n = 0; n < 2; ++n) _Pragma("unroll") for (int k = 0; k < 2; ++k) dst[n][k] = *(const PG8_LAS bf16x8*)(lds + PG8_SB(b, h) + boff + n * 2048 + k * 1024); } while (0)
#define PG8_MMA(ai, bj, At, Bt) do { __builtin_amdgcn_s_setprio(1); _Pragma("unroll") for (int m = 0; m < 4; ++m) _Pragma("unroll") for (int n = 0; n < 2; ++n) _Pragma("unroll") for (int k = 0; k < 2; ++k) \
    acc[ai][bj][m][n] = __builtin_amdgcn_mfma_f32_16x16x32_bf16(Bt[n][k], At[m][k], acc[ai][bj][m][n], 0, 0, 0); __builtin_amdgcn_s_setprio(0); } while (0)
#define PG8_WAIT_V(n) asm volatile("s_waitcnt vmcnt(" #n ")" ::: "memory")
#define PG8_WAIT_L(n) asm volatile("s_waitcnt lgkmcnt(" #n ")" ::: "memory")
#define PG8_BAR __builtin_amdgcn_s_barrier()
#define PG8_SCHED __builtin_amdgcn_sched_barrier(0)
  Unit cur, nxt; int ui = 0;
  if (!S.next(0, cur)) return;
  f32x4 acc[2][2][4][2];
#pragma unroll
  for (int a = 0; a < 2; ++a)
#pragma unroll
    for (int b = 0; b < 2; ++b)
#pragma unroll
      for (int m = 0; m < 4; ++m)
#pragma unroll
        for (int n = 0; n < 2; ++n) acc[a][b][m][n] = (f32x4){0.f, 0.f, 0.f, 0.f};
  bf16x8 At[4][2], B0[2][2], B1[2][2];
  const char* cA = (const char*)g.A + (size_t)cur.pm * tstep + cur.ks * ksb; const char* cB = (const char*)g.Bt + (size_t)cur.pn * tstep + cur.ks * ksb;
  S.a_ready(cur);
  PG8_STAGE(PG8_SB(0, 0), cB, voffB); PG8_STAGE(PG8_SA(0, 0), cA, voffA); PG8_STAGE(PG8_SB(0, 1), cB + hstep, voffB); PG8_STAGE(PG8_SA(0, 1), cA + hstep, voffA);
  if (wr == 1) PG8_BAR;
  PG8_WAIT_V(4); PG8_BAR;
  PG8_STAGE(PG8_SB(1, 0), cB + kstep, voffB); PG8_STAGE(PG8_SA(1, 0), cA + kstep, voffA); PG8_STAGE(PG8_SB(1, 1), cB + hstep + kstep, voffB);
  PG8_WAIT_V(6); PG8_BAR;
  for (;;) {
    const bool has_next = S.next(ui + 1, nxt);
    const char* nA = has_next ? (const char*)g.A + (size_t)nxt.pm * tstep + nxt.ks * ksb : cA; const char* nB = has_next ? (const char*)g.Bt + (size_t)nxt.pn * tstep + nxt.ks * ksb : cB;
    for (int t = 0; t < nt; t += 2) {
      const bool last = (t == nt - 2);
      const char* a1 = cA + (size_t)(t + 1) * kstep;
      const char* a2 = last ? nA : cA + (size_t)(t + 2) * kstep; const char* b2 = last ? nB : cB + (size_t)(t + 2) * kstep;
      const char* a3 = a2 + kstep; const char* b3 = b2 + kstep;
      if (last && has_next) S.a_ready(nxt);
      PG8_LDB(B0, 0, 0); PG8_SCHED; PG8_LDA(At, 0, 0); PG8_STAGE(PG8_SA(1, 1), a1 + hstep, voffA);
      PG8_WAIT_L(8); PG8_BAR; PG8_WAIT_L(0); PG8_MMA(0, 0, At, B0); PG8_BAR; PG8_SCHED;
      PG8_LDB(B1, 0, 1); PG8_STAGE(PG8_SB(0, 0), b2, voffB);
      PG8_BAR; PG8_WAIT_L(0); PG8_MMA(0, 1, At, B1); PG8_BAR;
      PG8_LDA(At, 0, 1); PG8_STAGE(PG8_SA(0, 0), a2, voffA);
      PG8_BAR; PG8_WAIT_L(0); PG8_MMA(1, 0, At, B0); PG8_BAR; PG8_SCHED;
      PG8_STAGE(PG8_SB(0, 1), b2 + hstep, voffB);
      PG8_WAIT_V(6); PG8_BAR; PG8_MMA(1, 1, At, B1); PG8_BAR;
      PG8_LDB(B0, 1, 0); PG8_SCHED; PG8_LDA(At, 1, 0); PG8_STAGE(PG8_SA(0, 1), a2 + hstep, voffA);
      PG8_WAIT_L(8); PG8_BAR; PG8_WAIT_L(0); PG8_MMA(0, 0, At, B0); PG8_BAR; PG8_SCHED;
      PG8_LDB(B1, 1, 1); PG8_STAGE(PG8_SB(1, 0), b3, voffB);
      PG8_BAR; PG8_WAIT_L(0); PG8_MMA(0, 1, At, B1); PG8_BAR;
      PG8_LDA(At, 1, 1); PG8_STAGE(PG8_SA(1, 0), a3, voffA);
      PG8_BAR; PG8_WAIT_L(0); PG8_MMA(1, 0, At, B0); PG8_BAR; PG8_SCHED;
      PG8_STAGE(PG8_SB(1, 1), b3 + hstep, voffB);
      PG8_WAIT_V(6); PG8_BAR; PG8_MMA(1, 1, At, B1); PG8_BAR;
    }
    E(acc, cur, wr, wc, fr, fq); S.done(cur);
    if (!has_next) break;
#pragma unroll
    for (int a = 0; a < 2; ++a)
#pragma unroll
      for (int b = 0; b < 2; ++b)
#pragma unroll
        for (int m = 0; m < 4; ++m)
#pragma unroll
          for (int n = 0; n < 2; ++n) acc[a][b][m][n] = (f32x4){0.f, 0.f, 0.f, 0.f};
    cur = nxt; cA = nA; cB = nB; ++ui;
  }
  PG8_WAIT_V(0);
  if (wr == 0) PG8_BAR;
  PG8_BAR;
#undef PG8_SA
#undef PG8_SB
#undef PG8_STAGE
#undef PG8_LDA
#undef PG8_LDB
#undef PG8_MMA
#undef PG8_WAIT_V
#undef PG8_WAIT_L
#undef PG8_BAR
#undef PG8_SCHED
}
}

DI void gemm_store_phase(const bf16_t* A, const bf16_t* Bt, int M, int N, int K, bf16_t* C, int ldc, unsigned char* shm) {
  pg8::Gemm g; g.A = A; g.Bt = Bt; g.M = M; g.N = N; g.K = K; g.Kext = K;
  pg8::StaticOrder S; S.init(M, N, (int)gridDim.x, obid());
  pg8::EpiStore E; E.O = C; E.ldc = ldc; E.O1 = C;
  pg8::gemm_phase(( __attribute__((address_space(3))) unsigned char*)shm, g, S, E);
}
DI void gemm_store_sk_phase(const bf16_t* A, const bf16_t* Bt, int M, int N, int K, bf16_t* C, bf16_t* C1, int ldc, unsigned char* shm) {
  pg8::Gemm g; g.A = A; g.Bt = Bt; g.M = M; g.N = N; g.K = K; g.Kext = K / 2;
  pg8::SplitK2Order S; S.init(M, N, (int)gridDim.x, obid());
  pg8::EpiStore E; E.O = C; E.ldc = ldc; E.O1 = C1;
  pg8::gemm_phase(( __attribute__((address_space(3))) unsigned char*)shm, g, S, E);
}
DI void gemm_resid_phase(CPR p, const bf16_t* A, int K, const bf16_t* Bt, int l, int gate_off, bool first, bool splitk, unsigned char* shm, bool dummy = false) {
  pg8::Gemm g; g.A = A; g.Bt = Bt; g.M = 8192; g.N = 1024; g.K = K; g.Kext = splitk ? K / 2 : K;
  pg8::EpiResid E; E.xp = p.in[I_XP]; E.xs = p.in[I_XS]; E.out = p.out; E.mods_l = (const float*)(p.ws + OFF_MODS) + (size_t)l * 3 * 6144; E.gate_off = gate_off; E.first = first ? 1 : 0;
  E.p1 = (float*)(p.ws + OFF_BIG);
  if (dummy) { E.out = (float*)(p.ws + OFF_BIG) + 8388608; E.p1 = E.out; E.first = 0; }
  if (splitk) {
    pg8::SplitK2Order S; S.init(8192, 1024, (int)gridDim.x, obid());
    pg8::gemm_phase(( __attribute__((address_space(3))) unsigned char*)shm, g, S, E);
  } else {
    pg8::StaticOrder S; S.init(8192, 1024, (int)gridDim.x, obid());
    pg8::gemm_phase(( __attribute__((address_space(3))) unsigned char*)shm, g, S, E);
  }
}

DI void mods_item(CPR p, int it, char* smem) {
  const int tid = vtid();
  const int l = it / 96, n0 = (it % 96) * 64;
  float* sc = (float*)smem;
  float* red = sc + 3072;
  for (int i = tid; i < 3072; i += 256) {
    int rr = i >> 10, k = i & 1023;
    float cv = (rr == 0) ? p.in[I_CCTX][k] : p.in[I_C][(rr - 1) * 1024 + k];
    sc[i] = siluf(cv);
  }
  __syncthreads();
  const int cq = tid & 15, ks = tid >> 4;
  float a0[4] = {0, 0, 0, 0}, a1[4] = {0, 0, 0, 0}, a2[4] = {0, 0, 0, 0};
  const float* w = p.in[I_ADAW] + ((size_t)l * 1024 + ks * 64) * 6144 + n0 + cq * 4;
#pragma unroll 8
  for (int kk = 0; kk < 64; ++kk) {
    float4 w4 = *(const float4*)(w + (size_t)kk * 6144);
    int k = ks * 64 + kk;
    float s0 = sc[k], s1 = sc[1024 + k], s2 = sc[2048 + k];
    a0[0] += s0 * w4.x; a0[1] += s0 * w4.y; a0[2] += s0 * w4.z; a0[3] += s0 * w4.w;
    a1[0] += s1 * w4.x; a1[1] += s1 * w4.y; a1[2] += s1 * w4.z; a1[3] += s1 * w4.w;
    a2[0] += s2 * w4.x; a2[1] += s2 * w4.y; a2[2] += s2 * w4.z; a2[3] += s2 * w4.w;
  }
#pragma unroll
  for (int j = 0; j < 4; ++j) {
    red[(ks * 3 + 0) * 64 + cq * 4 + j] = a0[j];
    red[(ks * 3 + 1) * 64 + cq * 4 + j] = a1[j];
    red[(ks * 3 + 2) * 64 + cq * 4 + j] = a2[j];
  }
  __syncthreads();
  if (tid < 192) {
    int rr = tid >> 6, n = tid & 63;
    float s = 0.f;
#pragma unroll
    for (int k2 = 0; k2 < 16; ++k2) s += red[(k2 * 3 + rr) * 64 + n];
    float* mods = (float*)(p.ws + OFF_MODS);
    mods[(size_t)(l * 3 + rr) * 6144 + n0 + n] = s + p.in[I_ADAB][l * 6144 + n0 + n];
  }
  __syncthreads();
}

DI void conv_tile(CPR p, int t, char* smem) {
  const float* src = nullptr; size_t dsto = 0; int K = 0, N = 0, tt = -1;
  int rem = t;
#define JOB(SRC, DST, KK, NN) { int nt_ = ((KK) / 64) * (((NN) + 63) / 64); if (rem >= 0 && rem < nt_) { src = (SRC); dsto = (DST); K = (KK); N = (NN); tt = rem; } rem -= nt_; }
  JOB(p.in[I_NAQKV], W_NA_QKV, 1024, 3072)
  JOB(p.in[I_NAO], W_NA_O, 1024, 1024)
  JOB(p.in[I_GQKVG], W_GLA_QKVG, 1024, 3072)
  JOB(p.in[I_GG1], W_GLA_QKVG + 3072ull * 1024, 1024, 16)
  JOB(p.in[I_GG1] + 1024 * 16, W_GLA_QKVG + 3088ull * 1024, 1024, 16)
  JOB(p.in[I_GO], W_GLA_O, 1024, 1024)
  JOB(p.in[I_DQKV], W_DIFF_QKV, 1024, 3072)
  JOB(p.in[I_DO], W_DIFF_O, 1024, 1024)
  JOB(p.in[I_MDQ], W_MLA_DQKV, 1024, 384)
  JOB(p.in[I_MDKV], W_MLA_DQKV + 384ull * 1024, 1024, 288)
  JOB(p.in[I_MUQ], W_MLA_UQ, 384, 1536)
  JOB(p.in[I_MUKV], W_MLA_UKV, 256, 2048)
  JOB(p.in[I_MO], W_MLA_O, 1024, 1024)
  JOB(p.in[I_WUP] + 0ull * 1024 * 5632, W_UP + 0ull * 5632 * 1024, 1024, 5632)
  JOB(p.in[I_WUP] + 1ull * 1024 * 5632, W_UP + 1ull * 5632 * 1024, 1024, 5632)
  JOB(p.in[I_WUP] + 2ull * 1024 * 5632, W_UP + 2ull * 5632 * 1024, 1024, 5632)
  JOB(p.in[I_WUP] + 3ull * 1024 * 5632, W_UP + 3ull * 5632 * 1024, 1024, 5632)
  JOB(p.in[I_WDOWN] + 0ull * 2816 * 1024, W_DOWN + 0ull * 2816 * 1024, 2816, 1024)
  JOB(p.in[I_WDOWN] + 1ull * 2816 * 1024, W_DOWN + 1ull * 2816 * 1024, 2816, 1024)
  JOB(p.in[I_WDOWN] + 2ull * 2816 * 1024, W_DOWN + 2ull * 2816 * 1024, 2816, 1024)
  JOB(p.in[I_WDOWN] + 3ull * 2816 * 1024, W_DOWN + 3ull * 2816 * 1024, 2816, 1024)
#undef JOB
  if (tt < 0) return;
  const int tid = vtid();
  const int nnt = (N + 63) / 64;
  const int k0 = (tt / nnt) * 64, n0 = (tt % nnt) * 64;
  float* tl = (float*)smem;
#pragma unroll
  for (int i = 0; i < 4; ++i) {
    int id = tid + 256 * i, kr = id >> 4, c4 = id & 15;
    int n = n0 + c4 * 4;
    float4 v = make_float4(0.f, 0.f, 0.f, 0.f);
    if (n < N) v = *(const float4*)(src + (size_t)(k0 + kr) * N + n);
    tl[kr * 65 + c4 * 4 + 0] = v.x; tl[kr * 65 + c4 * 4 + 1] = v.y; tl[kr * 65 + c4 * 4 + 2] = v.z; tl[kr * 65 + c4 * 4 + 3] = v.w;
  }
  __syncthreads();
  bf16_t* dst = (bf16_t*)p.ws + dsto;
  const int n = tid & 63, kg = tid >> 6;
  if (n0 + n < N) {
#pragma unroll
    for (int g2 = 0; g2 < 2; ++g2) {
      int g = kg + 4 * g2;
      uint4 q;
      q.x = pack2(tl[(g * 8 + 0) * 65 + n], tl[(g * 8 + 1) * 65 + n]);
      q.y = pack2(tl[(g * 8 + 2) * 65 + n], tl[(g * 8 + 3) * 65 + n]);
      q.z = pack2(tl[(g * 8 + 4) * 65 + n], tl[(g * 8 + 5) * 65 + n]);
      q.w = pack2(tl[(g * 8 + 6) * 65 + n], tl[(g * 8 + 7) * 65 + n]);
      *(uint4*)(dst + (size_t)(n0 + n) * K + k0 + g * 8) = q;
    }
  }
  __syncthreads();
}
constexpr int CONV_TILES = 768 + 256 + 768 + 16 + 16 + 256 + 768 + 256 + 96 + 80 + 144 + 128 + 256 + 4 * 1408 + 4 * 704;

DI void phase0(CPR p, char* smem0) {
  char* smem = smem0 + (otid() >> 8) * 65536;
  const int nm0 = ((int)gridDim.x >= 256) ? 192 : 384;
  for (int it = vbid(); it < nm0 + 1024; it += nvb()) {
    if (it < nm0) mods_item(p, it, smem);
    else conv_tile(p, it - nm0, smem);
  }
}
DI void conv_ahead(CPR p, int l, char* smem0, int wg, int nwg) {
  char* smem = smem0 + (otid() >> 8) * 65536;
  const int vb = wg * 2 + (otid() >> 8), nv = nwg * 2;
  const int m0 = l == 0 ? 1024 : l == 1 ? 2080 : 3104, m1 = l == 0 ? 2080 : l == 1 ? 3104 : l == 2 ? 3808 : 3104;
  const int nm = m1 - m0;
  const int nmods = 0;
  const int total = nmods + 1408 + 704 + nm;
  for (int t0 = vb; t0 < total; t0 += nv) {
    if (t0 < nmods) { mods_item(p, 96 + t0, smem); continue; }
    const int t = t0 - nmods;
    int tile = t < 1408 ? 3808 + 1408 * l + t : (t < 2112 ? 9440 + 704 * l + (t - 1408) : m0 + (t - 2112));
    conv_tile(p, tile, smem);
  }
}

DI void norm_phase(CPR p, int l, int which, bool from_input, bool addp1) {
  const int lane = otid() & 63, wave = otid() >> 6;
  const float* g = p.in[which ? I_NFFN : I_NMIX] + l * 1024;
  const float* mods = (const float*)(p.ws + OFF_MODS);
  bf16_t* h = (bf16_t*)(p.ws + OFF_H);
  const int rpw = 8192 / ((int)gridDim.x * 8);
  const int row_begin = (rpw * (int)gridDim.x * 8 == 8192) ? (obid() * 8 + wave) * rpw : obid() * 8 + wave;
  const int row_end = (rpw * (int)gridDim.x * 8 == 8192) ? row_begin + rpw : 8192;
  const int row_step = (rpw * (int)gridDim.x * 8 == 8192) ? 1 : (int)gridDim.x * 8;
  for (int row = row_begin; row < row_end; row += row_step) {
    const float* x = from_input ? (row < 4096 ? p.in[I_XP] + (size_t)row * 1024 : p.in[I_XS] + (size_t)(row - 4096) * 1024) : p.out + (size_t)row * 1024;
    int mr = row < 4096 ? 0 : (row < 6144 ? 1 : 2);
    const float* md = mods + (size_t)(l * 3 + mr) * 6144 + which * 3072;
    float4 v[4];
    float ss = 0.f;
#pragma unroll
    for (int j = 0; j < 4; ++j) {
      v[j] = *(const float4*)(x + j * 256 + lane * 4);
      if (addp1) {
        const float4 q = *(const float4*)((const float*)(p.ws + OFF_BIG) + (size_t)row * 1024 + j * 256 + lane * 4);
        v[j].x += q.x; v[j].y += q.y; v[j].z += q.z; v[j].w += q.w;
        *(float4*)(p.out + (size_t)row * 1024 + j * 256 + lane * 4) = v[j];
      }
      ss += v[j].x * v[j].x + v[j].y * v[j].y + v[j].z * v[j].z + v[j].w * v[j].w;
    }
#pragma unroll
    for (int o = 32; o >= 1; o >>= 1) ss += __shfl_xor(ss, o);
    float rs = rsqrtf(ss * (1.f / 1024.f) + 1e-6f);
#pragma unroll
    for (int j = 0; j < 4; ++j) {
      int col = j * 256 + lane * 4;
      float4 gg = *(const float4*)(g + col), sh = *(const float4*)(md + col), scl = *(const float4*)(md + 1024 + col);
      float y0 = v[j].x * rs * gg.x * (1.f + scl.x) + sh.x;
      float y1 = v[j].y * rs * gg.y * (1.f + scl.y) + sh.y;
      float y2 = v[j].z * rs * gg.z * (1.f + scl.z) + sh.z;
      float y3 = v[j].w * rs * gg.w * (1.f + scl.w) + sh.w;
      uint2 q; q.x = pack2(y0, y1); q.y = pack2(y2, y3);
      *(uint2*)(h + (size_t)row * 1024 + col) = q;
    }
  }
}

DI void final_add_phase(CPR p) {
  const float* p1 = (const float*)(p.ws + OFF_BIG);
  for (int idx = gtid(); idx < 8192 * 256; idx += gthreads()) {
    float4 a = *(const float4*)(p.out + (size_t)idx * 4), b = *(const float4*)(p1 + (size_t)idx * 4);
    a.x += b.x; a.y += b.y; a.z += b.z; a.w += b.w;
    *(float4*)(p.out + (size_t)idx * 4) = a;
  }
}

DI void convgate_phase(CPR p, int l) {
  const bf16_t* u = (const bf16_t*)(p.ws + OFF_BIG);
  bf16_t* a = (bf16_t*)(p.ws + OFF_MIX);
  const float* cw = p.in[I_CONVW] + (size_t)l * 3 * 5632;
  const float* cb = p.in[I_CONVB] + (size_t)l * 5632;
  for (int idx = gtid(); idx < 1024 * 352; idx += gthreads()) {
    int rg = idx / 352, f = (idx % 352) * 8;
    int row0 = rg * 8;
    int T = row0 < 4096 ? 256 : 2048;
    int t0 = row0 < 4096 ? (row0 & 255) : ((row0 - 4096) & 2047);
    float w0g[8], w1g[8], w2g[8], bg[8], w0v[8], w1v[8], w2v[8], bv[8];
#pragma unroll
    for (int e2 = 0; e2 < 8; ++e2) {
      w0g[e2] = cw[f + e2]; w1g[e2] = cw[5632 + f + e2]; w2g[e2] = cw[2 * 5632 + f + e2]; bg[e2] = cb[f + e2];
      w0v[e2] = cw[2816 + f + e2]; w1v[e2] = cw[5632 + 2816 + f + e2]; w2v[e2] = cw[2 * 5632 + 2816 + f + e2]; bv[e2] = cb[2816 + f + e2];
    }
    const bf16_t* ur = u + (size_t)row0 * 5632 + f;
    float gp[8], vp[8], gc[8], vc[8], gn[8], vn[8];
    if (t0 > 0) { load_bf16_row<8>(ur - 5632, gp); load_bf16_row<8>(ur - 5632 + 2816, vp); }
    else {
#pragma unroll
      for (int e2 = 0; e2 < 8; ++e2) { gp[e2] = 0.f; vp[e2] = 0.f; }
    }
    load_bf16_row<8>(ur, gc); load_bf16_row<8>(ur + 2816, vc);
#pragma unroll
    for (int j = 0; j < 8; ++j) {
      if (t0 + j < T - 1) { load_bf16_row<8>(ur + (size_t)(j + 1) * 5632, gn); load_bf16_row<8>(ur + (size_t)(j + 1) * 5632 + 2816, vn); }
      else {
#pragma unroll
        for (int e2 = 0; e2 < 8; ++e2) { gn[e2] = 0.f; vn[e2] = 0.f; }
      }
      float res[8];
#pragma unroll
      for (int e2 = 0; e2 < 8; ++e2) {
        float gg = gp[e2] * w0g[e2] + gc[e2] * w1g[e2] + gn[e2] * w2g[e2] + bg[e2];
        float vv = vp[e2] * w0v[e2] + vc[e2] * w1v[e2] + vn[e2] * w2v[e2] + bv[e2];
        res[e2] = siluf(gg) * vv;
      }
      store_bf16_row<8>(a + (size_t)(row0 + j) * 2816 + f, res);
#pragma unroll
      for (int e2 = 0; e2 < 8; ++e2) { gp[e2] = gc[e2]; vp[e2] = vc[e2]; gc[e2] = gn[e2]; vc[e2] = vn[e2]; }
    }
  }
}

template <int DQK, int DV, class TileF, class ScoreF>
DI void flash_wave(const bf16_t* q0, int ntiles, float scale, TileF tilef, ScoreF scoref, f32x16 (&O)[DV / 32], float& m_run, float& l_run, int r, int hh) {
  constexpr int NK = DQK / 16, NV = DV / 32;
  bf16x8 qf[NK];
#pragma unroll
  for (int kk = 0; kk < NK; ++kk) qf[kk] = *(const bf16x8*)(q0 + (size_t)r * DQK + kk * 16 + hh * 8);
#pragma unroll
  for (int t = 0; t < NV; ++t)
#pragma unroll
    for (int i = 0; i < 16; ++i) O[t][i] = 0.f;
  m_run = 0.f;
  l_run = 0.f;
  constexpr bool PREFV = (DV <= 64);
  bf16x8 kc[NK], vc[2][NV];
  auto loadk = [&](int it, bf16x8 (&k)[NK]) {
    const bf16_t* kp; const bf16_t* vp; int vs;
    tilef(it, kp, vp, vs);
    const unsigned ko = (unsigned)r * DQK + hh * 8;
#pragma unroll
    for (int kk = 0; kk < NK; ++kk) k[kk] = *(const bf16x8*)(kp + (ko + kk * 16));
  };
  auto loadv = [&](int it, bf16x8 (&v)[2][NV]) {
    const bf16_t* kp; const bf16_t* vp; int vs;
    tilef(it, kp, vp, vs);
#pragma unroll
    for (int s2 = 0; s2 < 2; ++s2)
#pragma unroll
      for (int t = 0; t < NV; ++t) v[s2][t] = *(const bf16x8*)(vp + ((unsigned)r * (unsigned)vs + 8u * hh + (unsigned)(t * 32) * (unsigned)vs + 16u * s2));
  };
  loadk(0, kc);
  if (PREFV) loadv(0, vc);
  for (int it = 0; it < ntiles; ++it) {
    bf16x8 kn[NK], vn[2][NV];
    const int nx = min(it + 1, ntiles - 1);
    loadk(nx, kn);
    if (PREFV) loadv(nx, vn); else loadv(it, vc);
    f32x16 s;
#pragma unroll
    for (int i = 0; i < 16; ++i) s[i] = -m_run;
#pragma unroll
    for (int kk = 0; kk < NK; ++kk) s = MFMA32(kc[kk], qf[kk], s);
    float mx = -1e30f;
#pragma unroll
    for (int i = 0; i < 16; ++i) { float v = scoref(it, i, s[i]); s[i] = v; mx = fmaxf(mx, v); }
    if (__any(mx > 8.f)) {
      mx = fmaxf(mx, __shfl_xor(mx, 32));
      const float delta = fmaxf(mx, 0.f);
      const float alpha = __builtin_amdgcn_exp2f(-delta);
      m_run += delta;
      l_run *= alpha;
#pragma unroll
      for (int i = 0; i < 16; ++i) s[i] -= delta;
#pragma unroll
      for (int t = 0; t < NV; ++t)
#pragma unroll
        for (int i = 0; i < 16; ++i) O[t][i] *= alpha;
    }
    float sum = 0.f;
#pragma unroll
    for (int i = 0; i < 16; ++i) { float pv = __builtin_amdgcn_exp2f(s[i]); s[i] = pv; sum += pv; }
    l_run += sum;
#pragma unroll
    for (int s2 = 0; s2 < 2; ++s2) {
      union { uint4 q; bf16x8 v; } pb;
      pb.q.x = pack2(s[8 * s2 + 0], s[8 * s2 + 1]); pb.q.y = pack2(s[8 * s2 + 2], s[8 * s2 + 3]);
      pb.q.z = pack2(s[8 * s2 + 4], s[8 * s2 + 5]); pb.q.w = pack2(s[8 * s2 + 6], s[8 * s2 + 7]);
#pragma unroll
      for (int t = 0; t < NV; ++t) O[t] = MFMA32(vc[s2][t], pb.v, O[t]);
    }
#pragma unroll
    for (int kk = 0; kk < NK; ++kk) kc[kk] = kn[kk];
    if (PREFV) {
#pragma unroll
      for (int s2 = 0; s2 < 2; ++s2)
#pragma unroll
        for (int t = 0; t < NV; ++t) vc[s2][t] = vn[s2][t];
    }
  }
  l_run += __shfl_xor(l_run, 32);
}
template <int DQK, int DV, int NKS, bool PIPE>
DI void flash_block(const bf16_t* q0, int ntiles, float scale, const bf16_t* kb0, const bf16_t* kb1, const bf16_t* vb, int vs, char* lds, int ks,
                    f32x16 (&O)[DV / 32], float& m_run, float& l_run, int tid, int r, int hh) {
  constexpr int NK = DQK / 16, NV = DV / 32;
  constexpr int KROW = DQK * 2 + 16, VROW = 80;
  constexpr int KBYTES = NKS * 32 * KROW, STAGE = KBYTES + DV * VROW;
  constexpr int KCH = 32 * (DQK / 8), NKC = NKS * KCH, TOT = NKC + DV * 4, NJ = (TOT + 255) / 256;
  bf16x8 qf[NK];
#pragma unroll
  for (int kk = 0; kk < NK; ++kk) qf[kk] = *(const bf16x8*)(q0 + (size_t)r * DQK + kk * 16 + hh * 8);
#pragma unroll
  for (int t = 0; t < NV; ++t)
#pragma unroll
    for (int i = 0; i < 16; ++i) O[t][i] = 0.f;
  m_run = 0.f;
  l_run = 0.f;
  static_assert(NJ >= 3 && NJ <= 4, "loader written for 3 or 4 chunks per thread");
  const bf16_t *gp0, *gp1, *gp2, *gp3; int gi0, gi1, gi2, gi3, lo0, lo1, lo2, lo3;
  auto setup = [&](int j, const bf16_t*& gp, int& ginc, int& loff) __attribute__((always_inline)) {
    int c = tid + 256 * j;
    if (c >= TOT) c -= 256;
    if (c < NKC) {
      int s = c / KCH, rem = c % KCH, row = rem / (DQK / 8), c8 = rem % (DQK / 8);
      gp = (s == 0 ? kb0 : kb1) + (size_t)row * DQK + c8 * 8;
      ginc = 32 * DQK;
      loff = s * 32 * KROW + row * KROW + c8 * 16;
    } else {
      int c2 = c - NKC;
      int dv = c2 >> 2, q = c2 & 3;
      gp = vb + c2 * 8;
      ginc = DV * 32;
      loff = KBYTES + dv * VROW + q * 16;
    }
  };
  setup(0, gp0, gi0, lo0); setup(1, gp1, gi1, lo1); setup(2, gp2, gi2, lo2); setup(NJ > 3 ? 3 : 2, gp3, gi3, lo3);
  uint4 sa0, sa1, sa2, sa3, sb0, sb1, sb2, sb3;
#define gload(S, IT) do { S##0 = *(const uint4*)(gp0 + (size_t)(IT) * gi0); S##1 = *(const uint4*)(gp1 + (size_t)(IT) * gi1); S##2 = *(const uint4*)(gp2 + (size_t)(IT) * gi2); \
    if (NJ > 3) S##3 = *(const uint4*)(gp3 + (size_t)(IT) * gi3); } while (0)
#define swrite(S, SI) do { char* sd_ = lds + (SI) * STAGE; *(uint4*)(sd_ + lo0) = S##0; *(uint4*)(sd_ + lo1) = S##1; *(uint4*)(sd_ + lo2) = S##2; if (NJ > 3) *(uint4*)(sd_ + lo3) = S##3; } while (0)
  const int koff = ks * 32 * KROW + r * KROW + hh * 16;
  const int voff = KBYTES + r * VROW + hh * 16;
  int stg = 0;
  if constexpr (PIPE) {
    gload(sa, 0);
    gload(sb, min(1, ntiles - 1));
    __syncthreads();
    swrite(sa, 0);
    swrite(sb, 1);
    gload(sb, min(2, ntiles - 1));
    __syncthreads();
    f32x16 sn;
#pragma unroll
    for (int i = 0; i < 16; ++i) sn[i] = 0.f;
#pragma unroll
    for (int kk = 0; kk < NK; ++kk) { bf16x8 kf = *(const bf16x8*)(lds + koff + kk * 32); sn = MFMA32(kf, qf[kk], sn); }
#define FB_BODY_P(IT, SLOAD, SWRITE) do { \
      gload(SLOAD, min((IT) + 3, ntiles - 1)); \
      const char* sb = lds + stg * STAGE; \
      const int stg1 = (stg == 2) ? 0 : stg + 1; \
      const char* sbnx = lds + stg1 * STAGE; \
      f32x16 s = sn; \
      _Pragma("unroll") for (int i = 0; i < 16; ++i) sn[i] = -m_run; \
      _Pragma("unroll") for (int kk = 0; kk < NK; ++kk) { bf16x8 kf = *(const bf16x8*)(sbnx + koff + kk * 32); sn = MFMA32(kf, qf[kk], sn); } \
      float mx = -1e30f; \
      _Pragma("unroll") for (int i = 0; i < 16; ++i) mx = fmaxf(mx, s[i]); \
      if (__any(mx > 8.f)) { \
        mx = fmaxf(mx, __shfl_xor(mx, 32)); \
        const float delta = fmaxf(mx, 0.f); \
        const float alpha = __builtin_amdgcn_exp2f(-delta); \
        m_run += delta; \
        l_run *= alpha; \
        _Pragma("unroll") for (int i = 0; i < 16; ++i) { s[i] -= delta; sn[i] -= delta; } \
        _Pragma("unroll") for (int t = 0; t < NV; ++t) _Pragma("unroll") for (int i = 0; i < 16; ++i) O[t][i] *= alpha; \
      } \
      float sum = 0.f; \
      _Pragma("unroll") for (int i = 0; i < 16; ++i) { float pv = __builtin_amdgcn_exp2f(s[i]); s[i] = pv; sum += pv; } \
      l_run += sum; \
      _Pragma("unroll") for (int s2 = 0; s2 < 2; ++s2) { \
        union { uint4 q; bf16x8 v; } pb; \
        pb.q.x = pack2(s[8 * s2 + 0], s[8 * s2 + 1]); pb.q.y = pack2(s[8 * s2 + 2], s[8 * s2 + 3]); \
        pb.q.z = pack2(s[8 * s2 + 4], s[8 * s2 + 5]); pb.q.w = pack2(s[8 * s2 + 6], s[8 * s2 + 7]); \
        _Pragma("unroll") for (int t = 0; t < NV; ++t) { bf16x8 vf = *(const bf16x8*)(sb + voff + t * 32 * VROW + s2 * 32); O[t] = MFMA32(vf, pb.v, O[t]); } \
      } \
      swrite(SWRITE, (stg1 == 2) ? 0 : stg1 + 1); \
      stg = stg1; \
      __syncthreads(); \
    } while (0)
    for (int it = 0; it < ntiles; it += 2) {
      FB_BODY_P(it, sa, sb);
      FB_BODY_P(it + 1, sb, sa);
    }
#undef FB_BODY_P
    l_run += __shfl_xor(l_run, 32);
    return;
  }
  gload(sa, 0);
  gload(sb, 1);
  __syncthreads();
  swrite(sa, 0);
  __syncthreads();
#define FB_BODY(IT, SLOAD, SWRITE) do { \
    gload(SLOAD, min((IT) + 2, ntiles - 1)); \
    const char* sb = lds + stg * STAGE; \
    f32x16 s; \
    _Pragma("unroll") for (int i = 0; i < 16; ++i) s[i] = -m_run; \
    _Pragma("unroll") for (int kk = 0; kk < NK; ++kk) { bf16x8 kf = *(const bf16x8*)(sb + koff + kk * 32); s = MFMA32(kf, qf[kk], s); } \
    float mx = -1e30f; \
    _Pragma("unroll") for (int i = 0; i < 16; ++i) mx = fmaxf(mx, s[i]); \
    if (__any(mx > 8.f)) { \
      mx = fmaxf(mx, __shfl_xor(mx, 32)); \
      const float delta = fmaxf(mx, 0.f); \
      const float alpha = __builtin_amdgcn_exp2f(-delta); \
      m_run += delta; \
      l_run *= alpha; \
      _Pragma("unroll") for (int i = 0; i < 16; ++i) s[i] -= delta; \
      _Pragma("unroll") for (int t = 0; t < NV; ++t) _Pragma("unroll") for (int i = 0; i < 16; ++i) O[t][i] *= alpha; \
    } \
    float sum = 0.f; \
    _Pragma("unroll") for (int i = 0; i < 16; ++i) { float pv = __builtin_amdgcn_exp2f(s[i]); s[i] = pv; sum += pv; } \
    l_run += sum; \
    _Pragma("unroll") for (int s2 = 0; s2 < 2; ++s2) { \
      union { uint4 q; bf16x8 v; } pb; \
      pb.q.x = pack2(s[8 * s2 + 0], s[8 * s2 + 1]); pb.q.y = pack2(s[8 * s2 + 2], s[8 * s2 + 3]); \
      pb.q.z = pack2(s[8 * s2 + 4], s[8 * s2 + 5]); pb.q.w = pack2(s[8 * s2 + 6], s[8 * s2 + 7]); \
      _Pragma("unroll") for (int t = 0; t < NV; ++t) { bf16x8 vf = *(const bf16x8*)(sb + voff + t * 32 * VROW + s2 * 32); O[t] = MFMA32(vf, pb.v, O[t]); } \
    } \
    stg = (stg == 2) ? 0 : stg + 1; \
    swrite(SWRITE, stg); \
    __syncthreads(); \
  } while (0)
  for (int it = 0; it < ntiles; it += 2) {
    FB_BODY(it, sa, sb);
    FB_BODY(it + 1, sb, sa);
  }
#undef FB_BODY
  l_run += __shfl_xor(l_run, 32);
}
#undef gload
#undef swrite
template <int NT> DI void store_o(bf16_t* o, int ldo, f32x16 (&O)[NT], float linv, int r, int hh) {
#pragma unroll
  for (int t = 0; t < NT; ++t)
#pragma unroll
    for (int ig = 0; ig < 4; ++ig) {
      uint2 q;
      q.x = pack2(O[t][ig * 4 + 0] * linv, O[t][ig * 4 + 1] * linv);
      q.y = pack2(O[t][ig * 4 + 2] * linv, O[t][ig * 4 + 3] * linv);
      *(uint2*)(o + (size_t)r * ldo + t * 32 + 8 * ig + 4 * hh) = q;
    }
}

template <bool ROPE> DI void headnorm8(float (&v)[8], const float* g, int sub, float extra, int t) {
  float ss = 0.f;
#pragma unroll
  for (int e = 0; e < 8; ++e) ss += v[e] * v[e];
  ss += __shfl_xor(ss, 1); ss += __shfl_xor(ss, 2); ss += __shfl_xor(ss, 4);
  const float rs = rsqrtf(ss * (1.f / 64.f) + 1e-6f) * extra;
  const float4 g0 = *(const float4*)(g + sub * 8), g1 = *(const float4*)(g + sub * 8 + 4);
  v[0] *= rs * g0.x; v[1] *= rs * g0.y; v[2] *= rs * g0.z; v[3] *= rs * g0.w;
  v[4] *= rs * g1.x; v[5] *= rs * g1.y; v[6] *= rs * g1.z; v[7] *= rs * g1.w;
  if (ROPE) {
    const float pos = (sub & 4) ? (float)(t & 63) : (float)(t >> 6);
    const bool second = (sub >> 1) & 1;
#pragma unroll
    for (int e = 0; e < 8; ++e) {
      const float other = __shfl_xor(v[e], 2);
      const int f = (sub & 1) * 8 + e;
      const float ang = pos * exp2f(-(float)f * (13.287712379549449f / 16.f));
      const float c = __cosf(ang), s = __sinf(ang);
      v[e] = second ? (other * s + v[e] * c) : (v[e] * c - other * s);
    }
  }
}

constexpr size_t L0_QB = 0, L0_KB = 16 * MB, L0_VT = 32 * MB, L0_KC = 48 * MB, L0_VCT = 49 * MB;
DI void prep0_phase(CPR p) {
  const bf16_t* big = (const bf16_t*)(p.ws + OFF_BIG);
  char* mix = p.ws + OFF_MIX;
  bf16_t* qb = (bf16_t*)(mix + L0_QB); bf16_t* kb = (bf16_t*)(mix + L0_KB); bf16_t* vT = (bf16_t*)(mix + L0_VT);
  bf16_t* kc = (bf16_t*)(mix + L0_KC); bf16_t* vcT = (bf16_t*)(mix + L0_VCT);
  for (int idx = gtid(); idx < 2 * 8192 * 16 * 8; idx += gthreads()) {
    int sub = idx & 7, hd = (idx >> 3) & 15, row = (idx >> 7) & 8191, which = idx >> 20;
    float v[8];
    load_bf16_row<8>(big + (size_t)row * 3072 + which * 1024 + hd * 64 + sub * 8, v);
    headnorm8<false>(v, p.in[which ? I_NAKN : I_NAQN], sub, which ? 1.f : 0.125f * 1.4426950408889634f, 0);
    store_bf16_row<8>((which ? kb : qb) + ((size_t)hd * 8192 + row) * 64 + sub * 8, v);
    if (which && row < 4096) store_f32_row<8>(p.out + O_L0K + (((size_t)(row >> 8) * 16 + hd) * 256 + (row & 255)) * 64 + sub * 8, v);
  }
  for (int idx = gtid(); idx < 4096 * 128; idx += gthreads()) {
    int row = idx >> 7, c = (idx & 127) * 8;
    float v[8];
    load_bf16_row<8>(big + (size_t)row * 3072 + 2048 + c, v);
    int hd = c >> 6, d = c & 63;
    store_f32_row<8>(p.out + O_L0V + (((size_t)(row >> 8) * 16 + hd) * 256 + (row & 255)) * 64 + d, v);
  }
  transpose_gen<true>(1024, 8192, vT, 8192, [&](int rr, int c) { return big[(size_t)rr * 3072 + 2048 + c]; });
  const float* ck = p.in[I_C0K]; const float* cv = p.in[I_C0V];
  for (int idx = gtid(); idx < 2 * 16 * 256 * 64 / 8; idx += gthreads()) {
    float v[8];
#pragma unroll
    for (int e = 0; e < 8; ++e) v[e] = ck[(size_t)idx * 8 + e];
    store_bf16_row<8>(kc + (size_t)idx * 8, v);
  }
  transpose_gen<true>(2048, 256, vcT, 256, [&](int l_, int c) { return f2bf(cv[((size_t)(c >> 6) * 256 + l_) * 64 + (c & 63)]); });
}

DI void attn0_phase(CPR p, char* smem0) {
  char* smem = smem0 + (otid() >> 8) * 65536;
  const int tid = vtid(), lane = tid & 63, wave = tid >> 6, r = lane & 31, hh = lane >> 5;
  char* mix = p.ws + OFF_MIX;
  const bf16_t* qb = (const bf16_t*)(mix + L0_QB); const bf16_t* kb = (const bf16_t*)(mix + L0_KB); const bf16_t* vT = (const bf16_t*)(mix + L0_VT);
  const bf16_t* kc = (const bf16_t*)(mix + L0_KC); const bf16_t* vcT = (const bf16_t*)(mix + L0_VCT);
  bf16_t* o = (bf16_t*)(p.ws + OFF_O);
  float* sbias = (float*)smem;
  for (int it = vbid(); it < 1024; it += nvb()) {
    f32x16 O[2];
    float m_run, l_run;
    if (it < 512) {
      int b = it >> 8, hd = (it >> 4) & 15, blk = it & 15;
      __syncthreads();
      for (int i = tid; i < 465; i += 256) sbias[i] = p.in[I_NABIAS][hd * 465 + i] * 1.4426950408889634f;
      __syncthreads();
      int gr = blk * 2 + (wave >> 1), cq0 = (wave & 1) * 32;
      int grow_q = 4096 + b * 2048 + gr * 64 + cq0;
      int kr0 = min(max(gr - 4, 0), 24);
      int qc = cq0 + r;
      int win0 = min(max(qc - 8, 0), 48);
      const bf16_t* kcb = kc + (size_t)(b * 16 + hd) * 256 * 64;
      const bf16_t* vcb = vcT + (size_t)(b * 16 + hd) * 64 * 256;
      const bf16_t* kbb = kb + ((size_t)hd * 8192 + 4096 + b * 2048) * 64;
      const bf16_t* vtb = vT + (size_t)hd * 64 * 8192 + 4096 + b * 2048;
      flash_wave<64, 64>(qb + ((size_t)hd * 8192 + grow_q) * 64, 24, 0.125f * 1.4426950408889634f,
        [&](int ti, const bf16_t*& kp, const bf16_t*& vp, int& vs) {
          if (ti < 8) { kp = kcb + ti * 32 * 64; vp = vcb + ti * 32; vs = 256; }
          else { int lt = ti - 8; int tok = (kr0 + (lt >> 1)) * 64 + (lt & 1) * 32; kp = kbb + (size_t)tok * 64; vp = vtb + tok; vs = 8192; }
        },
        [&](int ti, int i, float s) {
          if (ti < 8) return s;
          int lt = ti - 8;
          int kcol = (lt & 1) * 32 + crow(i, hh);
          int roff = kr0 + (lt >> 1) - gr + 7;
          int coff = min(max(kcol - qc + 15, 0), 30);
          bool valid = (kcol >= win0) && (kcol < win0 + 16);
          return valid ? s + sbias[roff * 31 + coff] : -1e30f;
        },
        O, m_run, l_run, r, hh);
      store_o<2>(o + (size_t)grow_q * 1024 + hd * 64, 1024, O, 1.f / l_run, r, hh);
    } else {
      int pi = it - 512;
      int b = pi >> 5, hd = (pi >> 1) & 15, qbk = pi & 1;
      int grow_q = b * 256 + qbk * 128 + wave * 32;
      const bf16_t* kbb = kb + ((size_t)hd * 8192 + b * 256) * 64;
      const bf16_t* vtb = vT + (size_t)hd * 64 * 8192 + b * 256;
      flash_wave<64, 64>(qb + ((size_t)hd * 8192 + grow_q) * 64, 8, 0.125f * 1.4426950408889634f,
        [&](int ti, const bf16_t*& kp, const bf16_t*& vp, int& vs) { kp = kbb + ti * 32 * 64; vp = vtb + ti * 32; vs = 8192; },
        [&](int, int, float s) { return s; }, O, m_run, l_run, r, hh);
      store_o<2>(o + (size_t)grow_q * 1024 + hd * 64, 1024, O, 1.f / l_run, r, hh);
    }
  }
}

constexpr size_t L1_QE = 0, L1_KE = 16 * MB, L1_KDT = 32 * MB, L1_VT = 48 * MB, L1_DTOT = 64 * MB;
constexpr size_t L1_ODIR = 8192ull * 3328 * 2;
DI void prep1_phase(CPR p, char* smem0) {
  char* smem = smem0 + (otid() >> 8) * 65536;
  const int tid = vtid();
  const bf16_t* big = (const bf16_t*)(p.ws + OFF_BIG);
  char* mix = p.ws + OFF_MIX;
  bf16_t* qe = (bf16_t*)(mix + L1_QE); bf16_t* ke = (bf16_t*)(mix + L1_KE); bf16_t* kdT = (bf16_t*)(mix + L1_KDT);
  bf16_t* vT = (bf16_t*)(mix + L1_VT); float* dtot = (float*)(mix + L1_DTOT);
  float* rr = (float*)smem;
  bf16_t* qs = (bf16_t*)(smem + 8192);
  bf16_t* ks = (bf16_t*)(smem + 8192 + 16384);
  for (int it = vbid(); it < 128 * 4; it += nvb()) {
    int ch = it >> 2, hd = it & 3;
    int grow0 = ch * 64;
    __syncthreads();
    for (int i = tid; i < 64 * 32; i += 256) rr[i] = bf2f(big[(size_t)(grow0 + (i >> 5)) * 3328 + 3072 + (i & 31)]);
#pragma unroll
    for (int j = 0; j < 4; ++j) {
      int c = tid + 256 * j, row = c >> 4, pc = c & 15;
      *(uint4*)(qs + row * 128 + pc * 8) = *(const uint4*)(big + (size_t)(grow0 + row) * 3328 + hd * 128 + pc * 8);
      *(uint4*)(ks + row * 128 + pc * 8) = *(const uint4*)(big + (size_t)(grow0 + row) * 3328 + 512 + hd * 128 + pc * 8);
    }
    __syncthreads();
    int dir = tid >> 7, k = tid & 127;
    float w2[16];
#pragma unroll
    for (int j = 0; j < 16; ++j) w2[j] = p.in[I_GG2][((size_t)dir * 16 + j) * 512 + hd * 128 + k];
    float bg = p.in[I_GBG][dir * 512 + hd * 128 + k];
    float lgv[64];
    float btot = 0.f;
#pragma unroll
    for (int t = 0; t < 64; ++t) {
      float x = bg;
      const float4* r4 = (const float4*)(rr + t * 32 + dir * 16);
#pragma unroll
      for (int j4 = 0; j4 < 4; ++j4) { float4 rv = r4[j4]; x += rv.x * w2[j4 * 4] + rv.y * w2[j4 * 4 + 1] + rv.z * w2[j4 * 4 + 2] + rv.w * w2[j4 * 4 + 3]; }
      float ls = fminf(x, 0.f) - __logf(1.f + __expf(-fabsf(x)));
      lgv[t] = ls * (1.f / 16.f);
      btot += lgv[t];
    }
    float bc = 0.f;
    size_t dbase = ((size_t)dir * 4 + hd) * 8192;
    bf16_t* kdt_row = kdT + ((((size_t)dir * 4 + hd) * 128 + ch) * 128 + k) * 64;
#pragma unroll
    for (int tt = 0; tt < 64; ++tt) {
      const int tf = tt, tb = 63 - tt;
      bc += dir ? lgv[tb] : lgv[tf];
      const int t = dir ? tb : tf;
      float qv = bf2f(qs[t * 128 + k]);
      float kv = bf2f(ks[t * 128 + k]);
      qe[(dbase + grow0 + t) * 128 + k] = f2bf(qv * 0.08838834764831845f * __expf(bc));
      ke[(dbase + grow0 + t) * 128 + k] = f2bf(kv * __expf(-bc));
      kdt_row[t] = f2bf(kv * __expf(btot - bc));
    }
    dtot[(((size_t)dir * 4 + hd) * 128 + ch) * 128 + k] = __expf(btot);
  }
  transpose_gen<false>(1024, 8192, vT, 8192, [&](int r_, int c) { return big[(size_t)r_ * 3328 + 1024 + c]; });
}

DI void scan1_phase(CPR p, char* smem0) {
  char* smem = smem0 + (otid() >> 8) * 65536;
  const int tid = vtid(), lane = tid & 63, wave = tid >> 6, r = lane & 31, hh = lane >> 5;
  char* mix = p.ws + OFF_MIX;
  const bf16_t* qe = (const bf16_t*)(mix + L1_QE); const bf16_t* ke = (const bf16_t*)(mix + L1_KE); const bf16_t* kdT = (const bf16_t*)(mix + L1_KDT);
  const bf16_t* vT = (const bf16_t*)(mix + L1_VT); const float* dtot = (const float*)(mix + L1_DTOT);
  bf16_t* odir = (bf16_t*)(p.ws + OFF_BIG + L1_ODIR);
  bf16_t* St = (bf16_t*)smem;
  bf16_t* al = (bf16_t*)(smem + 8704);
  char* vls = smem + 17920;
  float* dts = (float*)(smem + 27136);
  char* qes = smem + 28160;
  char* kes = smem + 45568;
  const int wg_ = obid(), half_ = otid() >> 8, nwg_ = (int)gridDim.x;
  const bool spread = nwg_ >= 256;
  int it0, itstep, nsync_target = 0;
  if (spread) {
    if (wg_ < 128 && half_ == 0) { it0 = wg_; itstep = 1 << 20; }
    else {
      const int lam = wg_ < 128 ? wg_ : 128 + 2 * (wg_ - 128) + half_;
      it0 = 128 + lam; itstep = 128 + 2 * (nwg_ - 128);
    }
    if (wg_ < 128) nsync_target = 1 + 3 * 32;
  } else { it0 = vbid(); itstep = nvb(); }
  int nsync_done = 0;
  for (int it = it0; it < 1152; it += itstep) {
    bool samp = it < 128;
    int q_ = samp ? it : it - 128;
    int b = q_ >> 6, hd = (q_ >> 4) & 3, dir = (q_ >> 3) & 1, vsl = q_ & 7;
    int grow0 = samp ? 4096 + b * 2048 : b * 256;
    int nc = samp ? 32 : 4;
    const int ti = wave >> 1, xi = wave & 1;
    f32x16 S;
    if (samp) {
      const float* s0 = p.in[dir ? I_SB : I_SF] + ((size_t)(b * 4 + hd) * 128) * 256;
#pragma unroll
      for (int i = 0; i < 16; ++i) S[i] = s0[(size_t)(wave * 32 + crow(i, hh)) * 256 + vsl * 32 + r];
    } else {
#pragma unroll
      for (int i = 0; i < 16; ++i) S[i] = 0.f;
    }
    auto write_St = [&]() {
#pragma unroll
      for (int ig = 0; ig < 4; ++ig) {
        uint2 q;
        q.x = pack2(S[ig * 4 + 0], S[ig * 4 + 1]);
        q.y = pack2(S[ig * 4 + 2], S[ig * 4 + 3]);
        *(uint2*)(St + r * 136 + wave * 32 + 8 * ig + 4 * hh) = q;
      }
    };
    const size_t dbase = ((size_t)dir * 4 + hd) * 8192;
    const bf16_t* vsrc = vT + ((size_t)hd * 256 + vsl * 32 + (tid >> 3)) * 8192 + (tid & 7) * 8;
    const int vdst = (tid >> 3) * 144 + (tid & 7) * 16;
    const float* dsrc = dtot + (((size_t)dir * 4 + hd) * 128) * 128 + (tid & 127);
    const bf16_t* qsrc = qe + dbase * 128 + tid * 8;
    const bf16_t* ksrc = ke + dbase * 128 + tid * 8;
    const int tdst = (tid >> 4) * 272 + (tid & 15) * 16;
    bf16x8 kd[4], kdN[4];
    uint4 vst, qst0, qst1, qst2, qst3, kst0, kst1, kst2, kst3; float dtst;
#define SC_GROW(CC) (grow0 + ((dir ? nc - 1 - (CC) : (CC)) << 6))
#define SC_LOADKD(CC, KD) do { const bf16_t* kd_p = kdT + ((((size_t)dir * 4 + hd) * 128 + (SC_GROW(CC) >> 6)) * 128 + wave * 32 + r) * 64 + hh * 8; \
      _Pragma("unroll") for (int kk = 0; kk < 4; ++kk) KD[kk] = *(const bf16x8*)(kd_p + kk * 16); } while (0)
#define SC_LOADST(CC) do { const int g_ = SC_GROW(CC); vst = *(const uint4*)(vsrc + g_); dtst = dsrc[(size_t)(g_ >> 6) * 128]; \
      const bf16_t* q_p = qsrc + (size_t)g_ * 128; const bf16_t* k_p = ksrc + (size_t)g_ * 128; \
      qst0 = *(const uint4*)(q_p); qst1 = *(const uint4*)(q_p + 2048); qst2 = *(const uint4*)(q_p + 4096); qst3 = *(const uint4*)(q_p + 6144); \
      kst0 = *(const uint4*)(k_p); kst1 = *(const uint4*)(k_p + 2048); kst2 = *(const uint4*)(k_p + 4096); kst3 = *(const uint4*)(k_p + 6144); } while (0)
#define SC_WRITEST(BUF) do { *(uint4*)(vls + (BUF) * 4608 + vdst) = vst; if (tid < 128) dts[(BUF) * 128 + tid] = dtst; \
      *(uint4*)(qes + tdst) = qst0; *(uint4*)(qes + tdst + 16 * 272) = qst1; *(uint4*)(qes + tdst + 32 * 272) = qst2; *(uint4*)(qes + tdst + 48 * 272) = qst3; \
      *(uint4*)(kes + tdst) = kst0; *(uint4*)(kes + tdst + 16 * 272) = kst1; *(uint4*)(kes + tdst + 32 * 272) = kst2; *(uint4*)(kes + tdst + 48 * 272) = kst3; } while (0)
    SC_LOADST(0);
    SC_LOADKD(0, kd);
    __syncthreads();
    write_St();
    SC_WRITEST(0);
    for (int cc = 0; cc < nc; ++cc) {
      const int ccn = min(cc + 1, nc - 1);
      const int growc = SC_GROW(cc);
      const char* vcur = vls + (cc & 1) * 4608;
      const float* dcur = dts + (cc & 1) * 128;
      SC_LOADST(ccn);
      SC_LOADKD(ccn, kdN);
      __syncthreads();
      bf16x8 qf[8];
      f32x16 acc;
#pragma unroll
      for (int i = 0; i < 16; ++i) acc[i] = 0.f;
#pragma unroll
      for (int kk = 0; kk < 8; ++kk) {
        qf[kk] = *(const bf16x8*)(qes + (ti * 32 + r) * 272 + kk * 32 + hh * 16);
        bf16x8 kf = *(const bf16x8*)(kes + (xi * 32 + r) * 272 + kk * 32 + hh * 16);
        acc = MFMA32(qf[kk], kf, acc);
      }
#pragma unroll
      for (int i = 0; i < 16; ++i) {
        int t = ti * 32 + crow(i, hh), s = xi * 32 + r;
        bool keep = dir ? (s >= t) : (s <= t);
        al[t * 72 + s] = f2bf(keep ? acc[i] : 0.f);
      }
      __syncthreads();
      if (xi == 0) {
#pragma unroll
        for (int i = 0; i < 16; ++i) acc[i] = 0.f;
#pragma unroll
        for (int kk = 0; kk < 8; ++kk) {
          bf16x8 sf = *(const bf16x8*)(St + r * 136 + kk * 16 + hh * 8);
          acc = MFMA32(qf[kk], sf, acc);
        }
#pragma unroll
        for (int kk = 0; kk < 4; ++kk) {
          bf16x8 af = *(const bf16x8*)(al + (ti * 32 + r) * 72 + kk * 16 + hh * 8);
          bf16x8 vf = *(const bf16x8*)(vcur + r * 144 + kk * 32 + hh * 16);
          acc = MFMA32(af, vf, acc);
        }
#pragma unroll
        for (int i = 0; i < 16; ++i)
          odir[((size_t)dir * 8192 + growc + ti * 32 + crow(i, hh)) * 1024 + hd * 256 + vsl * 32 + r] = f2bf(acc[i]);
      }
#pragma unroll
      for (int i = 0; i < 16; ++i) S[i] *= dcur[wave * 32 + crow(i, hh)];
#pragma unroll
      for (int kk = 0; kk < 4; ++kk) {
        bf16x8 vf = *(const bf16x8*)(vcur + r * 144 + kk * 32 + hh * 16);
        S = MFMA32(kd[kk], vf, S);
      }
      __syncthreads();
      write_St();
      SC_WRITEST((cc + 1) & 1);
#pragma unroll
      for (int kk = 0; kk < 4; ++kk) kd[kk] = kdN[kk];
    }
#undef SC_GROW
#undef SC_LOADKD
#undef SC_LOADST
#undef SC_WRITEST
    nsync_done += 1 + 3 * nc;
    if (!samp) {
      const int t2 = vtid(), r2 = t2 & 31, h2 = (t2 >> 5) & 1, w2 = t2 >> 6;
      float* so = p.out + (dir ? O_L1B : O_L1F) + ((size_t)(b * 4 + hd) * 128) * 256 + (size_t)(w2 * 32 + 4 * h2) * 256 + vsl * 32 + r2;
#pragma unroll
      for (int i = 0; i < 16; ++i) so[((i & 3) + 8 * (i >> 2)) * 256] = S[i];
    }
  }
  for (; nsync_done < nsync_target; ++nsync_done) __syncthreads();
  if (spread && wg_ >= 128) {
    __syncthreads();
    const int lam2 = 2 * (wg_ - 128) + half_;
    if (lam2 < 192) mods_item(p, 192 + lam2, smem);
  }
}

DI void gla_out_phase(CPR p) {
  const bf16_t* big = (const bf16_t*)(p.ws + OFF_BIG);
  const bf16_t* odir = (const bf16_t*)(p.ws + OFF_BIG + L1_ODIR);
  bf16_t* o = (bf16_t*)(p.ws + OFF_O);
  const float* gn = p.in[I_GON];
  for (int idx = gtid(); idx < 8192 * 4 * 32; idx += gthreads()) {
    int sub = idx & 31, hd = (idx >> 5) & 3, row = idx >> 7;
    int col = hd * 256 + sub * 8;
    float a[8], b2[8], g[8];
    load_bf16_row<8>(odir + (size_t)row * 1024 + col, a);
    load_bf16_row<8>(odir + ((size_t)8192 + row) * 1024 + col, b2);
    load_bf16_row<8>(big + (size_t)row * 3328 + 2048 + col, g);
    float ss = 0.f;
#pragma unroll
    for (int e = 0; e < 8; ++e) { a[e] += b2[e]; ss += a[e] * a[e]; }
#pragma unroll
    for (int ofs = 16; ofs >= 1; ofs >>= 1) ss += __shfl_xor(ss, ofs);
    float rs = rsqrtf(ss * (1.f / 256.f) + 1e-6f);
#pragma unroll
    for (int e = 0; e < 8; ++e) a[e] = a[e] * rs * gn[sub * 8 + e] * siluf(g[e]);
    store_bf16_row<8>(o + (size_t)row * 1024 + col, a);
  }
}

constexpr size_t L2_QD = 0, L2_KDP = 16 * MB, L2_KDS = 24 * MB, L2_VTP = 34 * MB, L2_VTS = 42 * MB;
DI void prep2_phase(CPR p) {
  const bf16_t* big = (const bf16_t*)(p.ws + OFF_BIG);
  char* mix = p.ws + OFF_MIX;
  bf16_t* qd = (bf16_t*)(mix + L2_QD); bf16_t* kdp = (bf16_t*)(mix + L2_KDP); bf16_t* kds = (bf16_t*)(mix + L2_KDS);
  bf16_t* vtp = (bf16_t*)(mix + L2_VTP); bf16_t* vts = (bf16_t*)(mix + L2_VTS);
  for (int idx = gtid(); idx < 2 * 8192 * 16 * 8; idx += gthreads()) {
    int sub = idx & 7, hd = (idx >> 3) & 15, row = (idx >> 7) & 8191, which = idx >> 20;
    float v[8];
    load_bf16_row<8>(big + (size_t)row * 3072 + which * 1024 + hd * 64 + sub * 8, v);
    const float extra = which ? 1.f : 0.125f * 1.4426950408889634f;
    if (row >= 4096) headnorm8<true>(v, p.in[which ? I_DKN : I_DQN], sub, extra, (row - 4096) & 2047);
    else headnorm8<false>(v, p.in[which ? I_DKN : I_DQN], sub, extra, 0);
    if (!which) store_bf16_row<8>(qd + ((size_t)hd * 8192 + row) * 64 + sub * 8, v);
    else if (row < 4096) {
      store_bf16_row<8>(kdp + ((size_t)hd * 4096 + row) * 64 + sub * 8, v);
      store_f32_row<8>(p.out + O_L2K + (((size_t)(row >> 8) * 16 + hd) * 256 + (row & 255)) * 64 + sub * 8, v);
    } else {
      int b = (row - 4096) >> 11, t = (row - 4096) & 2047;
      store_bf16_row<8>(kds + (((size_t)b * 16 + hd) * 2304 + 256 + t) * 64 + sub * 8, v);
    }
  }
  for (int idx = gtid(); idx < 4096 * 128; idx += gthreads()) {
    int row = idx >> 7, c = (idx & 127) * 8;
    float v[8];
    load_bf16_row<8>(big + (size_t)row * 3072 + 2048 + c, v);
    int hd = c >> 7, d = c & 127;
    store_f32_row<8>(p.out + O_L2V + (((size_t)(row >> 8) * 8 + hd) * 256 + (row & 255)) * 128 + d, v);
  }
  transpose_gen<true, 128>(1024, 4096, vtp, (size_t)128 * 4096, [&](int r_, int c) { return big[(size_t)r_ * 3072 + 2048 + c]; }, 0);
  for (int b = 0; b < 2; ++b)
    transpose_gen<true, 128>(1024, 2048, vts + (size_t)b * 1024 * 2304, (size_t)128 * 2304, [&](int r_, int c) { return big[(size_t)(4096 + b * 2048 + r_) * 3072 + 2048 + c]; }, 256);
  const float* ck = p.in[I_C2K]; const float* cv = p.in[I_C2V];
  for (int idx = gtid(); idx < 2 * 16 * 256 * 8; idx += gthreads()) {
    int bh = idx >> 11, rem = idx & 2047;
    float v[8];
#pragma unroll
    for (int e = 0; e < 8; ++e) v[e] = ck[(size_t)idx * 8 + e];
    store_bf16_row<8>(kds + (size_t)bh * 2304 * 64 + (size_t)rem * 8, v);
  }
  transpose_gen<true, 128>(2048, 256, vts, (size_t)128 * 2304, [&](int l_, int c) { return f2bf(cv[((size_t)(c >> 7) * 256 + l_) * 128 + (c & 127)]); }, 0);
}

DI void attn2_phase(CPR p, char* smem0) {
  char* smem = smem0 + (otid() >> 8) * 65536;
  const int tid = vtid(), lane = tid & 63, wave = tid >> 6, r = lane & 31, hh = lane >> 5;
  float* xch = (float*)smem;
  float lam;
  {
    const float* dl = p.in[I_DLAM];
    float a = dl[lane] * dl[64 + lane], b2 = dl[128 + lane] * dl[192 + lane];
#pragma unroll
    for (int ofs = 32; ofs >= 1; ofs >>= 1) { a += __shfl_xor(a, ofs); b2 += __shfl_xor(b2, ofs); }
    lam = __expf(a) - __expf(b2) + 0.47071301834435835f;
  }
  const int qs = wave >> 1, comp = wave & 1;
  for (int it = vbid(); it < 1024; it += nvb()) {
    CPP pl = (CPP)__builtin_amdgcn_kernarg_segment_ptr();
    asm volatile("" : "+s"(pl));
    char* mix = pl->ws + OFF_MIX;
    const bf16_t* qd = (const bf16_t*)(mix + L2_QD); const bf16_t* kdp = (const bf16_t*)(mix + L2_KDP); const bf16_t* kds = (const bf16_t*)(mix + L2_KDS);
    const bf16_t* vtp = (const bf16_t*)(mix + L2_VTP); const bf16_t* vts = (const bf16_t*)(mix + L2_VTS);
    bf16_t* o = (bf16_t*)(pl->ws + OFF_O);
    f32x16 O[4];
    float m_run, l_run;
    int grow_q, hd;
    {
      const bf16_t *k0, *k1, *vb_; int vs_, nt_;
      if (it < 512) {
        int b = it >> 8; hd = (it >> 5) & 7; int blk = it & 31;
        grow_q = 4096 + b * 2048 + blk * 64 + qs * 32;
        k0 = kds + ((size_t)b * 16 + hd) * 2304 * 64; k1 = kds + ((size_t)b * 16 + 8 + hd) * 2304 * 64;
        vb_ = vts + ((size_t)b * 8 + hd) * 128 * 2304; vs_ = 2304; nt_ = 72;
      } else {
        int pi = it - 512;
        int b = pi >> 5; hd = (pi >> 2) & 7; int blk = pi & 3;
        grow_q = b * 256 + blk * 64 + qs * 32;
        k0 = kdp + ((size_t)hd * 4096 + b * 256) * 64; k1 = kdp + ((size_t)(8 + hd) * 4096 + b * 256) * 64;
        vb_ = vtp + (size_t)hd * 128 * 4096 + (size_t)b * 256 * 128; vs_ = 4096; nt_ = 8;
      }
      flash_block<64, 128, 2, false>(qd + ((size_t)(comp * 8 + hd) * 8192 + grow_q) * 64, nt_, 0.125f * 1.4426950408889634f, k0, k1, vb_, vs_, smem, comp, O, m_run, l_run, tid, r, hh);
    }
    float linv = 1.f / l_run;
    __syncthreads();
    if (comp == 1) {
#pragma unroll
      for (int t = 0; t < 4; ++t)
#pragma unroll
        for (int i = 0; i < 16; ++i) xch[(qs * 64 + t * 16 + i) * 64 + lane] = O[t][i] * linv;
    }
    __syncthreads();
    if (comp == 0) {
      float ss = 0.f;
#pragma unroll
      for (int t = 0; t < 4; ++t)
#pragma unroll
        for (int i = 0; i < 16; ++i) {
          float v = O[t][i] * linv - lam * xch[(qs * 64 + t * 16 + i) * 64 + lane];
          O[t][i] = v;
          ss += v * v;
        }
      ss += __shfl_xor(ss, 32);
      float rs = rsqrtf(ss * (1.f / 128.f) + 1e-6f) * 0.52928698165564165f;
      const float* gs = p.in[I_DSUB];
#pragma unroll
      for (int t = 0; t < 4; ++t)
#pragma unroll
        for (int i = 0; i < 16; ++i) O[t][i] *= rs * gs[t * 32 + crow(i, hh)];
      store_o<4>(o + (size_t)grow_q * 1024 + hd * 128, 1024, O, 1.f, r, hh);
    }
  }
}

constexpr size_t L3_QAN = 0, L3_CKVN = 6 * MB, L3_QM = 11 * MB, L3_KMP = 35 * MB, L3_KMS = 47 * MB, L3_VTP = 61 * MB, L3_VTS = 69 * MB;
constexpr size_t L3_Q1 = 8192ull * 768 * 2, L3_KV1 = L3_Q1 + 8192ull * 1536 * 2, L3_DQ2 = L3_KV1 + 8704ull * 2048 * 2;
DI void prep3a_phase(CPR p) {
  const int lane = otid() & 63, wave = otid() >> 6;
  const bf16_t* big = (const bf16_t*)(p.ws + OFF_BIG);
  char* mix = p.ws + OFF_MIX;
  bf16_t* qan = (bf16_t*)(mix + L3_QAN); bf16_t* ckvn = (bf16_t*)(mix + L3_CKVN);
  for (int row = obid() * 8 + wave; row < 8192; row += gridDim.x * 8) {
    bf16_t* br = (bf16_t*)(p.ws + OFF_BIG) + (size_t)row * 768;
    const bf16_t* br2 = (const bf16_t*)(p.ws + OFF_BIG + L3_DQ2) + (size_t)row * 768;
    float q[6], ss = 0.f;
#pragma unroll
    for (int j = 0; j < 6; ++j) { q[j] = bf2f(br[j * 64 + lane]) + bf2f(br2[j * 64 + lane]); ss += q[j] * q[j]; }
#pragma unroll
    for (int ofs = 32; ofs >= 1; ofs >>= 1) ss += __shfl_xor(ss, ofs);
    float rs = rsqrtf(ss * (1.f / 384.f) + 1e-6f);
#pragma unroll
    for (int j = 0; j < 6; ++j) qan[(size_t)row * 384 + j * 64 + lane] = f2bf(q[j] * rs * p.in[I_MQAN][j * 64 + lane]);
    float c[4]; ss = 0.f;
#pragma unroll
    for (int j = 0; j < 4; ++j) { c[j] = bf2f(br[384 + j * 64 + lane]) + bf2f(br2[384 + j * 64 + lane]); ss += c[j] * c[j]; }
#pragma unroll
    for (int ofs = 32; ofs >= 1; ofs >>= 1) ss += __shfl_xor(ss, ofs);
    rs = rsqrtf(ss * (1.f / 256.f) + 1e-6f);
#pragma unroll
    for (int j = 0; j < 4; ++j) {
      float y = c[j] * rs * p.in[I_MKVAN][j * 64 + lane];
      ckvn[(size_t)row * 256 + j * 64 + lane] = f2bf(y);
      if (row < 4096) p.out[O_L3C + (size_t)row * 256 + j * 64 + lane] = y;
    }
    if (lane < 32) {
      const float kr = bf2f(br[640 + lane]) + bf2f(br2[640 + lane]);
      br[640 + lane] = f2bf(kr);
      if (row < 4096) p.out[O_L3R + (size_t)row * 32 + lane] = kr;
    }
  }
  for (int idx = gtid(); idx < 512 * 256; idx += gthreads()) ckvn[(size_t)8192 * 256 + idx] = f2bf(p.in[I_C3C][idx]);
}

DI void prep3b_phase(CPR p) {
  const bf16_t* big = (const bf16_t*)(p.ws + OFF_BIG);
  const bf16_t* q1 = (const bf16_t*)(p.ws + OFF_BIG + L3_Q1);
  const bf16_t* kv1 = (const bf16_t*)(p.ws + OFF_BIG + L3_KV1);
  char* mix = p.ws + OFF_MIX;
  bf16_t* qm = (bf16_t*)(mix + L3_QM); bf16_t* kmp = (bf16_t*)(mix + L3_KMP); bf16_t* kms = (bf16_t*)(mix + L3_KMS);
  bf16_t* vtp = (bf16_t*)(mix + L3_VTP); bf16_t* vts = (bf16_t*)(mix + L3_VTS);
  for (int idx = gtid(); idx < 8192 * 16 * 2; idx += gthreads()) {
    int half = idx & 1, hd = (idx >> 1) & 15, row = idx >> 5;
    float v[48];
    load_bf16_row<48>(q1 + (size_t)row * 1536 + hd * 96 + half * 48, v);
    float ss = 0.f;
#pragma unroll
    for (int j = 0; j < 48; ++j) ss += v[j] * v[j];
    ss += __shfl_xor(ss, 1);
    float rs = rsqrtf(ss * (1.f / 96.f) + 1e-6f);
    const float* g = p.in[I_MQN] + half * 48;
    rs *= 0.10206207261596577f * 1.4426950408889634f;
#pragma unroll
    for (int j = 0; j < 48; ++j) v[j] = v[j] * rs * g[j];
    if (half && row >= 4096) rope_apply<48, 16, 32>(v, (row - 4096) & 2047);
    store_bf16_row<48>(qm + ((size_t)hd * 8192 + row) * 96 + half * 48, v);
  }
  for (int idx = gtid(); idx < 8704 * 16 * 2; idx += gthreads()) {
    int half = idx & 1, hd = (idx >> 1) & 15, row = idx >> 5;
    float v[48];
    if (!half) {
      load_bf16_row<48>(kv1 + (size_t)row * 2048 + hd * 128, v);
    } else {
      float t16[16];
      load_bf16_row<16>(kv1 + (size_t)row * 2048 + hd * 128 + 48, t16);
#pragma unroll
      for (int j = 0; j < 16; ++j) v[j] = t16[j];
      if (row < 8192) {
        float t32[32];
        load_bf16_row<32>(big + (size_t)row * 768 + 640, t32);
#pragma unroll
        for (int j = 0; j < 32; ++j) v[16 + j] = t32[j];
      } else {
#pragma unroll
        for (int j = 0; j < 32; ++j) v[16 + j] = p.in[I_C3R][(size_t)(row - 8192) * 32 + j];
      }
    }
    float ss = 0.f;
#pragma unroll
    for (int j = 0; j < 48; ++j) ss += v[j] * v[j];
    ss += __shfl_xor(ss, 1);
    float rs = rsqrtf(ss * (1.f / 96.f) + 1e-6f);
    const float* g = p.in[I_MKN] + half * 48;
#pragma unroll
    for (int j = 0; j < 48; ++j) v[j] = v[j] * rs * g[j];
    if (row < 4096) store_bf16_row<48>(kmp + ((size_t)hd * 4096 + row) * 96 + half * 48, v);
    else if (row < 8192) {
      int b = (row - 4096) >> 11, t = (row - 4096) & 2047;
      if (half) rope_apply<48, 16, 32>(v, t);
      store_bf16_row<48>(kms + (((size_t)b * 16 + hd) * 2304 + 256 + t) * 96 + half * 48, v);
    } else {
      int b = (row - 8192) >> 8, l_ = (row - 8192) & 255;
      store_bf16_row<48>(kms + (((size_t)b * 16 + hd) * 2304 + l_) * 96 + half * 48, v);
    }
  }
  transpose_gen<true, 64>(1024, 4096, vtp, (size_t)64 * 4096, [&](int r_, int c) { return kv1[(size_t)r_ * 2048 + (c >> 6) * 128 + 64 + (c & 63)]; }, 0);
  for (int b = 0; b < 2; ++b) {
    transpose_gen<true, 64>(1024, 2048, vts + (size_t)b * 1024 * 2304, (size_t)64 * 2304, [&](int r_, int c) { return kv1[(size_t)(4096 + b * 2048 + r_) * 2048 + (c >> 6) * 128 + 64 + (c & 63)]; }, 256);
    transpose_gen<true, 64>(1024, 256, vts + (size_t)b * 1024 * 2304, (size_t)64 * 2304, [&](int r_, int c) { return kv1[(size_t)(8192 + b * 256 + r_) * 2048 + (c >> 6) * 128 + 64 + (c & 63)]; }, 0);
  }
}

DI void attn3_phase(CPR p, char* smem0) {
  char* smem = smem0 + (otid() >> 8) * 65536;
  const int tid = vtid(), lane = tid & 63, wave = tid >> 6, r = lane & 31, hh = lane >> 5;
  char* mix = p.ws + OFF_MIX;
  const bf16_t* qm = (const bf16_t*)(mix + L3_QM); const bf16_t* kmp = (const bf16_t*)(mix + L3_KMP); const bf16_t* kms = (const bf16_t*)(mix + L3_KMS);
  const bf16_t* vtp = (const bf16_t*)(mix + L3_VTP); const bf16_t* vts = (const bf16_t*)(mix + L3_VTS);
  bf16_t* o = (bf16_t*)(p.ws + OFF_O);
  const float scale = 0.10206207261596577f * 1.4426950408889634f;
  for (int it = vbid(); it < 1024; it += nvb()) {
    f32x16 O[2];
    float m_run, l_run;
    int grow_q, hd;
    const bf16_t *k0, *vb_; int vs_, nt_;
    if (it < 512) {
      int b = it >> 8; hd = (it >> 4) & 15; int blk = it & 15;
      grow_q = 4096 + b * 2048 + blk * 128 + wave * 32;
      k0 = kms + ((size_t)b * 16 + hd) * 2304 * 96;
      vb_ = vts + ((size_t)b * 16 + hd) * 64 * 2304; vs_ = 2304; nt_ = 72;
    } else {
      int pi = it - 512;
      int b = pi >> 5; hd = (pi >> 1) & 15; int blk = pi & 1;
      grow_q = b * 256 + blk * 128 + wave * 32;
      k0 = kmp + ((size_t)hd * 4096 + b * 256) * 96;
      vb_ = vtp + (size_t)hd * 64 * 4096 + (size_t)b * 256 * 64; vs_ = 4096; nt_ = 8;
    }
    flash_block<96, 64, 1, true>(qm + ((size_t)hd * 8192 + grow_q) * 96, nt_, scale, k0, k0, vb_, vs_, smem, 0, O, m_run, l_run, tid, r, hh);
    store_o<2>(o + (size_t)grow_q * 1024 + hd * 64, 1024, O, 1.f / l_run, r, hh);
  }
}

#define XB_TMO      128
#define XB_XCNT(j)  (256  + 64 * (j))
#define XB_XSUB(j)  (1280 + 64 * (j))
#define XB_XGEN(j)  (2304 + 64 * (j))
#define XB_TOP      3328
#define XB_TOPGEN   3392
#define XCD_BAR_WORDS 3456
#define XB_SPIN_CAP (1u << 18)
#define LAS __attribute__((address_space(3)))
DI unsigned xb_ld(unsigned* p) { return __hip_atomic_load(p, __ATOMIC_RELAXED, __HIP_MEMORY_SCOPE_AGENT); }
DI unsigned xb_add(unsigned* p, unsigned v) { return __hip_atomic_fetch_add(p, v, __ATOMIC_RELAXED, __HIP_MEMORY_SCOPE_AGENT); }
DI unsigned xb_xcc_id() { return (unsigned)__builtin_amdgcn_s_getreg((3 << 11) | 20) & 0xFu; }
#define XB_SPIN(cond, bar) do { unsigned _sp = 0; while (cond) { __builtin_amdgcn_s_sleep(1); \
    if ((++_sp & 255u) == 0u) { if (xb_ld(&(bar)[XB_TMO])) break; if (_sp > XB_SPIN_CAP) { atomicAdd(&(bar)[XB_TMO], 1u); break; } } } } while (0)
DI void xcd_barrier_complete(unsigned* bar, unsigned x, unsigned& nloc, unsigned& nx) {
  const unsigned G = gridDim.x;
  unsigned sum, cnt, mine, sp = 0u;
  for (;;) {
    sum = 0u; cnt = 0u; mine = 0u;
#pragma unroll
    for (unsigned j = 0; j < 16; ++j) { const unsigned c = xb_ld(&bar[XB_XCNT(j)]); sum += c; cnt += (c > 0u) ? 1u : 0u; mine = (j == x) ? c : mine; }
    if (sum == G) break;
    __builtin_amdgcn_s_sleep(1);
    if ((++sp & 255u) == 0u) { if (xb_ld(&bar[XB_TMO])) break; if (sp > XB_SPIN_CAP) { atomicAdd(&bar[XB_TMO], 1u); break; } }
  }
  nloc = mine > 0u ? mine : 1u; nx = cnt > 0u ? cnt : 1u;
}
DI void xcd_barrier(unsigned* bar, volatile LAS unsigned* st) {
  asm volatile("s_waitcnt vmcnt(0)" ::: "memory");
  __syncthreads();
  if (__builtin_amdgcn_workitem_id_x() == 0) {
    const unsigned x = xb_xcc_id();
    __builtin_amdgcn_s_waitcnt(0);
    unsigned nloc = st[0], nx = st[1];
    if (nloc == 0u) { xcd_barrier_complete(bar, x, nloc, nx); st[0] = nloc; st[1] = nx; }
    const unsigned old = xb_add(&bar[XB_XSUB(x)], 1u);
    const unsigned gen = old / nloc;
    if (old + 1u == (gen + 1u) * nloc) {
      __builtin_amdgcn_fence(__ATOMIC_RELEASE, "agent");
      asm volatile("s_waitcnt vmcnt(0)" ::: "memory");
      const unsigned og = xb_add(&bar[XB_TOP], 1u);
      const unsigned tg = og / nx;
      if (og + 1u == (tg + 1u) * nx) xb_add(&bar[XB_TOPGEN], 1u);
      else XB_SPIN(xb_ld(&bar[XB_TOPGEN]) == tg, bar);
      __builtin_amdgcn_fence(__ATOMIC_ACQUIRE, "agent");
      xb_add(&bar[XB_XGEN(x)], 1u);
      asm volatile("s_waitcnt vmcnt(0)" ::: "memory");
    } else {
      XB_SPIN(xb_ld(&bar[XB_XGEN(x)]) == gen, bar);
      __builtin_amdgcn_fence(__ATOMIC_ACQUIRE, "agent");
      asm volatile("s_waitcnt vmcnt(0)" ::: "memory");
    }
  }
  __syncthreads();
}

constexpr int LDS_BYTES = 131072 + 64;
__global__ void __launch_bounds__(512, 2) mega(Params p_unused) {
  extern __shared__ __attribute__((aligned(16))) unsigned char shm[];
  char* smem = (char*)shm;
  volatile LAS unsigned* xbw = (volatile LAS unsigned*)(shm + 131072);
  {
    CPP pq = (CPP)__builtin_amdgcn_kernarg_segment_ptr();
    unsigned* bar0 = (unsigned*)(pq->ws + OFF_BAR);
    const unsigned xid = xb_xcc_id();
    if (__builtin_amdgcn_workitem_id_x() == 0) {
      xbw[0] = 0u; xbw[1] = 0u;
      (void)xb_add(&bar0[XB_XCNT(xid)], 1u);
    }
  }
  __syncthreads();
  for (int ph = 0; ph < 46; ++ph) {
    CPP pp = (CPP)__builtin_amdgcn_kernarg_segment_ptr();
    asm volatile("" : "+s"(pp));
    CPR p = *pp;
    bf16_t* W = (bf16_t*)p.ws;
    bf16_t* H = (bf16_t*)(p.ws + OFF_H);
    bf16_t* BIG = (bf16_t*)(p.ws + OFF_BIG);
    bf16_t* OB = (bf16_t*)(p.ws + OFF_O);
    bf16_t* AB = (bf16_t*)(p.ws + OFF_MIX);
    char* mix = p.ws + OFF_MIX;
    if (ph == 0) {
      phase0(p, smem);
      if (REPMASK & 16) phase0(p, smem);
    } else if (ph == 45) {
      final_add_phase(p);
    } else {
      const int l = (ph - 1) / 11, step = (ph - 1) % 11;
      if ((step == 4 && (l == 0 || l == 2)) || (step == 5 && l != 3)) continue;
      int reps = 1;
      {
        const bool is_attn = (step == 3 && l != 3) || step == 5;
        const bool is_gemm_store = step == 1 || step == 8 || (step == 3 && l == 3);
        const bool is_misc = step == 0 || step == 2 || step == 7 || step == 9 || (step == 4);
        if ((REPMASK & 2) && is_gemm_store) reps = 2;
        if ((REPMASK & 4) && is_attn) reps = 2;
        if ((REPMASK & 8) && is_misc) reps = 2;
        if ((REPMASK & 32) && step == 3 && l == 0) reps = 2;
        if ((REPMASK & 64) && step == 3 && l == 1) reps = 2;
        if ((REPMASK & 128) && step == 3 && l == 2) reps = 2;
        if ((REPMASK & 256) && step == 5) reps = 2;
        if ((REPMASK & 512) && (step == 0 || step == 7)) reps = 2;
        if ((REPMASK & 1024) && step == 9) reps = 2;
        if ((REPMASK & 2048) && (step == 2 || step == 4)) reps = 2;
        if ((REPMASK & 16384) && step == 2 && l == 0) reps = 2;
        if ((REPMASK & 32768) && step == 2 && l == 1) reps = 2;
        if ((REPMASK & 65536) && step == 2 && l == 2) reps = 2;
        if ((REPMASK & 131072) && (step == 2 || step == 4) && l == 3) reps = 2;
        if ((REPMASK & 262144) && step == 4 && l == 1) reps = 2;
      }
      for (int rep = 0; rep < reps; ++rep)
      switch (step) {
        case 0: norm_phase(p, l, 0, l == 0, l > 0); break;
        case 1:
          if (l == 0) gemm_store_phase(H, W + W_NA_QKV, 8192, 3072, 1024, BIG, 3072, shm);
          else if (l == 1) gemm_store_phase(H, W + W_GLA_QKVG, 8192, 3328, 1024, BIG, 3328, shm);
          else if (l == 2) gemm_store_phase(H, W + W_DIFF_QKV, 8192, 3072, 1024, BIG, 3072, shm);
          else gemm_store_sk_phase(H, W + W_MLA_DQKV, 8192, 768, 1024, BIG, (bf16_t*)(p.ws + OFF_BIG + L3_DQ2), 768, shm);
          break;
        case 2:
          if (l == 0) prep0_phase(p);
          else if (l == 1) prep1_phase(p, smem);
          else if (l == 2) prep2_phase(p);
          else prep3a_phase(p);
          break;
        case 3:
          if (l == 0) attn0_phase(p, smem);
          else if (l == 1) scan1_phase(p, smem);
          else if (l == 2) attn2_phase(p, smem);
          else {
            const bf16_t* qan = (const bf16_t*)(mix + L3_QAN); const bf16_t* ckvn = (const bf16_t*)(mix + L3_CKVN);
            bf16_t* q1 = (bf16_t*)(p.ws + OFF_BIG + L3_Q1); bf16_t* kv1 = (bf16_t*)(p.ws + OFF_BIG + L3_KV1);
            gemm_store_phase(qan, W + W_MLA_UQ, 8192, 1536, 384, q1, 1536, shm);
            gemm_store_phase(ckvn, W + W_MLA_UKV, 8704, 2048, 256, kv1, 2048, shm);
          }
          break;
        case 4:
          if (l == 1) gla_out_phase(p);
          else prep3b_phase(p);
          break;
        case 5: attn3_phase(p, smem); break;
        case 6: {
          const bf16_t* wo = W + (l == 0 ? W_NA_O : l == 1 ? W_GLA_O : l == 2 ? W_DIFF_O : W_MLA_O);
          if ((int)gridDim.x >= 256 && obid() >= 128) conv_ahead(p, l, smem, obid() - 128, (int)gridDim.x - 128);
          else {
            if ((int)gridDim.x < 256 ) conv_ahead(p, l, smem, obid(), (int)gridDim.x);
            gemm_resid_phase(p, OB, 1024, wo, l, 2048, l == 0, false, shm);
          }
          if (REPMASK & 4096) gemm_resid_phase(p, OB, 1024, wo, l, 2048, l == 0, false, shm, true);
        } break;
        case 7: norm_phase(p, l, 1, false, false); break;
        case 8: gemm_store_phase(H, W + W_UP + (size_t)l * 5632 * 1024, 8192, 5632, 1024, BIG, 5632, shm); break;
        case 9: convgate_phase(p, l); break;
        default: gemm_resid_phase(p, AB, 2816, W + W_DOWN + (size_t)l * 1024 * 2816, l, 5120, false, true, shm);
          if (REPMASK & 8192) gemm_resid_phase(p, AB, 2816, W + W_DOWN + (size_t)l * 1024 * 2816, l, 5120, false, true, shm, true);
          break;
      }
    }
    if (ph < 45) {
      xcd_barrier((unsigned*)(p.ws + OFF_BAR), xbw);
      if (REPMASK & 1) xcd_barrier((unsigned*)(p.ws + OFF_BAR), xbw);
    }
  }
}

extern "C" void kernel_launch(void* const* d_in, const int* in_sizes, int n_in, void* d_out, int out_size, void* d_ws, size_t ws_size, hipStream_t stream) {
  static int grid_blocks = 0;
  if (!grid_blocks) {
    int dev = 0, cus = 0, per_cu = 0;
    (void)hipGetDevice(&dev);
    (void)hipDeviceGetAttribute(&cus, hipDeviceAttributeMultiprocessorCount, dev);
    (void)hipFuncSetAttribute((const void*)mega, hipFuncAttributeMaxDynamicSharedMemorySize, LDS_BYTES);
    (void)hipOccupancyMaxActiveBlocksPerMultiprocessor(&per_cu, mega, 512, LDS_BYTES);
    (void)hipGetLastError();
    grid_blocks = cus;
    if (per_cu < 1) grid_blocks = cus;
  }
  Params p{};
  for (int i = 0; i < 46; ++i) p.in[i] = (const float*)d_in[i];
  p.out = (float*)d_out;
  p.ws = (char*)d_ws;
  (void)hipMemsetAsync((char*)d_ws + OFF_BAR, 0, XCD_BAR_WORDS * 4, stream);
  void* args[] = {&p};
  (void)hipLaunchCooperativeKernel((void*)mega, dim3(grid_blocks), dim3(512), args, LDS_BYTES, stream);
}
```

```cpp
#include <hip/hip_runtime.h>
#include <hip/hip_cooperative_groups.h>
#include <stdint.h>
namespace cg = cooperative_groups;

typedef unsigned short bf16_t;
typedef __attribute__((ext_vector_type(8))) short bf16x8;
typedef __attribute__((ext_vector_type(4))) short bf16x4;
typedef __attribute__((ext_vector_type(16))) float f32x16;
#define DI __device__ __forceinline__
#define MFMA32(a, b, c) __builtin_amdgcn_mfma_f32_32x32x16_bf16((a), (b), (c), 0, 0, 0)

#ifndef REPMASK
#define REPMASK 0
#endif
constexpr size_t MB = 1ull << 20;
constexpr size_t W_NA_QKV = 0;
constexpr size_t W_NA_O = W_NA_QKV + 3072ull * 1024;
constexpr size_t W_GLA_QKVG = W_NA_O + 1024ull * 1024;
constexpr size_t W_GLA_O = W_GLA_QKVG + 3328ull * 1024;
constexpr size_t W_DIFF_QKV = W_GLA_O + 1024ull * 1024;
constexpr size_t W_DIFF_O = W_DIFF_QKV + 3072ull * 1024;
constexpr size_t W_MLA_DQKV = W_DIFF_O + 1024ull * 1024;
constexpr size_t W_MLA_UQ = W_MLA_DQKV + 768ull * 1024;
constexpr size_t W_MLA_UKV = W_MLA_UQ + 1536ull * 384;
constexpr size_t W_MLA_O = W_MLA_UKV + 2048ull * 256;
constexpr size_t W_UP = W_MLA_O + 1024ull * 1024;
constexpr size_t W_DOWN = W_UP + 4ull * 5632 * 1024;
constexpr size_t W_END = W_DOWN + 4ull * 1024 * 2816;
constexpr size_t OFF_H = ((W_END * 2 + 255) / 256) * 256;
constexpr size_t OFF_BIG = OFF_H + 8192ull * 1024 * 2;
constexpr size_t OFF_O = OFF_BIG + 8192ull * 5632 * 2;
constexpr size_t OFF_MODS = OFF_O + 8192ull * 1024 * 2;
constexpr size_t OFF_MIX = OFF_MODS + 512 * 1024;
constexpr size_t OFF_BAR = OFF_MIX + 100 * MB;
constexpr size_t O_L0K = 8388608, O_L0V = 12582912, O_L1F = 16777216, O_L1B = 18874368;
constexpr size_t O_L2K = 20971520, O_L2V = 25165824, O_L3C = 29360128, O_L3R = 30408704;

struct Params {
  const float* in[46];
  float* out;
  char* ws;
};
typedef const __attribute__((address_space(4))) Params& CPR;
typedef const __attribute__((address_space(4))) Params* CPP;
enum { I_XP = 0, I_XS, I_C0K, I_C0V, I_SF, I_SB, I_C2K, I_C2V, I_C3C, I_C3R, I_C, I_CCTX, I_ADAW, I_ADAB, I_NMIX, I_NFFN,
       I_WUP, I_CONVW, I_CONVB, I_WDOWN, I_NAQKV, I_NAQN, I_NAKN, I_NABIAS, I_NAO, I_GQKVG, I_GG1, I_GG2, I_GBG, I_GON, I_GO,
       I_DQKV, I_DQN, I_DKN, I_DLAM, I_DSUB, I_DO, I_MDQ, I_MQAN, I_MUQ, I_MDKV, I_MKVAN, I_MUKV, I_MQN, I_MKN, I_MO };

DI unsigned short f2bf(float x) {
  unsigned u = __float_as_uint(x);
  u += 0x7fffu + ((u >> 16) & 1u);
  return (unsigned short)(u >> 16);
}
DI float bf2f(unsigned short b) { return __uint_as_float(((unsigned)b) << 16); }
typedef __bf16 bf16v2_t __attribute__((ext_vector_type(2)));
typedef float f32v2_t __attribute__((ext_vector_type(2)));
DI unsigned pack2(float a, float b) { f32v2_t f = {a, b}; bf16v2_t h = __builtin_convertvector(f, bf16v2_t); return __builtin_bit_cast(unsigned, h); }
DI int crow(int i, int hh) { return (i & 3) + 8 * (i >> 2) + 4 * hh; }
DI float siluf(float x) { return x / (1.f + __expf(-x)); }
DI int otid() { int t = __builtin_amdgcn_workitem_id_x(); asm volatile("" : "+v"(t)); return t; }
DI int obid() { int b = __builtin_amdgcn_workgroup_id_x(); asm volatile("" : "+s"(b)); return b; }
DI int gtid() { return obid() * 512 + otid(); }
DI int gthreads() { return gridDim.x * 512; }
DI int vtid() { return otid() & 255; }
DI int vbid() { return obid() * 2 + (otid() >> 8); }
DI int nvb() { return gridDim.x * 2; }

template <int D> DI void load_bf16_row(const bf16_t* p, float (&v)[D]) {
#pragma unroll
  for (int j = 0; j < D / 8; ++j) {
    uint4 q = *(const uint4*)(p + j * 8);
    unsigned w[4] = {q.x, q.y, q.z, q.w};
#pragma unroll
    for (int e = 0; e < 4; ++e) { v[j * 8 + 2 * e] = __uint_as_float(w[e] << 16); v[j * 8 + 2 * e + 1] = __uint_as_float(w[e] & 0xffff0000u); }
  }
}
template <int D> DI void store_bf16_row(bf16_t* p, const float (&v)[D]) {
#pragma unroll
  for (int j = 0; j < D / 8; ++j) {
    uint4 q;
    q.x = pack2(v[j * 8 + 0], v[j * 8 + 1]); q.y = pack2(v[j * 8 + 2], v[j * 8 + 3]);
    q.z = pack2(v[j * 8 + 4], v[j * 8 + 5]); q.w = pack2(v[j * 8 + 6], v[j * 8 + 7]);
    *(uint4*)(p + j * 8) = q;
  }
}
template <int D> DI void store_f32_row(float* p, const float (&v)[D]) {
#pragma unroll
  for (int j = 0; j < D / 4; ++j) *(float4*)(p + j * 4) = make_float4(v[j * 4], v[j * 4 + 1], v[j * 4 + 2], v[j * 4 + 3]);
}
template <int D> DI void rms_apply(float (&v)[D], const float* g) {
  float ss = 0.f;
#pragma unroll
  for (int j = 0; j < D; ++j) ss += v[j] * v[j];
  float rs = rsqrtf(ss * (1.f / D) + 1e-6f);
#pragma unroll
  for (int j = 0; j < D; ++j) v[j] = v[j] * rs * g[j];
}
template <int D, int BASE, int R> DI void rope_apply(float (&v)[D], int t) {
  constexpr int NF = R / 4;
  float rowf = (float)(t >> 6), colf = (float)(t & 63);
#pragma unroll
  for (int a = 0; a < 2; ++a) {
#pragma unroll
    for (int f = 0; f < NF; ++f) {
      float freq = exp2f(-(float)f * (13.287712379549449f / NF));
      float ang = (a == 0 ? rowf : colf) * freq;
      float c = __cosf(ang), s = __sinf(ang);
      int i1 = BASE + a * 2 * NF + f, i2 = i1 + NF;
      float x1 = v[i1], x2 = v[i2];
      v[i1] = x1 * c - x2 * s;
      v[i2] = x1 * s + x2 * c;
    }
  }
}
template <bool PERMK, int DVH = 0, class F> DI void transpose_gen(int ncols, int nrows, bf16_t* dst, size_t dstride, F srcf, int koff = 0) {
  int total = ncols * (nrows >> 3);
  for (int idx = gtid(); idx < total; idx += gthreads()) {
    int c = idx % ncols, r0 = (idx / ncols) << 3;
    unsigned short e[8];
#pragma unroll
    for (int j = 0; j < 8; ++j) e[j] = srcf(r0 + j, c);
    const int k0 = koff + r0;
    bf16_t* drow = (DVH > 0) ? dst + (size_t)(c / (DVH > 0 ? DVH : 1)) * dstride + (size_t)(k0 >> 5) * (DVH * 32) + (c % (DVH > 0 ? DVH : 1)) * 32 + (k0 & 16)
                             : dst + (size_t)c * dstride + (k0 & ~15);
    if (PERMK) {
      uint2 q0, q1;
      q0.x = e[0] | ((unsigned)e[1] << 16); q0.y = e[2] | ((unsigned)e[3] << 16);
      q1.x = e[4] | ((unsigned)e[5] << 16); q1.y = e[6] | ((unsigned)e[7] << 16);
      bf16_t* d = drow + ((k0 & 8) ? 4 : 0);
      *(uint2*)d = q0;
      *(uint2*)(d + 8) = q1;
    } else {
      uint4 q;
      q.x = e[0] | ((unsigned)e[1] << 16); q.y = e[2] | ((unsigned)e[3] << 16);
      q.z = e[4] | ((unsigned)e[5] << 16); q.w = e[6] | ((unsigned)e[7] << 16);
      *(uint4*)(drow + (k0 & 8)) = q;
    }
  }
}

namespace pg8 {
#define PG8_LAS __attribute__((address_space(3)))
typedef float f32x4 __attribute__((ext_vector_type(4)));
typedef unsigned u32x4 __attribute__((ext_vector_type(4)));
constexpr int BM = 256, BK = 64, HALF = 128, HTB = HALF * BK * 2, STAGE_BYTES = 8 * HTB, NXCD = 8, WGM = 4;
DI int lds_byte(int r, int c) { const int st = (r >> 4) * 2 + (c >> 5), rr = r & 15, cc = c & 31, ob = rr * 64 + cc * 2; return st * 1024 + (ob ^ (((ob >> 9) & 1) << 5)); }
DI void stage_rc(int b, int& R, int& C) { const int st = b / 1024, sb = b % 1024, swz = sb ^ (((sb >> 9) & 1) << 5); R = (st >> 1) * 16 + swz / 64; C = (st & 1) * 32 + (swz % 64) / 2; }
DI int perm32(int rho) { const int n = rho >> 4, i = rho & 15; return 8 * (i >> 2) + 4 * n + (i & 3); }
struct Unit { int pm, pn, ks; };
struct Gemm { const bf16_t* A; const bf16_t* Bt; int M, N, K; int Kext; };
struct StaticOrder {
  int nM, nN, nwg, G, c;
  DI void init(int M, int N, int G_, int c_) { nM = M / BM; nN = N / BM; nwg = nM * nN; G = G_; c = c_; }
  DI bool next(int i, Unit& u) const {
    const long L = (long)i * G + c; if (L >= nwg) return false;
    int wgid = (int)L; { const int q = nwg / NXCD, r = nwg % NXCD, xcd = wgid % NXCD, off = wgid / NXCD; wgid = (xcd < r ? xcd * (q + 1) : r * (q + 1) + (xcd - r) * q) + off; }
    const int nig = WGM * nN, gid = wgid / nig, fm = gid * WGM, gsz = (nM - fm) < WGM ? (nM - fm) : WGM;
    u.pm = fm + ((wgid % nig) % gsz); u.pn = (wgid % nig) / gsz; u.ks = 0; return true;
  }
  DI void a_ready(const Unit&) const {}
  DI void done(const Unit&) const {}
};
struct SplitK2Order : StaticOrder {
  DI bool next(int i, Unit& u) const {
    const long L = (long)i * G + c; if (L >= 2 * nwg) return false;
    int wgid = (int)(L >> 1); { const int q = nwg / NXCD, r = nwg % NXCD, xcd = wgid % NXCD, off = wgid / NXCD; wgid = (xcd < r ? xcd * (q + 1) : r * (q + 1) + (xcd - r) * q) + off; }
    const int nig = WGM * nN, gid = wgid / nig, fm = gid * WGM, gsz = (nM - fm) < WGM ? (nM - fm) : WGM;
    u.pm = fm + ((wgid % nig) % gsz); u.pn = (wgid % nig) / gsz; u.ks = (int)(L & 1); return true;
  }
};
DI unsigned cvt_pk_bf16(float lo, float hi) { unsigned r; asm volatile("v_cvt_pk_bf16_f32 %0, %1, %2" : "=v"(r) : "v"(lo), "v"(hi)); return r; }
struct EpiStore {
  static constexpr bool PERM = true;
  bf16_t* O; int ldc; bf16_t* O1;
  DI void operator()(const f32x4 (&acc)[2][2][4][2], const Unit& u, int wr, int wc, int fr, int fq) const {
    const int row0 = u.pm * BM + wr * 64 + fr, col0 = u.pn * BM + wc * 32 + 8 * fq;
#pragma unroll
    for (int ai = 0; ai < 2; ++ai)
#pragma unroll
      for (int m = 0; m < 4; ++m) {
        bf16_t* rowp = (u.ks ? O1 : O) + (size_t)(row0 + ai * HALF + m * 16) * ldc + col0;
#pragma unroll
        for (int bj = 0; bj < 2; ++bj) {
          const f32x4 v0 = acc[ai][bj][m][0], v1 = acc[ai][bj][m][1];
          u32x4 w; w.x = cvt_pk_bf16(v0[0], v0[1]); w.y = cvt_pk_bf16(v0[2], v0[3]); w.z = cvt_pk_bf16(v1[0], v1[1]); w.w = cvt_pk_bf16(v1[2], v1[3]);
          *(u32x4*)(rowp + bj * HALF) = w;
        }
      }
  }
};
struct EpiResid {
  static constexpr bool PERM = false;
  const float* xp; const float* xs; float* out; const float* mods_l; int gate_off; int first; float* p1;
  DI void operator()(const f32x4 (&acc)[2][2][4][2], const Unit& u, int wr, int wc, int fr, int fq) const {
    const int rowb = u.pm * BM;
    const float* xin = first ? (rowb < 4096 ? xp + (size_t)rowb * 1024 : xs + (size_t)(rowb - 4096) * 1024) : out + (size_t)rowb * 1024;
    float* xo = (u.ks ? p1 : out) + (size_t)rowb * 1024;
    const int mr = rowb < 4096 ? 0 : (rowb < 6144 ? 1 : 2);
    const float* gate = mods_l + (size_t)mr * 6144 + gate_off;
    const int col0 = u.pn * BM + wc * 32 + 4 * fq;
    f32x4 gv[2][2];
#pragma unroll
    for (int bj = 0; bj < 2; ++bj)
#pragma unroll
      for (int n = 0; n < 2; ++n) gv[bj][n] = *(const f32x4*)(gate + col0 + bj * HALF + n * 16);
#pragma unroll
    for (int ai = 0; ai < 2; ++ai)
#pragma unroll
      for (int m = 0; m < 4; ++m) {
        const unsigned ro = (unsigned)(wr * 64 + fr + ai * HALF + m * 16) * 1024u + col0;
#pragma unroll
        for (int bj = 0; bj < 2; ++bj)
#pragma unroll
          for (int n = 0; n < 2; ++n) {
            const unsigned o = ro + bj * HALF + n * 16;
            if (u.ks) *(f32x4*)(xo + o) = gv[bj][n] * acc[ai][bj][m][n];
            else *(f32x4*)(xo + o) = *(const f32x4*)(xin + o) + gv[bj][n] * acc[ai][bj][m][n];
          }
      }
  }
};

template <class Epi, class Sched>
DI void gemm_phase(PG8_LAS unsigned char* lds, const Gemm g, const Sched& S, const Epi& E) {
  const int tid = otid(), wid = __builtin_amdgcn_readfirstlane(tid >> 6), lane = tid & 63, wr = wid >> 2, wc = wid & 3, fr = lane & 15, fq = lane >> 4;
  const int K = g.K, nt = g.Kext / BK;
  const size_t ksb = (size_t)g.Kext * 2;
  unsigned voffA[2], voffB[2];
#pragma unroll
  for (int i = 0; i < 2; ++i) { int R, C; stage_rc(tid * 16 + i * 8192, R, C); const int Rb = Epi::PERM ? ((R & ~31) + perm32(R & 31)) : R;
    voffA[i] = (unsigned)(R * K + C) * 2u; voffB[i] = (unsigned)(Rb * K + C) * 2u; }
  const size_t kstep = (size_t)(BK * 2);
  const size_t hstep = (size_t)HALF * K * 2;
  const size_t tstep = 2 * hstep;
  const unsigned ldsw = (unsigned)wid * 1024u;
  const int aoff = lds_byte(wr * 64 + fr, fq * 8), boff = lds_byte(wc * 32 + fr, fq * 8);
#define PG8_SA(b, h) (((b) * 2 + (h)) * HTB)
#define PG8_SB(b, h) ((4 + (b) * 2 + (h)) * HTB)
#define PG8_STAGE(bufoff, gbase, voff) do { _Pragma("unroll") for (int _i = 0; _i < 2; ++_i) \
    __builtin_amdgcn_global_load_lds((const unsigned*)((const char*)(gbase) + (voff)[_i]), (PG8_LAS unsigned*)(lds + (bufoff) + ldsw + _i * 8192), 16, 0, 0); } while (0)
#define PG8_LDA(dst, b, h) do { _Pragma("unroll") for (int m = 0; m < 4; ++m) _Pragma("unroll") for (int k = 0; k < 2; ++k) dst[m][k] = *(const PG8_LAS bf16x8*)(lds + PG8_SA(b, h) + aoff + m * 2048 + k * 1024); } while (0)
#define PG8_LDB(dst, b, h) do { _Pragma("unroll") for (int n = 0; n < 2; ++n) _Pragma("unroll") for (int k = 0; k < 2; ++k) dst[n][k] = *(const PG8_LAS bf16x8*)(lds + PG8_SB(b, h) + boff + n * 2048 + k * 1024); } while (0)
#define PG8_MMA(ai, bj, At, Bt) do { __builtin_amdgcn_s_setprio(1); _Pragma("unroll") for (int m = 0; m < 4; ++m) _Pragma("unroll") for (int n = 0; n < 2; ++n) _Pragma("unroll") for (int k = 0; k < 2; ++k) \
    acc[ai][bj][m][n] = __builtin_amdgcn_mfma_f32_16x16x32_bf16(Bt[n][k], At[m][k], acc[ai][bj][m][n], 0, 0, 0); __builtin_amdgcn_s_setprio(0); } while (0)
#define PG8_WAIT_V(n) asm volatile("s_waitcnt vmcnt(" #n ")" ::: "memory")
#define PG8_WAIT_L(n) asm volatile("s_waitcnt lgkmcnt(" #n ")" ::: "memory")
#define PG8_BAR __builtin_amdgcn_s_barrier()
#define PG8_SCHED __builtin_amdgcn_sched_barrier(0)
  Unit cur, nxt; int ui = 0;
  if (!S.next(0, cur)) return;
  f32x4 acc[2][2][4][2];
#pragma unroll
  for (int a = 0; a < 2; ++a)
#pragma unroll
    for (int b = 0; b < 2; ++b)
#pragma unroll
      for (int m = 0; m < 4; ++m)
#pragma unroll
        for (int n = 0; n < 2; ++n) acc[a][b][m][n] = (f32x4){0.f, 0.f, 0.f, 0.f};
  bf16x8 At[4][2], B0[2][2], B1[2][2];
  const char* cA = (const char*)g.A + (size_t)cur.pm * tstep + cur.ks * ksb; const char* cB = (const char*)g.Bt + (size_t)cur.pn * tstep + cur.ks * ksb;
  S.a_ready(cur);
  PG8_STAGE(PG8_SB(0, 0), cB, voffB); PG8_STAGE(PG8_SA(0, 0), cA, voffA); PG8_STAGE(PG8_SB(0, 1), cB + hstep, voffB); PG8_STAGE(PG8_SA(0, 1), cA + hstep, voffA);
  if (wr == 1) PG8_BAR;
  PG8_WAIT_V(4); PG8_BAR;
  PG8_STAGE(PG8_SB(1, 0), cB + kstep, voffB); PG8_STAGE(PG8_SA(1, 0), cA + kstep, voffA); PG8_STAGE(PG8_SB(1, 1), cB + hstep + kstep, voffB);
  PG8_WAIT_V(6); PG8_BAR;
  for (;;) {
    const bool has_next = S.next(ui + 1, nxt);
    const char* nA = has_next ? (const char*)g.A + (size_t)nxt.pm * tstep + nxt.ks * ksb : cA; const char* nB = has_next ? (const char*)g.Bt + (size_t)nxt.pn * tstep + nxt.ks * ksb : cB;
    for (int t = 0; t < nt; t += 2) {
      const bool last = (t == nt - 2);
      const char* a1 = cA + (size_t)(t + 1) * kstep;
      const char* a2 = last ? nA : cA + (size_t)(t + 2) * kstep; const char* b2 = last ? nB : cB + (size_t)(t + 2) * kstep;
      const char* a3 = a2 + kstep; const char* b3 = b2 + kstep;
      if (last && has_next) S.a_ready(nxt);
      PG8_LDB(B0, 0, 0); PG8_SCHED; PG8_LDA(At, 0, 0); PG8_STAGE(PG8_SA(1, 1), a1 + hstep, voffA);
      PG8_WAIT_L(8); PG8_BAR; PG8_WAIT_L(0); PG8_MMA(0, 0, At, B0); PG8_BAR; PG8_SCHED;
      PG8_LDB(B1, 0, 1); PG8_STAGE(PG8_SB(0, 0), b2, voffB);
      PG8_BAR; PG8_WAIT_L(0); PG8_MMA(0, 1, At, B1); PG8_BAR;
      PG8_LDA(At, 0, 1); PG8_STAGE(PG8_SA(0, 0), a2, voffA);
      PG8_BAR; PG8_WAIT_L(0); PG8_MMA(1, 0, At, B0); PG8_BAR; PG8_SCHED;
      PG8_STAGE(PG8_SB(0, 1), b2 + hstep, voffB);
      PG8_WAIT_V(6); PG8_BAR; PG8_MMA(1, 1, At, B1); PG8_BAR;
      PG8_LDB(B0, 1, 0); PG8_SCHED; PG8_LDA(At, 1, 0); PG8_STAGE(PG8_SA(0, 1), a2 + hstep, voffA);
      PG8_WAIT_L(8); PG8_BAR; PG8_WAIT_L(0); PG8_MMA(0, 0, At, B0); PG8_BAR; PG8_SCHED;
      PG8_LDB(B1, 1, 1); PG8_STAGE(PG8_SB(1, 0), b3, voffB);
      PG8_BAR; PG8_WAIT_L(0); PG8_MMA(0, 1, At, B1); PG8_BAR;
      PG8_LDA(At, 1, 1); PG8_STAGE(PG8_SA(1, 0), a3, voffA);
      PG8_BAR; PG8_WAIT_L(0); PG8_MMA(1, 0, At, B0); PG8_BAR; PG8_SCHED;
      PG8_STAGE(PG8_SB(1, 1), b3 + hstep, voffB);
      PG8_WAIT_V(6); PG8_BAR; PG8_MMA(1, 1, At, B1); PG8_BAR;
    }
    E(acc, cur, wr, wc, fr, fq); S.done(cur);
    if (!has_next) break;
#pragma unroll
    for (int a = 0; a < 2; ++a)
#pragma unroll
      for (int b = 0; b < 2; ++b)
#pragma unroll
        for (int m = 0; m < 4; ++m)
#pragma unroll
          for (int n = 0; n < 2; ++n) acc[a][b][m][n] = (f32x4){0.f, 0.f, 0.f, 0.f};
    cur = nxt; cA = nA; cB = nB; ++ui;
  }
  PG8_WAIT_V(0);
  if (wr == 0) PG8_BAR;
  PG8_BAR;
#undef PG8_SA
#undef PG8_SB
#undef PG8_STAGE
#undef PG8_LDA
#undef PG8_LDB
#undef PG8_MMA
#undef PG8_WAIT_V
#undef PG8_WAIT_L
#undef PG8_BAR
#undef PG8_SCHED
}
}

DI void gemm_store_phase(const bf16_t* A, const bf16_t* Bt, int M, int N, int K, bf16_t* C, int ldc, unsigned char* shm) {
  pg8::Gemm g; g.A = A; g.Bt = Bt; g.M = M; g.N = N; g.K = K; g.Kext = K;
  pg8::StaticOrder S; S.init(M, N, (int)gridDim.x, obid());
  pg8::EpiStore E; E.O = C; E.ldc = ldc; E.O1 = C;
  pg8::gemm_phase(( __attribute__((address_space(3))) unsigned char*)shm, g, S, E);
}
DI void gemm_store_sk_phase(const bf16_t* A, const bf16_t* Bt, int M, int N, int K, bf16_t* C, bf16_t* C1, int ldc, unsigned char* shm) {
  pg8::Gemm g; g.A = A; g.Bt = Bt; g.M = M; g.N = N; g.K = K; g.Kext = K / 2;
  pg8::SplitK2Order S; S.init(M, N, (int)gridDim.x, obid());
  pg8::EpiStore E; E.O = C; E.ldc = ldc; E.O1 = C1;
  pg8::gemm_phase(( __attribute__((address_space(3))) unsigned char*)shm, g, S, E);
}
DI void gemm_resid_phase(CPR p, const bf16_t* A, int K, const bf16_t* Bt, int l, int gate_off, bool first, bool splitk, unsigned char* shm, bool dummy = false) {
  pg8::Gemm g; g.A = A; g.Bt = Bt; g.M = 8192; g.N = 1024; g.K = K; g.Kext = splitk ? K / 2 : K;
  pg8::EpiResid E; E.xp = p.in[I_XP]; E.xs = p.in[I_XS]; E.out = p.out; E.mods_l = (const float*)(p.ws + OFF_MODS) + (size_t)l * 3 * 6144; E.gate_off = gate_off; E.first = first ? 1 : 0;
  E.p1 = (float*)(p.ws + OFF_BIG);
  if (dummy) { E.out = (float*)(p.ws + OFF_BIG) + 8388608; E.p1 = E.out; E.first = 0; }
  if (splitk) {
    pg8::SplitK2Order S; S.init(8192, 1024, (int)gridDim.x, obid());
    pg8::gemm_phase(( __attribute__((address_space(3))) unsigned char*)shm, g, S, E);
  } else {
    pg8::StaticOrder S; S.init(8192, 1024, (int)gridDim.x, obid());
    pg8::gemm_phase(( __attribute__((address_space(3))) unsigned char*)shm, g, S, E);
  }
}

DI void mods_item(CPR p, int it, char* smem) {
  const int tid = vtid();
  const int l = it / 96, n0 = (it % 96) * 64;
  float* sc = (float*)smem;
  float* red = sc + 3072;
  for (int i = tid; i < 3072; i += 256) {
    int rr = i >> 10, k = i & 1023;
    float cv = (rr == 0) ? p.in[I_CCTX][k] : p.in[I_C][(rr - 1) * 1024 + k];
    sc[i] = siluf(cv);
  }
  __syncthreads();
  const int cq = tid & 15, ks = tid >> 4;
  float a0[4] = {0, 0, 0, 0}, a1[4] = {0, 0, 0, 0}, a2[4] = {0, 0, 0, 0};
  const float* w = p.in[I_ADAW] + ((size_t)l * 1024 + ks * 64) * 6144 + n0 + cq * 4;
#pragma unroll 8
  for (int kk = 0; kk < 64; ++kk) {
    const pg8::f32x4 t4 = __builtin_nontemporal_load((const pg8::f32x4*)(w + (size_t)kk * 6144)); float4 w4 = make_float4(t4[0], t4[1], t4[2], t4[3]);
    int k = ks * 64 + kk;
    float s0 = sc[k], s1 = sc[1024 + k], s2 = sc[2048 + k];
    a0[0] += s0 * w4.x; a0[1] += s0 * w4.y; a0[2] += s0 * w4.z; a0[3] += s0 * w4.w;
    a1[0] += s1 * w4.x; a1[1] += s1 * w4.y; a1[2] += s1 * w4.z; a1[3] += s1 * w4.w;
    a2[0] += s2 * w4.x; a2[1] += s2 * w4.y; a2[2] += s2 * w4.z; a2[3] += s2 * w4.w;
  }
#pragma unroll
  for (int j = 0; j < 4; ++j) {
    red[(ks * 3 + 0) * 64 + cq * 4 + j] = a0[j];
    red[(ks * 3 + 1) * 64 + cq * 4 + j] = a1[j];
    red[(ks * 3 + 2) * 64 + cq * 4 + j] = a2[j];
  }
  __syncthreads();
  if (tid < 192) {
    int rr = tid >> 6, n = tid & 63;
    float s = 0.f;
#pragma unroll
    for (int k2 = 0; k2 < 16; ++k2) s += red[(k2 * 3 + rr) * 64 + n];
    float* mods = (float*)(p.ws + OFF_MODS);
    mods[(size_t)(l * 3 + rr) * 6144 + n0 + n] = s + p.in[I_ADAB][l * 6144 + n0 + n];
  }
  __syncthreads();
}

DI void conv_tile(CPR p, int t, char* smem) {
  const float* src = nullptr; size_t dsto = 0; int K = 0, N = 0, tt = -1;
  int rem = t;
#define JOB(SRC, DST, KK, NN) { int nt_ = ((KK) / 64) * (((NN) + 63) / 64); if (rem >= 0 && rem < nt_) { src = (SRC); dsto = (DST); K = (KK); N = (NN); tt = rem; } rem -= nt_; }
  JOB(p.in[I_NAQKV], W_NA_QKV, 1024, 3072)
  JOB(p.in[I_NAO], W_NA_O, 1024, 1024)
  JOB(p.in[I_GQKVG], W_GLA_QKVG, 1024, 3072)
  JOB(p.in[I_GG1], W_GLA_QKVG + 3072ull * 1024, 1024, 16)
  JOB(p.in[I_GG1] + 1024 * 16, W_GLA_QKVG + 3088ull * 1024, 1024, 16)
  JOB(p.in[I_GO], W_GLA_O, 1024, 1024)
  JOB(p.in[I_DQKV], W_DIFF_QKV, 1024, 3072)
  JOB(p.in[I_DO], W_DIFF_O, 1024, 1024)
  JOB(p.in[I_MDQ], W_MLA_DQKV, 1024, 384)
  JOB(p.in[I_MDKV], W_MLA_DQKV + 384ull * 1024, 1024, 288)
  JOB(p.in[I_MUQ], W_MLA_UQ, 384, 1536)
  JOB(p.in[I_MUKV], W_MLA_UKV, 256, 2048)
  JOB(p.in[I_MO], W_MLA_O, 1024, 1024)
  JOB(p.in[I_WUP] + 0ull * 1024 * 5632, W_UP + 0ull * 5632 * 1024, 1024, 5632)
  JOB(p.in[I_WUP] + 1ull * 1024 * 5632, W_UP + 1ull * 5632 * 1024, 1024, 5632)
  JOB(p.in[I_WUP] + 2ull * 1024 * 5632, W_UP + 2ull * 5632 * 1024, 1024, 5632)
  JOB(p.in[I_WUP] + 3ull * 1024 * 5632, W_UP + 3ull * 5632 * 1024, 1024, 5632)
  JOB(p.in[I_WDOWN] + 0ull * 2816 * 1024, W_DOWN + 0ull * 2816 * 1024, 2816, 1024)
  JOB(p.in[I_WDOWN] + 1ull * 2816 * 1024, W_DOWN + 1ull * 2816 * 1024, 2816, 1024)
  JOB(p.in[I_WDOWN] + 2ull * 2816 * 1024, W_DOWN + 2ull * 2816 * 1024, 2816, 1024)
  JOB(p.in[I_WDOWN] + 3ull * 2816 * 1024, W_DOWN + 3ull * 2816 * 1024, 2816, 1024)
#undef JOB
  if (tt < 0) return;
  const int tid = vtid();
  const int nnt = (N + 63) / 64;
  const int k0 = (tt / nnt) * 64, n0 = (tt % nnt) * 64;
  float* tl = (float*)smem;
#pragma unroll
  for (int i = 0; i < 4; ++i) {
    int id = tid + 256 * i, kr = id >> 4, c4 = id & 15;
    int n = n0 + c4 * 4;
    float4 v = make_float4(0.f, 0.f, 0.f, 0.f);
    if (n < N) { const pg8::f32x4 t4 = __builtin_nontemporal_load((const pg8::f32x4*)(src + (size_t)(k0 + kr) * N + n)); v = make_float4(t4[0], t4[1], t4[2], t4[3]); }
    tl[kr * 65 + c4 * 4 + 0] = v.x; tl[kr * 65 + c4 * 4 + 1] = v.y; tl[kr * 65 + c4 * 4 + 2] = v.z; tl[kr * 65 + c4 * 4 + 3] = v.w;
  }
  __syncthreads();
  bf16_t* dst = (bf16_t*)p.ws + dsto;
  const int n = tid & 63, kg = tid >> 6;
  if (n0 + n < N) {
#pragma unroll
    for (int g2 = 0; g2 < 2; ++g2) {
      int g = kg + 4 * g2;
      uint4 q;
      q.x = pack2(tl[(g * 8 + 0) * 65 + n], tl[(g * 8 + 1) * 65 + n]);
      q.y = pack2(tl[(g * 8 + 2) * 65 + n], tl[(g * 8 + 3) * 65 + n]);
      q.z = pack2(tl[(g * 8 + 4) * 65 + n], tl[(g * 8 + 5) * 65 + n]);
      q.w = pack2(tl[(g * 8 + 6) * 65 + n], tl[(g * 8 + 7) * 65 + n]);
      *(uint4*)(dst + (size_t)(n0 + n) * K + k0 + g * 8) = q;
    }
  }
  __syncthreads();
}
constexpr int CONV_TILES = 768 + 256 + 768 + 16 + 16 + 256 + 768 + 256 + 96 + 80 + 144 + 128 + 256 + 4 * 1408 + 4 * 704;

DI void phase0(CPR p, char* smem0) {
  char* smem = smem0 + (otid() >> 8) * 65536;
  for (int it = vbid(); it < 384 + 1024; it += nvb()) {
    if (it < 384) mods_item(p, it, smem);
    else conv_tile(p, it - 384, smem);
  }
}
DI void conv_ahead(CPR p, int l, char* smem0, int wg, int nwg) {
  char* smem = smem0 + (otid() >> 8) * 65536;
  const int vb = wg * 2 + (otid() >> 8), nv = nwg * 2;
  const int m0 = l == 0 ? 1024 : l == 1 ? 2080 : 3104, m1 = l == 0 ? 2080 : l == 1 ? 3104 : l == 2 ? 3808 : 3104;
  const int nm = m1 - m0;
  const int nmods = 0;
  const int total = nmods + 1408 + 704 + nm;
  for (int t0 = vb; t0 < total; t0 += nv) {
    if (t0 < nmods) { mods_item(p, 96 + t0, smem); continue; }
    const int t = t0 - nmods;
    int tile = t < 1408 ? 3808 + 1408 * l + t : (t < 2112 ? 9440 + 704 * l + (t - 1408) : m0 + (t - 2112));
    conv_tile(p, tile, smem);
  }
}

DI void norm_phase(CPR p, int l, int which, bool from_input, bool addp1) {
  const int lane = otid() & 63, wave = otid() >> 6;
  const float* g = p.in[which ? I_NFFN : I_NMIX] + l * 1024;
  const float* mods = (const float*)(p.ws + OFF_MODS);
  bf16_t* h = (bf16_t*)(p.ws + OFF_H);
  const int rpw = 8192 / ((int)gridDim.x * 8);
  const int row_begin = (rpw * (int)gridDim.x * 8 == 8192) ? (obid() * 8 + wave) * rpw : obid() * 8 + wave;
  const int row_end = (rpw * (int)gridDim.x * 8 == 8192) ? row_begin + rpw : 8192;
  const int row_step = (rpw * (int)gridDim.x * 8 == 8192) ? 1 : (int)gridDim.x * 8;
  for (int row = row_begin; row < row_end; row += row_step) {
    const float* x = from_input ? (row < 4096 ? p.in[I_XP] + (size_t)row * 1024 : p.in[I_XS] + (size_t)(row - 4096) * 1024) : p.out + (size_t)row * 1024;
    int mr = row < 4096 ? 0 : (row < 6144 ? 1 : 2);
    const float* md = mods + (size_t)(l * 3 + mr) * 6144 + which * 3072;
    float4 v[4];
    float ss = 0.f;
#pragma unroll
    for (int j = 0; j < 4; ++j) {
      v[j] = *(const float4*)(x + j * 256 + lane * 4);
      if (addp1) {
        const float4 q = *(const float4*)((const float*)(p.ws + OFF_BIG) + (size_t)row * 1024 + j * 256 + lane * 4);
        v[j].x += q.x; v[j].y += q.y; v[j].z += q.z; v[j].w += q.w;
        *(float4*)(p.out + (size_t)row * 1024 + j * 256 + lane * 4) = v[j];
      }
      ss += v[j].x * v[j].x + v[j].y * v[j].y + v[j].z * v[j].z + v[j].w * v[j].w;
    }
#pragma unroll
    for (int o = 32; o >= 1; o >>= 1) ss += __shfl_xor(ss, o);
    float rs = rsqrtf(ss * (1.f / 1024.f) + 1e-6f);
#pragma unroll
    for (int j = 0; j < 4; ++j) {
      int col = j * 256 + lane * 4;
      float4 gg = *(const float4*)(g + col), sh = *(const float4*)(md + col), scl = *(const float4*)(md + 1024 + col);
      float y0 = v[j].x * rs * gg.x * (1.f + scl.x) + sh.x;
      float y1 = v[j].y * rs * gg.y * (1.f + scl.y) + sh.y;
      float y2 = v[j].z * rs * gg.z * (1.f + scl.z) + sh.z;
      float y3 = v[j].w * rs * gg.w * (1.f + scl.w) + sh.w;
      uint2 q; q.x = pack2(y0, y1); q.y = pack2(y2, y3);
      *(uint2*)(h + (size_t)row * 1024 + col) = q;
    }
  }
}

DI void final_add_phase(CPR p) {
  const float* p1 = (const float*)(p.ws + OFF_BIG);
  for (int idx = gtid(); idx < 8192 * 256; idx += gthreads()) {
    float4 a = *(const float4*)(p.out + (size_t)idx * 4), b = *(const float4*)(p1 + (size_t)idx * 4);
    a.x += b.x; a.y += b.y; a.z += b.z; a.w += b.w;
    *(float4*)(p.out + (size_t)idx * 4) = a;
  }
}

DI void convgate_phase(CPR p, int l) {
  const bf16_t* u = (const bf16_t*)(p.ws + OFF_BIG);
  bf16_t* a = (bf16_t*)(p.ws + OFF_MIX);
  const float* cw = p.in[I_CONVW] + (size_t)l * 3 * 5632;
  const float* cb = p.in[I_CONVB] + (size_t)l * 5632;
  for (int idx = gtid(); idx < 1024 * 352; idx += gthreads()) {
    int rg = idx / 352, f = (idx % 352) * 8;
    int row0 = rg * 8;
    int T = row0 < 4096 ? 256 : 2048;
    int t0 = row0 < 4096 ? (row0 & 255) : ((row0 - 4096) & 2047);
    float w0g[8], w1g[8], w2g[8], bg[8], w0v[8], w1v[8], w2v[8], bv[8];
#pragma unroll
    for (int e2 = 0; e2 < 8; ++e2) {
      w0g[e2] = cw[f + e2]; w1g[e2] = cw[5632 + f + e2]; w2g[e2] = cw[2 * 5632 + f + e2]; bg[e2] = cb[f + e2];
      w0v[e2] = cw[2816 + f + e2]; w1v[e2] = cw[5632 + 2816 + f + e2]; w2v[e2] = cw[2 * 5632 + 2816 + f + e2]; bv[e2] = cb[2816 + f + e2];
    }
    const bf16_t* ur = u + (size_t)row0 * 5632 + f;
    float gp[8], vp[8], gc[8], vc[8], gn[8], vn[8];
    if (t0 > 0) { load_bf16_row<8>(ur - 5632, gp); load_bf16_row<8>(ur - 5632 + 2816, vp); }
    else {
#pragma unroll
      for (int e2 = 0; e2 < 8; ++e2) { gp[e2] = 0.f; vp[e2] = 0.f; }
    }
    load_bf16_row<8>(ur, gc); load_bf16_row<8>(ur + 2816, vc);
#pragma unroll
    for (int j = 0; j < 8; ++j) {
      if (t0 + j < T - 1) { load_bf16_row<8>(ur + (size_t)(j + 1) * 5632, gn); load_bf16_row<8>(ur + (size_t)(j + 1) * 5632 + 2816, vn); }
      else {
#pragma unroll
        for (int e2 = 0; e2 < 8; ++e2) { gn[e2] = 0.f; vn[e2] = 0.f; }
      }
      float res[8];
#pragma unroll
      for (int e2 = 0; e2 < 8; ++e2) {
        float gg = gp[e2] * w0g[e2] + gc[e2] * w1g[e2] + gn[e2] * w2g[e2] + bg[e2];
        float vv = vp[e2] * w0v[e2] + vc[e2] * w1v[e2] + vn[e2] * w2v[e2] + bv[e2];
        res[e2] = siluf(gg) * vv;
      }
      store_bf16_row<8>(a + (size_t)(row0 + j) * 2816 + f, res);
#pragma unroll
      for (int e2 = 0; e2 < 8; ++e2) { gp[e2] = gc[e2]; vp[e2] = vc[e2]; gc[e2] = gn[e2]; vc[e2] = vn[e2]; }
    }
  }
}

template <int DQK, int DV, class TileF, class ScoreF>
DI void flash_wave(const bf16_t* q0, int ntiles, float scale, TileF tilef, ScoreF scoref, f32x16 (&O)[DV / 32], float& m_run, float& l_run, int r, int hh) {
  constexpr int NK = DQK / 16, NV = DV / 32;
  bf16x8 qf[NK];
#pragma unroll
  for (int kk = 0; kk < NK; ++kk) qf[kk] = *(const bf16x8*)(q0 + (size_t)r * DQK + kk * 16 + hh * 8);
#pragma unroll
  for (int t = 0; t < NV; ++t)
#pragma unroll
    for (int i = 0; i < 16; ++i) O[t][i] = 0.f;
  m_run = 0.f;
  l_run = 0.f;
  constexpr bool PREFV = (DV <= 64);
  bf16x8 kc[NK], vc[2][NV];
  auto loadk = [&](int it, bf16x8 (&k)[NK]) {
    const bf16_t* kp; const bf16_t* vp; int vs;
    tilef(it, kp, vp, vs);
    const unsigned ko = (unsigned)r * DQK + hh * 8;
#pragma unroll
    for (int kk = 0; kk < NK; ++kk) k[kk] = *(const bf16x8*)(kp + (ko + kk * 16));
  };
  auto loadv = [&](int it, bf16x8 (&v)[2][NV]) {
    const bf16_t* kp; const bf16_t* vp; int vs;
    tilef(it, kp, vp, vs);
#pragma unroll
    for (int s2 = 0; s2 < 2; ++s2)
#pragma unroll
      for (int t = 0; t < NV; ++t) v[s2][t] = *(const bf16x8*)(vp + ((unsigned)r * (unsigned)vs + 8u * hh + (unsigned)(t * 32) * (unsigned)vs + 16u * s2));
  };
  loadk(0, kc);
  if (PREFV) loadv(0, vc);
  for (int it = 0; it < ntiles; ++it) {
    bf16x8 kn[NK], vn[2][NV];
    const int nx = min(it + 1, ntiles - 1);
    loadk(nx, kn);
    if (PREFV) loadv(nx, vn); else loadv(it, vc);
    f32x16 s;
#pragma unroll
    for (int i = 0; i < 16; ++i) s[i] = -m_run;
#pragma unroll
    for (int kk = 0; kk < NK; ++kk) s = MFMA32(kc[kk], qf[kk], s);
    float mx = -1e30f;
#pragma unroll
    for (int i = 0; i < 16; ++i) { float v = scoref(it, i, s[i]); s[i] = v; mx = fmaxf(mx, v); }
    if (__any(mx > 8.f)) {
      mx = fmaxf(mx, __shfl_xor(mx, 32));
      const float delta = fmaxf(mx, 0.f);
      const float alpha = __builtin_amdgcn_exp2f(-delta);
      m_run += delta;
      l_run *= alpha;
#pragma unroll
      for (int i = 0; i < 16; ++i) s[i] -= delta;
#pragma unroll
      for (int t = 0; t < NV; ++t)
#pragma unroll
        for (int i = 0; i < 16; ++i) O[t][i] *= alpha;
    }
    float sum = 0.f;
#pragma unroll
    for (int i = 0; i < 16; ++i) { float pv = __builtin_amdgcn_exp2f(s[i]); s[i] = pv; sum += pv; }
    l_run += sum;
#pragma unroll
    for (int s2 = 0; s2 < 2; ++s2) {
      union { uint4 q; bf16x8 v; } pb;
      pb.q.x = pack2(s[8 * s2 + 0], s[8 * s2 + 1]); pb.q.y = pack2(s[8 * s2 + 2], s[8 * s2 + 3]);
      pb.q.z = pack2(s[8 * s2 + 4], s[8 * s2 + 5]); pb.q.w = pack2(s[8 * s2 + 6], s[8 * s2 + 7]);
#pragma unroll
      for (int t = 0; t < NV; ++t) O[t] = MFMA32(vc[s2][t], pb.v, O[t]);
    }
#pragma unroll
    for (int kk = 0; kk < NK; ++kk) kc[kk] = kn[kk];
    if (PREFV) {
#pragma unroll
      for (int s2 = 0; s2 < 2; ++s2)
#pragma unroll
        for (int t = 0; t < NV; ++t) vc[s2][t] = vn[s2][t];
    }
  }
  l_run += __shfl_xor(l_run, 32);
}
template <int DQK, int DV, int NKS, bool PIPE>
DI void flash_block(const bf16_t* q0, int ntiles, float scale, const bf16_t* kb0, const bf16_t* kb1, const bf16_t* vb, int vs, char* lds, int ks,
                    f32x16 (&O)[DV / 32], float& m_run, float& l_run, int tid, int r, int hh) {
  constexpr int NK = DQK / 16, NV = DV / 32;
  constexpr int KROW = DQK * 2 + 16, VROW = 80;
  constexpr int KBYTES = NKS * 32 * KROW, STAGE = KBYTES + DV * VROW;
  constexpr int KCH = 32 * (DQK / 8), NKC = NKS * KCH, TOT = NKC + DV * 4, NJ = (TOT + 255) / 256;
  bf16x8 qf[NK];
#pragma unroll
  for (int kk = 0; kk < NK; ++kk) qf[kk] = *(const bf16x8*)(q0 + (size_t)r * DQK + kk * 16 + hh * 8);
#pragma unroll
  for (int t = 0; t < NV; ++t)
#pragma unroll
    for (int i = 0; i < 16; ++i) O[t][i] = 0.f;
  m_run = 0.f;
  l_run = 0.f;
  static_assert(NJ >= 3 && NJ <= 4, "loader written for 3 or 4 chunks per thread");
  const bf16_t *gp0, *gp1, *gp2, *gp3; int gi0, gi1, gi2, gi3, lo0, lo1, lo2, lo3;
  auto setup = [&](int j, const bf16_t*& gp, int& ginc, int& loff) __attribute__((always_inline)) {
    int c = tid + 256 * j;
    if (c >= TOT) c -= 256;
    if (c < NKC) {
      int s = c / KCH, rem = c % KCH, row = rem / (DQK / 8), c8 = rem % (DQK / 8);
      gp = (s == 0 ? kb0 : kb1) + (size_t)row * DQK + c8 * 8;
      ginc = 32 * DQK;
      loff = s * 32 * KROW + row * KROW + c8 * 16;
    } else {
      int c2 = c - NKC;
      int dv = c2 >> 2, q = c2 & 3;
      gp = vb + c2 * 8;
      ginc = DV * 32;
      loff = KBYTES + dv * VROW + q * 16;
    }
  };
  setup(0, gp0, gi0, lo0); setup(1, gp1, gi1, lo1); setup(2, gp2, gi2, lo2); setup(NJ > 3 ? 3 : 2, gp3, gi3, lo3);
  uint4 sa0, sa1, sa2, sa3, sb0, sb1, sb2, sb3;
#define gload(S, IT) do { S##0 = *(const uint4*)(gp0 + (size_t)(IT) * gi0); S##1 = *(const uint4*)(gp1 + (size_t)(IT) * gi1); S##2 = *(const uint4*)(gp2 + (size_t)(IT) * gi2); \
    if (NJ > 3) S##3 = *(const uint4*)(gp3 + (size_t)(IT) * gi3); } while (0)
#define swrite(S, SI) do { char* sd_ = lds + (SI) * STAGE; *(uint4*)(sd_ + lo0) = S##0; *(uint4*)(sd_ + lo1) = S##1; *(uint4*)(sd_ + lo2) = S##2; if (NJ > 3) *(uint4*)(sd_ + lo3) = S##3; } while (0)
  const int koff = ks * 32 * KROW + r * KROW + hh * 16;
  const int voff = KBYTES + r * VROW + hh * 16;
  int stg = 0;
  if constexpr (PIPE) {
    gload(sa, 0);
    gload(sb, min(1, ntiles - 1));
    __syncthreads();
    swrite(sa, 0);
    swrite(sb, 1);
    gload(sb, min(2, ntiles - 1));
    __syncthreads();
    f32x16 sn;
#pragma unroll
    for (int i = 0; i < 16; ++i) sn[i] = 0.f;
#pragma unroll
    for (int kk = 0; kk < NK; ++kk) { bf16x8 kf = *(const bf16x8*)(lds + koff + kk * 32); sn = MFMA32(kf, qf[kk], sn); }
#define FB_BODY_P(IT, SLOAD, SWRITE) do { \
      gload(SLOAD, min((IT) + 3, ntiles - 1)); \
      const char* sb = lds + stg * STAGE; \
      const int stg1 = (stg == 2) ? 0 : stg + 1; \
      const char* sbnx = lds + stg1 * STAGE; \
      f32x16 s = sn; \
      _Pragma("unroll") for (int i = 0; i < 16; ++i) sn[i] = -m_run; \
      _Pragma("unroll") for (int kk = 0; kk < NK; ++kk) { bf16x8 kf = *(const bf16x8*)(sbnx + koff + kk * 32); sn = MFMA32(kf, qf[kk], sn); } \
      float mx = -1e30f; \
      _Pragma("unroll") for (int i = 0; i < 16; ++i) mx = fmaxf(mx, s[i]); \
      if (__any(mx > 8.f)) { \
        mx = fmaxf(mx, __shfl_xor(mx, 32)); \
        const float delta = fmaxf(mx, 0.f); \
        const float alpha = __builtin_amdgcn_exp2f(-delta); \
        m_run += delta; \
        l_run *= alpha; \
        _Pragma("unroll") for (int i = 0; i < 16; ++i) { s[i] -= delta; sn[i] -= delta; } \
        _Pragma("unroll") for (int t = 0; t < NV; ++t) _Pragma("unroll") for (int i = 0; i < 16; ++i) O[t][i] *= alpha; \
      } \
      float sum = 0.f; \
      _Pragma("unroll") for (int i = 0; i < 16; ++i) { float pv = __builtin_amdgcn_exp2f(s[i]); s[i] = pv; sum += pv; } \
      l_run += sum; \
      _Pragma("unroll") for (int s2 = 0; s2 < 2; ++s2) { \
        union { uint4 q; bf16x8 v; } pb; \
        pb.q.x = pack2(s[8 * s2 + 0], s[8 * s2 + 1]); pb.q.y = pack2(s[8 * s2 + 2], s[8 * s2 + 3]); \
        pb.q.z = pack2(s[8 * s2 + 4], s[8 * s2 + 5]); pb.q.w = pack2(s[8 * s2 + 6], s[8 * s2 + 7]); \
        _Pragma("unroll") for (int t = 0; t < NV; ++t) { bf16x8 vf = *(const bf16x8*)(sb + voff + t * 32 * VROW + s2 * 32); O[t] = MFMA32(vf, pb.v, O[t]); } \
      } \
      swrite(SWRITE, (stg1 == 2) ? 0 : stg1 + 1); \
      stg = stg1; \
      __syncthreads(); \
    } while (0)
    for (int it = 0; it < ntiles; it += 2) {
      FB_BODY_P(it, sa, sb);
      FB_BODY_P(it + 1, sb, sa);
    }
#undef FB_BODY_P
    l_run += __shfl_xor(l_run, 32);
    return;
  }
  gload(sa, 0);
  gload(sb, 1);
  __syncthreads();
  swrite(sa, 0);
  __syncthreads();
#define FB_BODY(IT, SLOAD, SWRITE) do { \
    gload(SLOAD, min((IT) + 2, ntiles - 1)); \
    const char* sb = lds + stg * STAGE; \
    f32x16 s; \
    _Pragma("unroll") for (int i = 0; i < 16; ++i) s[i] = -m_run; \
    _Pragma("unroll") for (int kk = 0; kk < NK; ++kk) { bf16x8 kf = *(const bf16x8*)(sb + koff + kk * 32); s = MFMA32(kf, qf[kk], s); } \
    float mx = -1e30f; \
    _Pragma("unroll") for (int i = 0; i < 16; ++i) mx = fmaxf(mx, s[i]); \
    if (__any(mx > 8.f)) { \
      mx = fmaxf(mx, __shfl_xor(mx, 32)); \
      const float delta = fmaxf(mx, 0.f); \
      const float alpha = __builtin_amdgcn_exp2f(-delta); \
      m_run += delta; \
      l_run *= alpha; \
      _Pragma("unroll") for (int i = 0; i < 16; ++i) s[i] -= delta; \
      _Pragma("unroll") for (int t = 0; t < NV; ++t) _Pragma("unroll") for (int i = 0; i < 16; ++i) O[t][i] *= alpha; \
    } \
    float sum = 0.f; \
    _Pragma("unroll") for (int i = 0; i < 16; ++i) { float pv = __builtin_amdgcn_exp2f(s[i]); s[i] = pv; sum += pv; } \
    l_run += sum; \
    _Pragma("unroll") for (int s2 = 0; s2 < 2; ++s2) { \
      union { uint4 q; bf16x8 v; } pb; \
      pb.q.x = pack2(s[8 * s2 + 0], s[8 * s2 + 1]); pb.q.y = pack2(s[8 * s2 + 2], s[8 * s2 + 3]); \
      pb.q.z = pack2(s[8 * s2 + 4], s[8 * s2 + 5]); pb.q.w = pack2(s[8 * s2 + 6], s[8 * s2 + 7]); \
      _Pragma("unroll") for (int t = 0; t < NV; ++t) { bf16x8 vf = *(const bf16x8*)(sb + voff + t * 32 * VROW + s2 * 32); O[t] = MFMA32(vf, pb.v, O[t]); } \
    } \
    stg = (stg == 2) ? 0 : stg + 1; \
    swrite(SWRITE, stg); \
    __syncthreads(); \
  } while (0)
  for (int it = 0; it < ntiles; it += 2) {
    FB_BODY(it, sa, sb);
    FB_BODY(it + 1, sb, sa);
  }
#undef FB_BODY
  l_run += __shfl_xor(l_run, 32);
}
#undef gload
#undef swrite
template <int NT> DI void store_o(bf16_t* o, int ldo, f32x16 (&O)[NT], float linv, int r, int hh) {
#pragma unroll
  for (int t = 0; t < NT; ++t)
#pragma unroll
    for (int ig = 0; ig < 4; ++ig) {
      uint2 q;
      q.x = pack2(O[t][ig * 4 + 0] * linv, O[t][ig * 4 + 1] * linv);
      q.y = pack2(O[t][ig * 4 + 2] * linv, O[t][ig * 4 + 3] * linv);
      *(uint2*)(o + (size_t)r * ldo + t * 32 + 8 * ig + 4 * hh) = q;
    }
}

template <bool ROPE> DI void headnorm8(float (&v)[8], const float* g, int sub, float extra, int t) {
  float ss = 0.f;
#pragma unroll
  for (int e = 0; e < 8; ++e) ss += v[e] * v[e];
  ss += __shfl_xor(ss, 1); ss += __shfl_xor(ss, 2); ss += __shfl_xor(ss, 4);
  const float rs = rsqrtf(ss * (1.f / 64.f) + 1e-6f) * extra;
  const float4 g0 = *(const float4*)(g + sub * 8), g1 = *(const float4*)(g + sub * 8 + 4);
  v[0] *= rs * g0.x; v[1] *= rs * g0.y; v[2] *= rs * g0.z; v[3] *= rs * g0.w;
  v[4] *= rs * g1.x; v[5] *= rs * g1.y; v[6] *= rs * g1.z; v[7] *= rs * g1.w;
  if (ROPE) {
    const float pos = (sub & 4) ? (float)(t & 63) : (float)(t >> 6);
    const bool second = (sub >> 1) & 1;
#pragma unroll
    for (int e = 0; e < 8; ++e) {
      const float other = __shfl_xor(v[e], 2);
      const int f = (sub & 1) * 8 + e;
      const float ang = pos * exp2f(-(float)f * (13.287712379549449f / 16.f));
      const float c = __cosf(ang), s = __sinf(ang);
      v[e] = second ? (other * s + v[e] * c) : (v[e] * c - other * s);
    }
  }
}

constexpr size_t L0_QB = 0, L0_KB = 16 * MB, L0_VT = 32 * MB, L0_KC = 48 * MB, L0_VCT = 49 * MB;
DI void prep0_phase(CPR p) {
  const bf16_t* big = (const bf16_t*)(p.ws + OFF_BIG);
  char* mix = p.ws + OFF_MIX;
  bf16_t* qb = (bf16_t*)(mix + L0_QB); bf16_t* kb = (bf16_t*)(mix + L0_KB); bf16_t* vT = (bf16_t*)(mix + L0_VT);
  bf16_t* kc = (bf16_t*)(mix + L0_KC); bf16_t* vcT = (bf16_t*)(mix + L0_VCT);
  for (int idx = gtid(); idx < 2 * 8192 * 16 * 8; idx += gthreads()) {
    int sub = idx & 7, hd = (idx >> 3) & 15, row = (idx >> 7) & 8191, which = idx >> 20;
    float v[8];
    load_bf16_row<8>(big + (size_t)row * 3072 + which * 1024 + hd * 64 + sub * 8, v);
    headnorm8<false>(v, p.in[which ? I_NAKN : I_NAQN], sub, which ? 1.f : 0.125f * 1.4426950408889634f, 0);
    store_bf16_row<8>((which ? kb : qb) + ((size_t)hd * 8192 + row) * 64 + sub * 8, v);
    if (which && row < 4096) store_f32_row<8>(p.out + O_L0K + (((size_t)(row >> 8) * 16 + hd) * 256 + (row & 255)) * 64 + sub * 8, v);
  }
  for (int idx = gtid(); idx < 4096 * 128; idx += gthreads()) {
    int row = idx >> 7, c = (idx & 127) * 8;
    float v[8];
    load_bf16_row<8>(big + (size_t)row * 3072 + 2048 + c, v);
    int hd = c >> 6, d = c & 63;
    store_f32_row<8>(p.out + O_L0V + (((size_t)(row >> 8) * 16 + hd) * 256 + (row & 255)) * 64 + d, v);
  }
  transpose_gen<true>(1024, 8192, vT, 8192, [&](int rr, int c) { return big[(size_t)rr * 3072 + 2048 + c]; });
  const float* ck = p.in[I_C0K]; const float* cv = p.in[I_C0V];
  for (int idx = gtid(); idx < 2 * 16 * 256 * 64 / 8; idx += gthreads()) {
    float v[8];
#pragma unroll
    for (int e = 0; e < 8; ++e) v[e] = ck[(size_t)idx * 8 + e];
    store_bf16_row<8>(kc + (size_t)idx * 8, v);
  }
  transpose_gen<true>(2048, 256, vcT, 256, [&](int l_, int c) { return f2bf(cv[((size_t)(c >> 6) * 256 + l_) * 64 + (c & 63)]); });
}

DI void attn0_phase(CPR p, char* smem0) {
  char* smem = smem0 + (otid() >> 8) * 65536;
  const int tid = vtid(), lane = tid & 63, wave = tid >> 6, r = lane & 31, hh = lane >> 5;
  char* mix = p.ws + OFF_MIX;
  const bf16_t* qb = (const bf16_t*)(mix + L0_QB); const bf16_t* kb = (const bf16_t*)(mix + L0_KB); const bf16_t* vT = (const bf16_t*)(mix + L0_VT);
  const bf16_t* kc = (const bf16_t*)(mix + L0_KC); const bf16_t* vcT = (const bf16_t*)(mix + L0_VCT);
  bf16_t* o = (bf16_t*)(p.ws + OFF_O);
  float* sbias = (float*)smem;
  for (int it = vbid(); it < 1024; it += nvb()) {
    f32x16 O[2];
    float m_run, l_run;
    if (it < 512) {
      int b = it >> 8, hd = (it >> 4) & 15, blk = it & 15;
      __syncthreads();
      for (int i = tid; i < 465; i += 256) sbias[i] = p.in[I_NABIAS][hd * 465 + i] * 1.4426950408889634f;
      __syncthreads();
      int gr = blk * 2 + (wave >> 1), cq0 = (wave & 1) * 32;
      int grow_q = 4096 + b * 2048 + gr * 64 + cq0;
      int kr0 = min(max(gr - 4, 0), 24);
      int qc = cq0 + r;
      int win0 = min(max(qc - 8, 0), 48);
      const bf16_t* kcb = kc + (size_t)(b * 16 + hd) * 256 * 64;
      const bf16_t* vcb = vcT + (size_t)(b * 16 + hd) * 64 * 256;
      const bf16_t* kbb = kb + ((size_t)hd * 8192 + 4096 + b * 2048) * 64;
      const bf16_t* vtb = vT + (size_t)hd * 64 * 8192 + 4096 + b * 2048;
      flash_wave<64, 64>(qb + ((size_t)hd * 8192 + grow_q) * 64, 24, 0.125f * 1.4426950408889634f,
        [&](int ti, const bf16_t*& kp, const bf16_t*& vp, int& vs) {
          if (ti < 8) { kp = kcb + ti * 32 * 64; vp = vcb + ti * 32; vs = 256; }
          else { int lt = ti - 8; int tok = (kr0 + (lt >> 1)) * 64 + (lt & 1) * 32; kp = kbb + (size_t)tok * 64; vp = vtb + tok; vs = 8192; }
        },
        [&](int ti, int i, float s) {
          if (ti < 8) return s;
          int lt = ti - 8;
          int kcol = (lt & 1) * 32 + crow(i, hh);
          int roff = kr0 + (lt >> 1) - gr + 7;
          int coff = min(max(kcol - qc + 15, 0), 30);
          bool valid = (kcol >= win0) && (kcol < win0 + 16);
          return valid ? s + sbias[roff * 31 + coff] : -1e30f;
        },
        O, m_run, l_run, r, hh);
      store_o<2>(o + (size_t)grow_q * 1024 + hd * 64, 1024, O, 1.f / l_run, r, hh);
    } else {
      int pi = it - 512;
      int b = pi >> 5, hd = (pi >> 1) & 15, qbk = pi & 1;
      int grow_q = b * 256 + qbk * 128 + wave * 32;
      const bf16_t* kbb = kb + ((size_t)hd * 8192 + b * 256) * 64;
      const bf16_t* vtb = vT + (size_t)hd * 64 * 8192 + b * 256;
      flash_wave<64, 64>(qb + ((size_t)hd * 8192 + grow_q) * 64, 8, 0.125f * 1.4426950408889634f,
        [&](int ti, const bf16_t*& kp, const bf16_t*& vp, int& vs) { kp = kbb + ti * 32 * 64; vp = vtb + ti * 32; vs = 8192; },
        [&](int, int, float s) { return s; }, O, m_run, l_run, r, hh);
      store_o<2>(o + (size_t)grow_q * 1024 + hd * 64, 1024, O, 1.f / l_run, r, hh);
    }
  }
}

constexpr size_t L1_QE = 0, L1_KE = 16 * MB, L1_KDT = 32 * MB, L1_VT = 48 * MB, L1_DTOT = 64 * MB;
constexpr size_t L1_ODIR = 8192ull * 3328 * 2;
DI void prep1_phase(CPR p, char* smem0) {
  char* smem = smem0 + (otid() >> 8) * 65536;
  const int tid = vtid();
  const bf16_t* big = (const bf16_t*)(p.ws + OFF_BIG);
  char* mix = p.ws + OFF_MIX;
  bf16_t* qe = (bf16_t*)(mix + L1_QE); bf16_t* ke = (bf16_t*)(mix + L1_KE); bf16_t* kdT = (bf16_t*)(mix + L1_KDT);
  bf16_t* vT = (bf16_t*)(mix + L1_VT); float* dtot = (float*)(mix + L1_DTOT);
  float* rr = (float*)smem;
  bf16_t* qs = (bf16_t*)(smem + 8192);
  bf16_t* ks = (bf16_t*)(smem + 8192 + 16384);
  for (int it = vbid(); it < 128 * 4; it += nvb()) {
    int ch = it >> 2, hd = it & 3;
    int grow0 = ch * 64;
    __syncthreads();
    for (int i = tid; i < 64 * 32; i += 256) rr[i] = bf2f(big[(size_t)(grow0 + (i >> 5)) * 3328 + 3072 + (i & 31)]);
#pragma unroll
    for (int j = 0; j < 4; ++j) {
      int c = tid + 256 * j, row = c >> 4, pc = c & 15;
      *(uint4*)(qs + row * 128 + pc * 8) = *(const uint4*)(big + (size_t)(grow0 + row) * 3328 + hd * 128 + pc * 8);
      *(uint4*)(ks + row * 128 + pc * 8) = *(const uint4*)(big + (size_t)(grow0 + row) * 3328 + 512 + hd * 128 + pc * 8);
    }
    __syncthreads();
    int dir = tid >> 7, k = tid & 127;
    float w2[16];
#pragma unroll
    for (int j = 0; j < 16; ++j) w2[j] = p.in[I_GG2][((size_t)dir * 16 + j) * 512 + hd * 128 + k];
    float bg = p.in[I_GBG][dir * 512 + hd * 128 + k];
    float lgv[64];
    float btot = 0.f;
#pragma unroll
    for (int t = 0; t < 64; ++t) {
      float x = bg;
      const float4* r4 = (const float4*)(rr + t * 32 + dir * 16);
#pragma unroll
      for (int j4 = 0; j4 < 4; ++j4) { float4 rv = r4[j4]; x += rv.x * w2[j4 * 4] + rv.y * w2[j4 * 4 + 1] + rv.z * w2[j4 * 4 + 2] + rv.w * w2[j4 * 4 + 3]; }
      float ls = fminf(x, 0.f) - __logf(1.f + __expf(-fabsf(x)));
      lgv[t] = ls * (1.f / 16.f);
      btot += lgv[t];
    }
    float bc = 0.f;
    size_t dbase = ((size_t)dir * 4 + hd) * 8192;
    bf16_t* kdt_row = kdT + ((((size_t)dir * 4 + hd) * 128 + ch) * 128 + k) * 64;
#pragma unroll
    for (int tt = 0; tt < 64; ++tt) {
      const int tf = tt, tb = 63 - tt;
      bc += dir ? lgv[tb] : lgv[tf];
      const int t = dir ? tb : tf;
      float qv = bf2f(qs[t * 128 + k]);
      float kv = bf2f(ks[t * 128 + k]);
      qe[(dbase + grow0 + t) * 128 + k] = f2bf(qv * 0.08838834764831845f * __expf(bc));
      ke[(dbase + grow0 + t) * 128 + k] = f2bf(kv * __expf(-bc));
      kdt_row[t] = f2bf(kv * __expf(btot - bc));
    }
    dtot[(((size_t)dir * 4 + hd) * 128 + ch) * 128 + k] = __expf(btot);
  }
  transpose_gen<false>(1024, 8192, vT, 8192, [&](int r_, int c) { return big[(size_t)r_ * 3328 + 1024 + c]; });
}

DI void scan1_phase(CPR p, char* smem0) {
  char* smem = smem0 + (otid() >> 8) * 65536;
  const int tid = vtid(), lane = tid & 63, wave = tid >> 6, r = lane & 31, hh = lane >> 5;
  char* mix = p.ws + OFF_MIX;
  const bf16_t* qe = (const bf16_t*)(mix + L1_QE); const bf16_t* ke = (const bf16_t*)(mix + L1_KE); const bf16_t* kdT = (const bf16_t*)(mix + L1_KDT);
  const bf16_t* vT = (const bf16_t*)(mix + L1_VT); const float* dtot = (const float*)(mix + L1_DTOT);
  bf16_t* odir = (bf16_t*)(p.ws + OFF_BIG + L1_ODIR);
  bf16_t* St = (bf16_t*)smem;
  bf16_t* al = (bf16_t*)(smem + 8704);
  char* vls = smem + 17920;
  float* dts = (float*)(smem + 27136);
  char* qes = smem + 28160;
  char* kes = smem + 45568;
  const int wg_ = obid(), half_ = otid() >> 8, nwg_ = (int)gridDim.x;
  const bool spread = nwg_ >= 256;
  int it0, itstep, nsync_target = 0;
  if (spread) {
    if (wg_ < 128 && half_ == 0) { it0 = wg_; itstep = 1 << 20; }
    else {
      const int lam = wg_ < 128 ? wg_ : 128 + 2 * (wg_ - 128) + half_;
      it0 = 128 + lam; itstep = 128 + 2 * (nwg_ - 128);
    }
    if (wg_ < 128) nsync_target = 1 + 3 * 32;
  } else { it0 = vbid(); itstep = nvb(); }
  int nsync_done = 0;
  for (int it = it0; it < 1152; it += itstep) {
    bool samp = it < 128;
    int q_ = samp ? it : it - 128;
    int b = q_ >> 6, hd = (q_ >> 4) & 3, dir = (q_ >> 3) & 1, vsl = q_ & 7;
    int grow0 = samp ? 4096 + b * 2048 : b * 256;
    int nc = samp ? 32 : 4;
    const int ti = wave >> 1, xi = wave & 1;
    f32x16 S;
    if (samp) {
      const float* s0 = p.in[dir ? I_SB : I_SF] + ((size_t)(b * 4 + hd) * 128) * 256;
#pragma unroll
      for (int i = 0; i < 16; ++i) S[i] = s0[(size_t)(wave * 32 + crow(i, hh)) * 256 + vsl * 32 + r];
    } else {
#pragma unroll
      for (int i = 0; i < 16; ++i) S[i] = 0.f;
    }
    auto write_St = [&]() {
#pragma unroll
      for (int ig = 0; ig < 4; ++ig) {
        uint2 q;
        q.x = pack2(S[ig * 4 + 0], S[ig * 4 + 1]);
        q.y = pack2(S[ig * 4 + 2], S[ig * 4 + 3]);
        *(uint2*)(St + r * 136 + wave * 32 + 8 * ig + 4 * hh) = q;
      }
    };
    const size_t dbase = ((size_t)dir * 4 + hd) * 8192;
    const bf16_t* vsrc = vT + ((size_t)hd * 256 + vsl * 32 + (tid >> 3)) * 8192 + (tid & 7) * 8;
    const int vdst = (tid >> 3) * 144 + (tid & 7) * 16;
    const float* dsrc = dtot + (((size_t)dir * 4 + hd) * 128) * 128 + (tid & 127);
    const bf16_t* qsrc = qe + dbase * 128 + tid * 8;
    const bf16_t* ksrc = ke + dbase * 128 + tid * 8;
    const int tdst = (tid >> 4) * 272 + (tid & 15) * 16;
    bf16x8 kd[4], kdN[4];
    uint4 vst, qst0, qst1, qst2, qst3, kst0, kst1, kst2, kst3; float dtst;
#define SC_GROW(CC) (grow0 + ((dir ? nc - 1 - (CC) : (CC)) << 6))
#define SC_LOADKD(CC, KD) do { const bf16_t* kd_p = kdT + ((((size_t)dir * 4 + hd) * 128 + (SC_GROW(CC) >> 6)) * 128 + wave * 32 + r) * 64 + hh * 8; \
      _Pragma("unroll") for (int kk = 0; kk < 4; ++kk) KD[kk] = *(const bf16x8*)(kd_p + kk * 16); } while (0)
#define SC_LOADST(CC) do { const int g_ = SC_GROW(CC); vst = *(const uint4*)(vsrc + g_); dtst = dsrc[(size_t)(g_ >> 6) * 128]; \
      const bf16_t* q_p = qsrc + (size_t)g_ * 128; const bf16_t* k_p = ksrc + (size_t)g_ * 128; \
      qst0 = *(const uint4*)(q_p); qst1 = *(const uint4*)(q_p + 2048); qst2 = *(const uint4*)(q_p + 4096); qst3 = *(const uint4*)(q_p + 6144); \
      kst0 = *(const uint4*)(k_p); kst1 = *(const uint4*)(k_p + 2048); kst2 = *(const uint4*)(k_p + 4096); kst3 = *(const uint4*)(k_p + 6144); } while (0)
#define SC_WRITEST(BUF) do { *(uint4*)(vls + (BUF) * 4608 + vdst) = vst; if (tid < 128) dts[(BUF) * 128 + tid] = dtst; \
      *(uint4*)(qes + tdst) = qst0; *(uint4*)(qes + tdst + 16 * 272) = qst1; *(uint4*)(qes + tdst + 32 * 272) = qst2; *(uint4*)(qes + tdst + 48 * 272) = qst3; \
      *(uint4*)(kes + tdst) = kst0; *(uint4*)(kes + tdst + 16 * 272) = kst1; *(uint4*)(kes + tdst + 32 * 272) = kst2; *(uint4*)(kes + tdst + 48 * 272) = kst3; } while (0)
    SC_LOADST(0);
    SC_LOADKD(0, kd);
    __syncthreads();
    write_St();
    SC_WRITEST(0);
    for (int cc = 0; cc < nc; ++cc) {
      const int ccn = min(cc + 1, nc - 1);
      const int growc = SC_GROW(cc);
      const char* vcur = vls + (cc & 1) * 4608;
      const float* dcur = dts + (cc & 1) * 128;
      SC_LOADST(ccn);
      SC_LOADKD(ccn, kdN);
      __syncthreads();
      bf16x8 qf[8];
      f32x16 acc;
#pragma unroll
      for (int i = 0; i < 16; ++i) acc[i] = 0.f;
#pragma unroll
      for (int kk = 0; kk < 8; ++kk) {
        qf[kk] = *(const bf16x8*)(qes + (ti * 32 + r) * 272 + kk * 32 + hh * 16);
        bf16x8 kf = *(const bf16x8*)(kes + (xi * 32 + r) * 272 + kk * 32 + hh * 16);
        acc = MFMA32(qf[kk], kf, acc);
      }
#pragma unroll
      for (int i = 0; i < 16; ++i) {
        int t = ti * 32 + crow(i, hh), s = xi * 32 + r;
        bool keep = dir ? (s >= t) : (s <= t);
        al[t * 72 + s] = f2bf(keep ? acc[i] : 0.f);
      }
      __syncthreads();
      if (xi == 0) {
#pragma unroll
        for (int i = 0; i < 16; ++i) acc[i] = 0.f;
#pragma unroll
        for (int kk = 0; kk < 8; ++kk) {
          bf16x8 sf = *(const bf16x8*)(St + r * 136 + kk * 16 + hh * 8);
          acc = MFMA32(qf[kk], sf, acc);
        }
#pragma unroll
        for (int kk = 0; kk < 4; ++kk) {
          bf16x8 af = *(const bf16x8*)(al + (ti * 32 + r) * 72 + kk * 16 + hh * 8);
          bf16x8 vf = *(const bf16x8*)(vcur + r * 144 + kk * 32 + hh * 16);
          acc = MFMA32(af, vf, acc);
        }
#pragma unroll
        for (int i = 0; i < 16; ++i)
          odir[((size_t)dir * 8192 + growc + ti * 32 + crow(i, hh)) * 1024 + hd * 256 + vsl * 32 + r] = f2bf(acc[i]);
      }
#pragma unroll
      for (int i = 0; i < 16; ++i) S[i] *= dcur[wave * 32 + crow(i, hh)];
#pragma unroll
      for (int kk = 0; kk < 4; ++kk) {
        bf16x8 vf = *(const bf16x8*)(vcur + r * 144 + kk * 32 + hh * 16);
        S = MFMA32(kd[kk], vf, S);
      }
      __syncthreads();
      write_St();
      SC_WRITEST((cc + 1) & 1);
#pragma unroll
      for (int kk = 0; kk < 4; ++kk) kd[kk] = kdN[kk];
    }
#undef SC_GROW
#undef SC_LOADKD
#undef SC_LOADST
#undef SC_WRITEST
    nsync_done += 1 + 3 * nc;
    if (!samp) {
      const int t2 = vtid(), r2 = t2 & 31, h2 = (t2 >> 5) & 1, w2 = t2 >> 6;
      float* so = p.out + (dir ? O_L1B : O_L1F) + ((size_t)(b * 4 + hd) * 128) * 256 + (size_t)(w2 * 32 + 4 * h2) * 256 + vsl * 32 + r2;
#pragma unroll
      for (int i = 0; i < 16; ++i) so[((i & 3) + 8 * (i >> 2)) * 256] = S[i];
    }
  }
  for (; nsync_done < nsync_target; ++nsync_done) __syncthreads();
}

DI void gla_out_phase(CPR p) {
  const bf16_t* big = (const bf16_t*)(p.ws + OFF_BIG);
  const bf16_t* odir = (const bf16_t*)(p.ws + OFF_BIG + L1_ODIR);
  bf16_t* o = (bf16_t*)(p.ws + OFF_O);
  const float* gn = p.in[I_GON];
  for (int idx = gtid(); idx < 8192 * 4 * 32; idx += gthreads()) {
    int sub = idx & 31, hd = (idx >> 5) & 3, row = idx >> 7;
    int col = hd * 256 + sub * 8;
    float a[8], b2[8], g[8];
    load_bf16_row<8>(odir + (size_t)row * 1024 + col, a);
    load_bf16_row<8>(odir + ((size_t)8192 + row) * 1024 + col, b2);
    load_bf16_row<8>(big + (size_t)row * 3328 + 2048 + col, g);
    float ss = 0.f;
#pragma unroll
    for (int e = 0; e < 8; ++e) { a[e] += b2[e]; ss += a[e] * a[e]; }
#pragma unroll
    for (int ofs = 16; ofs >= 1; ofs >>= 1) ss += __shfl_xor(ss, ofs);
    float rs = rsqrtf(ss * (1.f / 256.f) + 1e-6f);
#pragma unroll
    for (int e = 0; e < 8; ++e) a[e] = a[e] * rs * gn[sub * 8 + e] * siluf(g[e]);
    store_bf16_row<8>(o + (size_t)row * 1024 + col, a);
  }
}

constexpr size_t L2_QD = 0, L2_KDP = 16 * MB, L2_KDS = 24 * MB, L2_VTP = 34 * MB, L2_VTS = 42 * MB;
DI void prep2_phase(CPR p) {
  const bf16_t* big = (const bf16_t*)(p.ws + OFF_BIG);
  char* mix = p.ws + OFF_MIX;
  bf16_t* qd = (bf16_t*)(mix + L2_QD); bf16_t* kdp = (bf16_t*)(mix + L2_KDP); bf16_t* kds = (bf16_t*)(mix + L2_KDS);
  bf16_t* vtp = (bf16_t*)(mix + L2_VTP); bf16_t* vts = (bf16_t*)(mix + L2_VTS);
  for (int idx = gtid(); idx < 2 * 8192 * 16 * 8; idx += gthreads()) {
    int sub = idx & 7, hd = (idx >> 3) & 15, row = (idx >> 7) & 8191, which = idx >> 20;
    float v[8];
    load_bf16_row<8>(big + (size_t)row * 3072 + which * 1024 + hd * 64 + sub * 8, v);
    const float extra = which ? 1.f : 0.125f * 1.4426950408889634f;
    if (row >= 4096) headnorm8<true>(v, p.in[which ? I_DKN : I_DQN], sub, extra, (row - 4096) & 2047);
    else headnorm8<false>(v, p.in[which ? I_DKN : I_DQN], sub, extra, 0);
    if (!which) store_bf16_row<8>(qd + ((size_t)hd * 8192 + row) * 64 + sub * 8, v);
    else if (row < 4096) {
      store_bf16_row<8>(kdp + ((size_t)hd * 4096 + row) * 64 + sub * 8, v);
      store_f32_row<8>(p.out + O_L2K + (((size_t)(row >> 8) * 16 + hd) * 256 + (row & 255)) * 64 + sub * 8, v);
    } else {
      int b = (row - 4096) >> 11, t = (row - 4096) & 2047;
      store_bf16_row<8>(kds + (((size_t)b * 16 + hd) * 2304 + 256 + t) * 64 + sub * 8, v);
    }
  }
  for (int idx = gtid(); idx < 4096 * 128; idx += gthreads()) {
    int row = idx >> 7, c = (idx & 127) * 8;
    float v[8];
    load_bf16_row<8>(big + (size_t)row * 3072 + 2048 + c, v);
    int hd = c >> 7, d = c & 127;
    store_f32_row<8>(p.out + O_L2V + (((size_t)(row >> 8) * 8 + hd) * 256 + (row & 255)) * 128 + d, v);
  }
  transpose_gen<true, 128>(1024, 4096, vtp, (size_t)128 * 4096, [&](int r_, int c) { return big[(size_t)r_ * 3072 + 2048 + c]; }, 0);
  for (int b = 0; b < 2; ++b)
    transpose_gen<true, 128>(1024, 2048, vts + (size_t)b * 1024 * 2304, (size_t)128 * 2304, [&](int r_, int c) { return big[(size_t)(4096 + b * 2048 + r_) * 3072 + 2048 + c]; }, 256);
  const float* ck = p.in[I_C2K]; const float* cv = p.in[I_C2V];
  for (int idx = gtid(); idx < 2 * 16 * 256 * 8; idx += gthreads()) {
    int bh = idx >> 11, rem = idx & 2047;
    float v[8];
#pragma unroll
    for (int e = 0; e < 8; ++e) v[e] = ck[(size_t)idx * 8 + e];
    store_bf16_row<8>(kds + (size_t)bh * 2304 * 64 + (size_t)rem * 8, v);
  }
  transpose_gen<true, 128>(2048, 256, vts, (size_t)128 * 2304, [&](int l_, int c) { return f2bf(cv[((size_t)(c >> 7) * 256 + l_) * 128 + (c & 127)]); }, 0);
}

DI void attn2_phase(CPR p, char* smem0) {
  char* smem = smem0 + (otid() >> 8) * 65536;
  const int tid = vtid(), lane = tid & 63, wave = tid >> 6, r = lane & 31, hh = lane >> 5;
  float* xch = (float*)smem;
  float lam;
  {
    const float* dl = p.in[I_DLAM];
    float a = dl[lane] * dl[64 + lane], b2 = dl[128 + lane] * dl[192 + lane];
#pragma unroll
    for (int ofs = 32; ofs >= 1; ofs >>= 1) { a += __shfl_xor(a, ofs); b2 += __shfl_xor(b2, ofs); }
    lam = __expf(a) - __expf(b2) + 0.47071301834435835f;
  }
  const int qs = wave >> 1, comp = wave & 1;
  for (int it = vbid(); it < 1024; it += nvb()) {
    CPP pl = (CPP)__builtin_amdgcn_kernarg_segment_ptr();
    asm volatile("" : "+s"(pl));
    char* mix = pl->ws + OFF_MIX;
    const bf16_t* qd = (const bf16_t*)(mix + L2_QD); const bf16_t* kdp = (const bf16_t*)(mix + L2_KDP); const bf16_t* kds = (const bf16_t*)(mix + L2_KDS);
    const bf16_t* vtp = (const bf16_t*)(mix + L2_VTP); const bf16_t* vts = (const bf16_t*)(mix + L2_VTS);
    bf16_t* o = (bf16_t*)(pl->ws + OFF_O);
    f32x16 O[4];
    float m_run, l_run;
    int grow_q, hd;
    {
      const bf16_t *k0, *k1, *vb_; int vs_, nt_;
      if (it < 512) {
        int b = it >> 8; hd = (it >> 5) & 7; int blk = it & 31;
        grow_q = 4096 + b * 2048 + blk * 64 + qs * 32;
        k0 = kds + ((size_t)b * 16 + hd) * 2304 * 64; k1 = kds + ((size_t)b * 16 + 8 + hd) * 2304 * 64;
        vb_ = vts + ((size_t)b * 8 + hd) * 128 * 2304; vs_ = 2304; nt_ = 72;
      } else {
        int pi = it - 512;
        int b = pi >> 5; hd = (pi >> 2) & 7; int blk = pi & 3;
        grow_q = b * 256 + blk * 64 + qs * 32;
        k0 = kdp + ((size_t)hd * 4096 + b * 256) * 64; k1 = kdp + ((size_t)(8 + hd) * 4096 + b * 256) * 64;
        vb_ = vtp + (size_t)hd * 128 * 4096 + (size_t)b * 256 * 128; vs_ = 4096; nt_ = 8;
      }
      flash_block<64, 128, 2, false>(qd + ((size_t)(comp * 8 + hd) * 8192 + grow_q) * 64, nt_, 0.125f * 1.4426950408889634f, k0, k1, vb_, vs_, smem, comp, O, m_run, l_run, tid, r, hh);
    }
    float linv = 1.f / l_run;
    __syncthreads();
    if (comp == 1) {
#pragma unroll
      for (int t = 0; t < 4; ++t)
#pragma unroll
        for (int i = 0; i < 16; ++i) xch[(qs * 64 + t * 16 + i) * 64 + lane] = O[t][i] * linv;
    }
    __syncthreads();
    if (comp == 0) {
      float ss = 0.f;
#pragma unroll
      for (int t = 0; t < 4; ++t)
#pragma unroll
        for (int i = 0; i < 16; ++i) {
          float v = O[t][i] * linv - lam * xch[(qs * 64 + t * 16 + i) * 64 + lane];
          O[t][i] = v;
          ss += v * v;
        }
      ss += __shfl_xor(ss, 32);
      float rs = rsqrtf(ss * (1.f / 128.f) + 1e-6f) * 0.52928698165564165f;
      const float* gs = p.in[I_DSUB];
#pragma unroll
      for (int t = 0; t < 4; ++t)
#pragma unroll
        for (int i = 0; i < 16; ++i) O[t][i] *= rs * gs[t * 32 + crow(i, hh)];
      store_o<4>(o + (size_t)grow_q * 1024 + hd * 128, 1024, O, 1.f, r, hh);
    }
  }
}

constexpr size_t L3_QAN = 0, L3_CKVN = 6 * MB, L3_QM = 11 * MB, L3_KMP = 35 * MB, L3_KMS = 47 * MB, L3_VTP = 61 * MB, L3_VTS = 69 * MB;
constexpr size_t L3_Q1 = 8192ull * 768 * 2, L3_KV1 = L3_Q1 + 8192ull * 1536 * 2, L3_DQ2 = L3_KV1 + 8704ull * 2048 * 2;
DI void prep3a_phase(CPR p) {
  const int lane = otid() & 63, wave = otid() >> 6;
  const bf16_t* big = (const bf16_t*)(p.ws + OFF_BIG);
  char* mix = p.ws + OFF_MIX;
  bf16_t* qan = (bf16_t*)(mix + L3_QAN); bf16_t* ckvn = (bf16_t*)(mix + L3_CKVN);
  for (int row = obid() * 8 + wave; row < 8192; row += gridDim.x * 8) {
    bf16_t* br = (bf16_t*)(p.ws + OFF_BIG) + (size_t)row * 768;
    const bf16_t* br2 = (const bf16_t*)(p.ws + OFF_BIG + L3_DQ2) + (size_t)row * 768;
    float q[6], ss = 0.f;
#pragma unroll
    for (int j = 0; j < 6; ++j) { q[j] = bf2f(br[j * 64 + lane]) + bf2f(br2[j * 64 + lane]); ss += q[j] * q[j]; }
#pragma unroll
    for (int ofs = 32; ofs >= 1; ofs >>= 1) ss += __shfl_xor(ss, ofs);
    float rs = rsqrtf(ss * (1.f / 384.f) + 1e-6f);
#pragma unroll
    for (int j = 0; j < 6; ++j) qan[(size_t)row * 384 + j * 64 + lane] = f2bf(q[j] * rs * p.in[I_MQAN][j * 64 + lane]);
    float c[4]; ss = 0.f;
#pragma unroll
    for (int j = 0; j < 4; ++j) { c[j] = bf2f(br[384 + j * 64 + lane]) + bf2f(br2[384 + j * 64 + lane]); ss += c[j] * c[j]; }
#pragma unroll
    for (int ofs = 32; ofs >= 1; ofs >>= 1) ss += __shfl_xor(ss, ofs);
    rs = rsqrtf(ss * (1.f / 256.f) + 1e-6f);
#pragma unroll
    for (int j = 0; j < 4; ++j) {
      float y = c[j] * rs * p.in[I_MKVAN][j * 64 + lane];
      ckvn[(size_t)row * 256 + j * 64 + lane] = f2bf(y);
      if (row < 4096) p.out[O_L3C + (size_t)row * 256 + j * 64 + lane] = y;
    }
    if (lane < 32) {
      const float kr = bf2f(br[640 + lane]) + bf2f(br2[640 + lane]);
      br[640 + lane] = f2bf(kr);
      if (row < 4096) p.out[O_L3R + (size_t)row * 32 + lane] = kr;
    }
  }
  for (int idx = gtid(); idx < 512 * 256; idx += gthreads()) ckvn[(size_t)8192 * 256 + idx] = f2bf(p.in[I_C3C][idx]);
}

DI void prep3b_phase(CPR p) {
  const bf16_t* big = (const bf16_t*)(p.ws + OFF_BIG);
  const bf16_t* q1 = (const bf16_t*)(p.ws + OFF_BIG + L3_Q1);
  const bf16_t* kv1 = (const bf16_t*)(p.ws + OFF_BIG + L3_KV1);
  char* mix = p.ws + OFF_MIX;
  bf16_t* qm = (bf16_t*)(mix + L3_QM); bf16_t* kmp = (bf16_t*)(mix + L3_KMP); bf16_t* kms = (bf16_t*)(mix + L3_KMS);
  bf16_t* vtp = (bf16_t*)(mix + L3_VTP); bf16_t* vts = (bf16_t*)(mix + L3_VTS);
  for (int idx = gtid(); idx < 8192 * 16 * 2; idx += gthreads()) {
    int half = idx & 1, hd = (idx >> 1) & 15, row = idx >> 5;
    float v[48];
    load_bf16_row<48>(q1 + (size_t)row * 1536 + hd * 96 + half * 48, v);
    float ss = 0.f;
#pragma unroll
    for (int j = 0; j < 48; ++j) ss += v[j] * v[j];
    ss += __shfl_xor(ss, 1);
    float rs = rsqrtf(ss * (1.f / 96.f) + 1e-6f);
    const float* g = p.in[I_MQN] + half * 48;
    rs *= 0.10206207261596577f * 1.4426950408889634f;
#pragma unroll
    for (int j = 0; j < 48; ++j) v[j] = v[j] * rs * g[j];
    if (half && row >= 4096) rope_apply<48, 16, 32>(v, (row - 4096) & 2047);
    store_bf16_row<48>(qm + ((size_t)hd * 8192 + row) * 96 + half * 48, v);
  }
  for (int idx = gtid(); idx < 8704 * 16 * 2; idx += gthreads()) {
    int half = idx & 1, hd = (idx >> 1) & 15, row = idx >> 5;
    float v[48];
    if (!half) {
      load_bf16_row<48>(kv1 + (size_t)row * 2048 + hd * 128, v);
    } else {
      float t16[16];
      load_bf16_row<16>(kv1 + (size_t)row * 2048 + hd * 128 + 48, t16);
#pragma unroll
      for (int j = 0; j < 16; ++j) v[j] = t16[j];
      if (row < 8192) {
        float t32[32];
        load_bf16_row<32>(big + (size_t)row * 768 + 640, t32);
#pragma unroll
        for (int j = 0; j < 32; ++j) v[16 + j] = t32[j];
      } else {
#pragma unroll
        for (int j = 0; j < 32; ++j) v[16 + j] = p.in[I_C3R][(size_t)(row - 8192) * 32 + j];
      }
    }
    float ss = 0.f;
#pragma unroll
    for (int j = 0; j < 48; ++j) ss += v[j] * v[j];
    ss += __shfl_xor(ss, 1);
    float rs = rsqrtf(ss * (1.f / 96.f) + 1e-6f);
    const float* g = p.in[I_MKN] + half * 48;
#pragma unroll
    for (int j = 0; j < 48; ++j) v[j] = v[j] * rs * g[j];
    if (row < 4096) store_bf16_row<48>(kmp + ((size_t)hd * 4096 + row) * 96 + half * 48, v);
    else if (row < 8192) {
      int b = (row - 4096) >> 11, t = (row - 4096) & 2047;
      if (half) rope_apply<48, 16, 32>(v, t);
      store_bf16_row<48>(kms + (((size_t)b * 16 + hd) * 2304 + 256 + t) * 96 + half * 48, v);
    } else {
      int b = (row - 8192) >> 8, l_ = (row - 8192) & 255;
      store_bf16_row<48>(kms + (((size_t)b * 16 + hd) * 2304 + l_) * 96 + half * 48, v);
    }
  }
  transpose_gen<true, 64>(1024, 4096, vtp, (size_t)64 * 4096, [&](int r_, int c) { return kv1[(size_t)r_ * 2048 + (c >> 6) * 128 + 64 + (c & 63)]; }, 0);
  for (int b = 0; b < 2; ++b) {
    transpose_gen<true, 64>(1024, 2048, vts + (size_t)b * 1024 * 2304, (size_t)64 * 2304, [&](int r_, int c) { return kv1[(size_t)(4096 + b * 2048 + r_) * 2048 + (c >> 6) * 128 + 64 + (c & 63)]; }, 256);
    transpose_gen<true, 64>(1024, 256, vts + (size_t)b * 1024 * 2304, (size_t)64 * 2304, [&](int r_, int c) { return kv1[(size_t)(8192 + b * 256 + r_) * 2048 + (c >> 6) * 128 + 64 + (c & 63)]; }, 0);
  }
}

DI void attn3_phase(CPR p, char* smem0) {
  char* smem = smem0 + (otid() >> 8) * 65536;
  const int tid = vtid(), lane = tid & 63, wave = tid >> 6, r = lane & 31, hh = lane >> 5;
  char* mix = p.ws + OFF_MIX;
  const bf16_t* qm = (const bf16_t*)(mix + L3_QM); const bf16_t* kmp = (const bf16_t*)(mix + L3_KMP); const bf16_t* kms = (const bf16_t*)(mix + L3_KMS);
  const bf16_t* vtp = (const bf16_t*)(mix + L3_VTP); const bf16_t* vts = (const bf16_t*)(mix + L3_VTS);
  bf16_t* o = (bf16_t*)(p.ws + OFF_O);
  const float scale = 0.10206207261596577f * 1.4426950408889634f;
  for (int it = vbid(); it < 1024; it += nvb()) {
    f32x16 O[2];
    float m_run, l_run;
    int grow_q, hd;
    const bf16_t *k0, *vb_; int vs_, nt_;
    if (it < 512) {
      int b = it >> 8; hd = (it >> 4) & 15; int blk = it & 15;
      grow_q = 4096 + b * 2048 + blk * 128 + wave * 32;
      k0 = kms + ((size_t)b * 16 + hd) * 2304 * 96;
      vb_ = vts + ((size_t)b * 16 + hd) * 64 * 2304; vs_ = 2304; nt_ = 72;
    } else {
      int pi = it - 512;
      int b = pi >> 5; hd = (pi >> 1) & 15; int blk = pi & 1;
      grow_q = b * 256 + blk * 128 + wave * 32;
      k0 = kmp + ((size_t)hd * 4096 + b * 256) * 96;
      vb_ = vtp + (size_t)hd * 64 * 4096 + (size_t)b * 256 * 64; vs_ = 4096; nt_ = 8;
    }
    flash_block<96, 64, 1, true>(qm + ((size_t)hd * 8192 + grow_q) * 96, nt_, scale, k0, k0, vb_, vs_, smem, 0, O, m_run, l_run, tid, r, hh);
    store_o<2>(o + (size_t)grow_q * 1024 + hd * 64, 1024, O, 1.f / l_run, r, hh);
  }
}

#define XB_TMO      128
#define XB_XCNT(j)  (256  + 64 * (j))
#define XB_XSUB(j)  (1280 + 64 * (j))
#define XB_XGEN(j)  (2304 + 64 * (j))
#define XB_TOP      3328
#define XB_TOPGEN   3392
#define XCD_BAR_WORDS 3456
#define XB_SPIN_CAP (1u << 18)
#define LAS __attribute__((address_space(3)))
DI unsigned xb_ld(unsigned* p) { return __hip_atomic_load(p, __ATOMIC_RELAXED, __HIP_MEMORY_SCOPE_AGENT); }
DI unsigned xb_add(unsigned* p, unsigned v) { return __hip_atomic_fetch_add(p, v, __ATOMIC_RELAXED, __HIP_MEMORY_SCOPE_AGENT); }
DI unsigned xb_xcc_id() { return (unsigned)__builtin_amdgcn_s_getreg((3 << 11) | 20) & 0xFu; }
#define XB_SPIN(cond, bar) do { unsigned _sp = 0; while (cond) { __builtin_amdgcn_s_sleep(1); \
    if ((++_sp & 255u) == 0u) { if (xb_ld(&(bar)[XB_TMO])) break; if (_sp > XB_SPIN_CAP) { atomicAdd(&(bar)[XB_TMO], 1u); break; } } } } while (0)
DI void xcd_barrier_complete(unsigned* bar, unsigned x, unsigned& nloc, unsigned& nx) {
  const unsigned G = gridDim.x;
  unsigned sum, cnt, mine, sp = 0u;
  for (;;) {
    sum = 0u; cnt = 0u; mine = 0u;
#pragma unroll
    for (unsigned j = 0; j < 16; ++j) { const unsigned c = xb_ld(&bar[XB_XCNT(j)]); sum += c; cnt += (c > 0u) ? 1u : 0u; mine = (j == x) ? c : mine; }
    if (sum == G) break;
    __builtin_amdgcn_s_sleep(1);
    if ((++sp & 255u) == 0u) { if (xb_ld(&bar[XB_TMO])) break; if (sp > XB_SPIN_CAP) { atomicAdd(&bar[XB_TMO], 1u); break; } }
  }
  nloc = mine > 0u ? mine : 1u; nx = cnt > 0u ? cnt : 1u;
}
DI void xcd_barrier(unsigned* bar, volatile LAS unsigned* st) {
  asm volatile("s_waitcnt vmcnt(0)" ::: "memory");
  __syncthreads();
  if (__builtin_amdgcn_workitem_id_x() == 0) {
    const unsigned x = xb_xcc_id();
    __builtin_amdgcn_s_waitcnt(0);
    unsigned nloc = st[0], nx = st[1];
    if (nloc == 0u) { xcd_barrier_complete(bar, x, nloc, nx); st[0] = nloc; st[1] = nx; }
    const unsigned old = xb_add(&bar[XB_XSUB(x)], 1u);
    const unsigned gen = old / nloc;
    if (old + 1u == (gen + 1u) * nloc) {
      __builtin_amdgcn_fence(__ATOMIC_RELEASE, "agent");
      asm volatile("s_waitcnt vmcnt(0)" ::: "memory");
      const unsigned og = xb_add(&bar[XB_TOP], 1u);
      const unsigned tg = og / nx;
      if (og + 1u == (tg + 1u) * nx) xb_add(&bar[XB_TOPGEN], 1u);
      else XB_SPIN(xb_ld(&bar[XB_TOPGEN]) == tg, bar);
      __builtin_amdgcn_fence(__ATOMIC_ACQUIRE, "agent");
      xb_add(&bar[XB_XGEN(x)], 1u);
      asm volatile("s_waitcnt vmcnt(0)" ::: "memory");
    } else {
      XB_SPIN(xb_ld(&bar[XB_XGEN(x)]) == gen, bar);
      __builtin_amdgcn_fence(__ATOMIC_ACQUIRE, "agent");
      asm volatile("s_waitcnt vmcnt(0)" ::: "memory");
    }
  }
  __syncthreads();
}

constexpr int LDS_BYTES = 131072 + 64;
__global__ void __launch_bounds__(512, 2) mega(Params p_unused) {
  extern __shared__ __attribute__((aligned(16))) unsigned char shm[];
  char* smem = (char*)shm;
  volatile LAS unsigned* xbw = (volatile LAS unsigned*)(shm + 131072);
  {
    CPP pq = (CPP)__builtin_amdgcn_kernarg_segment_ptr();
    unsigned* bar0 = (unsigned*)(pq->ws + OFF_BAR);
    const unsigned xid = xb_xcc_id();
    if (__builtin_amdgcn_workitem_id_x() == 0) {
      xbw[0] = 0u; xbw[1] = 0u;
      (void)xb_add(&bar0[XB_XCNT(xid)], 1u);
    }
  }
  __syncthreads();
  for (int ph = 0; ph < 46; ++ph) {
    CPP pp = (CPP)__builtin_amdgcn_kernarg_segment_ptr();
    asm volatile("" : "+s"(pp));
    CPR p = *pp;
    bf16_t* W = (bf16_t*)p.ws;
    bf16_t* H = (bf16_t*)(p.ws + OFF_H);
    bf16_t* BIG = (bf16_t*)(p.ws + OFF_BIG);
    bf16_t* OB = (bf16_t*)(p.ws + OFF_O);
    bf16_t* AB = (bf16_t*)(p.ws + OFF_MIX);
    char* mix = p.ws + OFF_MIX;
    if (ph == 0) {
      phase0(p, smem);
      if (REPMASK & 16) phase0(p, smem);
    } else if (ph == 45) {
      final_add_phase(p);
    } else {
      const int l = (ph - 1) / 11, step = (ph - 1) % 11;
      if ((step == 4 && (l == 0 || l == 2)) || (step == 5 && l != 3)) continue;
      int reps = 1;
      {
        const bool is_attn = (step == 3 && l != 3) || step == 5;
        const bool is_gemm_store = step == 1 || step == 8 || (step == 3 && l == 3);
        const bool is_misc = step == 0 || step == 2 || step == 7 || step == 9 || (step == 4);
        if ((REPMASK & 2) && is_gemm_store) reps = 2;
        if ((REPMASK & 4) && is_attn) reps = 2;
        if ((REPMASK & 8) && is_misc) reps = 2;
        if ((REPMASK & 32) && step == 3 && l == 0) reps = 2;
        if ((REPMASK & 64) && step == 3 && l == 1) reps = 2;
        if ((REPMASK & 128) && step == 3 && l == 2) reps = 2;
        if ((REPMASK & 256) && step == 5) reps = 2;
        if ((REPMASK & 512) && (step == 0 || step == 7)) reps = 2;
        if ((REPMASK & 1024) && step == 9) reps = 2;
        if ((REPMASK & 2048) && (step == 2 || step == 4)) reps = 2;
        if ((REPMASK & 16384) && step == 2 && l == 0) reps = 2;
        if ((REPMASK & 32768) && step == 2 && l == 1) reps = 2;
        if ((REPMASK & 65536) && step == 2 && l == 2) reps = 2;
        if ((REPMASK & 131072) && (step == 2 || step == 4) && l == 3) reps = 2;
        if ((REPMASK & 262144) && step == 4 && l == 1) reps = 2;
      }
      for (int rep = 0; rep < reps; ++rep)
      switch (step) {
        case 0: norm_phase(p, l, 0, l == 0, l > 0); break;
        case 1:
          if (l == 0) gemm_store_phase(H, W + W_NA_QKV, 8192, 3072, 1024, BIG, 3072, shm);
          else if (l == 1) gemm_store_phase(H, W + W_GLA_QKVG, 8192, 3328, 1024, BIG, 3328, shm);
          else if (l == 2) gemm_store_phase(H, W + W_DIFF_QKV, 8192, 3072, 1024, BIG, 3072, shm);
          else gemm_store_sk_phase(H, W + W_MLA_DQKV, 8192, 768, 1024, BIG, (bf16_t*)(p.ws + OFF_BIG + L3_DQ2), 768, shm);
          break;
        case 2:
          if (l == 0) prep0_phase(p);
          else if (l == 1) prep1_phase(p, smem);
          else if (l == 2) prep2_phase(p);
          else prep3a_phase(p);
          break;
        case 3:
          if (l == 0) attn0_phase(p, smem);
          else if (l == 1) scan1_phase(p, smem);
          else if (l == 2) attn2_phase(p, smem);
          else {
            const bf16_t* qan = (const bf16_t*)(mix + L3_QAN); const bf16_t* ckvn = (const bf16_t*)(mix + L3_CKVN);
            bf16_t* q1 = (bf16_t*)(p.ws + OFF_BIG + L3_Q1); bf16_t* kv1 = (bf16_t*)(p.ws + OFF_BIG + L3_KV1);
            gemm_store_phase(qan, W + W_MLA_UQ, 8192, 1536, 384, q1, 1536, shm);
            gemm_store_phase(ckvn, W + W_MLA_UKV, 8704, 2048, 256, kv1, 2048, shm);
          }
          break;
        case 4:
          if (l == 1) gla_out_phase(p);
          else prep3b_phase(p);
          break;
        case 5: attn3_phase(p, smem); break;
        case 6: {
          const bf16_t* wo = W + (l == 0 ? W_NA_O : l == 1 ? W_GLA_O : l == 2 ? W_DIFF_O : W_MLA_O);
          if ((int)gridDim.x >= 256 && obid() >= 128) conv_ahead(p, l, smem, obid() - 128, (int)gridDim.x - 128);
          else {
            if ((int)gridDim.x < 256 ) conv_ahead(p, l, smem, obid(), (int)gridDim.x);
            gemm_resid_phase(p, OB, 1024, wo, l, 2048, l == 0, false, shm);
          }
          if (REPMASK & 4096) gemm_resid_phase(p, OB, 1024, wo, l, 2048, l == 0, false, shm, true);
        } break;
        case 7: norm_phase(p, l, 1, false, false); break;
        case 8: gemm_store_phase(H, W + W_UP + (size_t)l * 5632 * 1024, 8192, 5632, 1024, BIG, 5632, shm); break;
        case 9: convgate_phase(p, l); break;
        default: gemm_resid_phase(p, AB, 2816, W + W_DOWN + (size_t)l * 1024 * 2816, l, 5120, false, true, shm);
          if (REPMASK & 8192) gemm_resid_phase(p, AB, 2816, W + W_DOWN + (size_t)l * 1024 * 2816, l, 5120, false, true, shm, true);
          break;
      }
    }
    if (ph < 45) {
      xcd_barrier((unsigned*)(p.ws + OFF_BAR), xbw);
      if (REPMASK & 1) xcd_barrier((unsigned*)(p.ws + OFF_BAR), xbw);
    }
  }
}

extern "C" void kernel_launch(void* const* d_in, const int* in_sizes, int n_in, void* d_out, int out_size, void* d_ws, size_t ws_size, hipStream_t stream) {
  static int grid_blocks = 0;
  if (!grid_blocks) {
    int dev = 0, cus = 0, per_cu = 0;
    (void)hipGetDevice(&dev);
    (void)hipDeviceGetAttribute(&cus, hipDeviceAttributeMultiprocessorCount, dev);
    (void)hipFuncSetAttribute((const void*)mega, hipFuncAttributeMaxDynamicSharedMemorySize, LDS_BYTES);
    (void)hipOccupancyMaxActiveBlocksPerMultiprocessor(&per_cu, mega, 512, LDS_BYTES);
    (void)hipGetLastError();
    grid_blocks = cus;
    if (per_cu < 1) grid_blocks = cus;
  }
  Params p{};
  for (int i = 0; i < 46; ++i) p.in[i] = (const float*)d_in[i];
  p.out = (float*)d_out;
  p.ws = (char*)d_ws;
  (void)hipMemsetAsync((char*)d_ws + OFF_BAR, 0, XCD_BAR_WORDS * 4, stream);
  void* args[] = {&p};
  (void)hipLaunchCooperativeKernel((void*)mega, dim3(grid_blocks), dim3(512), args, LDS_BYTES, stream);
}
```

```cpp
#include <hip/hip_runtime.h>
#include <hip/hip_cooperative_groups.h>
#include <stdint.h>
namespace cg = cooperative_groups;

typedef unsigned short bf16_t;
typedef __attribute__((ext_vector_type(8))) short bf16x8;
typedef __attribute__((ext_vector_type(4))) short bf16x4;
typedef __attribute__((ext_vector_type(16))) float f32x16;
#define DI __device__ __forceinline__
#define MFMA32(a, b, c) __builtin_amdgcn_mfma_f32_32x32x16_bf16((a), (b), (c), 0, 0, 0)

#ifndef REPMASK
#define REPMASK 0
#endif
constexpr size_t MB = 1ull << 20;
constexpr size_t W_NA_QKV = 0;
constexpr size_t W_NA_O = W_NA_QKV + 3072ull * 1024;
constexpr size_t W_GLA_QKVG = W_NA_O + 1024ull * 1024;
constexpr size_t W_GLA_O = W_GLA_QKVG + 3328ull * 1024;
constexpr size_t W_DIFF_QKV = W_GLA_O + 1024ull * 1024;
constexpr size_t W_DIFF_O = W_DIFF_QKV + 3072ull * 1024;
constexpr size_t W_MLA_DQKV = W_DIFF_O + 1024ull * 1024;
constexpr size_t W_MLA_UQ = W_MLA_DQKV + 768ull * 1024;
constexpr size_t W_MLA_UKV = W_MLA_UQ + 1536ull * 384;
constexpr size_t W_MLA_O = W_MLA_UKV + 2048ull * 256;
constexpr size_t W_UP = W_MLA_O + 1024ull * 1024;
constexpr size_t W_DOWN = W_UP + 4ull * 5632 * 1024;
constexpr size_t W_END = W_DOWN + 4ull * 1024 * 2816;
constexpr size_t OFF_H = ((W_END * 2 + 255) / 256) * 256;
constexpr size_t OFF_BIG = OFF_H + 8192ull * 1024 * 2;
constexpr size_t OFF_O = OFF_BIG + 8192ull * 5632 * 2;
constexpr size_t OFF_MODS = OFF_O + 8192ull * 1024 * 2;
constexpr size_t OFF_MIX = OFF_MODS + 512 * 1024;
constexpr size_t OFF_BAR = OFF_MIX + 100 * MB;
constexpr size_t O_L0K = 8388608, O_L0V = 12582912, O_L1F = 16777216, O_L1B = 18874368;
constexpr size_t O_L2K = 20971520, O_L2V = 25165824, O_L3C = 29360128, O_L3R = 30408704;

struct Params {
  const float* in[46];
  float* out;
  char* ws;
};
typedef const __attribute__((address_space(4))) Params& CPR;
typedef const __attribute__((address_space(4))) Params* CPP;
enum { I_XP = 0, I_XS, I_C0K, I_C0V, I_SF, I_SB, I_C2K, I_C2V, I_C3C, I_C3R, I_C, I_CCTX, I_ADAW, I_ADAB, I_NMIX, I_NFFN,
       I_WUP, I_CONVW, I_CONVB, I_WDOWN, I_NAQKV, I_NAQN, I_NAKN, I_NABIAS, I_NAO, I_GQKVG, I_GG1, I_GG2, I_GBG, I_GON, I_GO,
       I_DQKV, I_DQN, I_DKN, I_DLAM, I_DSUB, I_DO, I_MDQ, I_MQAN, I_MUQ, I_MDKV, I_MKVAN, I_MUKV, I_MQN, I_MKN, I_MO };

DI unsigned short f2bf(float x) {
  unsigned u = __float_as_uint(x);
  u += 0x7fffu + ((u >> 16) & 1u);
  return (unsigned short)(u >> 16);
}
DI float bf2f(unsigned short b) { return __uint_as_float(((unsigned)b) << 16); }
typedef __bf16 bf16v2_t __attribute__((ext_vector_type(2)));
typedef float f32v2_t __attribute__((ext_vector_type(2)));
DI unsigned pack2(float a, float b) { f32v2_t f = {a, b}; bf16v2_t h = __builtin_convertvector(f, bf16v2_t); return __builtin_bit_cast(unsigned, h); }
DI int crow(int i, int hh) { return (i & 3) + 8 * (i >> 2) + 4 * hh; }
DI float siluf(float x) { return x / (1.f + __expf(-x)); }
DI int otid() { int t = __builtin_amdgcn_workitem_id_x(); asm volatile("" : "+v"(t)); return t; }
DI int obid() { int b = __builtin_amdgcn_workgroup_id_x(); asm volatile("" : "+s"(b)); return b; }
DI int gtid() { return obid() * 512 + otid(); }
DI int gthreads() { return gridDim.x * 512; }
DI int vtid() { return otid() & 255; }
DI int vbid() { return obid() * 2 + (otid() >> 8); }
DI int nvb() { return gridDim.x * 2; }

template <int D> DI void load_bf16_row(const bf16_t* p, float (&v)[D]) {
#pragma unroll
  for (int j = 0; j < D / 8; ++j) {
    uint4 q = *(const uint4*)(p + j * 8);
    unsigned w[4] = {q.x, q.y, q.z, q.w};
#pragma unroll
    for (int e = 0; e < 4; ++e) { v[j * 8 + 2 * e] = __uint_as_float(w[e] << 16); v[j * 8 + 2 * e + 1] = __uint_as_float(w[e] & 0xffff0000u); }
  }
}
template <int D> DI void store_bf16_row(bf16_t* p, const float (&v)[D]) {
#pragma unroll
  for (int j = 0; j < D / 8; ++j) {
    uint4 q;
    q.x = pack2(v[j * 8 + 0], v[j * 8 + 1]); q.y = pack2(v[j * 8 + 2], v[j * 8 + 3]);
    q.z = pack2(v[j * 8 + 4], v[j * 8 + 5]); q.w = pack2(v[j * 8 + 6], v[j * 8 + 7]);
    *(uint4*)(p + j * 8) = q;
  }
}
template <int D> DI void store_f32_row(float* p, const float (&v)[D]) {
#pragma unroll
  for (int j = 0; j < D / 4; ++j) *(float4*)(p + j * 4) = make_float4(v[j * 4], v[j * 4 + 1], v[j * 4 + 2], v[j * 4 + 3]);
}
template <int D> DI void rms_apply(float (&v)[D], const float* g) {
  float ss = 0.f;
#pragma unroll
  for (int j = 0; j < D; ++j) ss += v[j] * v[j];
  float rs = rsqrtf(ss * (1.f / D) + 1e-6f);
#pragma unroll
  for (int j = 0; j < D; ++j) v[j] = v[j] * rs * g[j];
}
template <int D, int BASE, int R> DI void rope_apply(float (&v)[D], int t) {
  constexpr int NF = R / 4;
  float rowf = (float)(t >> 6), colf = (float)(t & 63);
#pragma unroll
  for (int a = 0; a < 2; ++a) {
#pragma unroll
    for (int f = 0; f < NF; ++f) {
      float freq = exp2f(-(float)f * (13.287712379549449f / NF));
      float ang = (a == 0 ? rowf : colf) * freq;
      float c = __cosf(ang), s = __sinf(ang);
      int i1 = BASE + a * 2 * NF + f, i2 = i1 + NF;
      float x1 = v[i1], x2 = v[i2];
      v[i1] = x1 * c - x2 * s;
      v[i2] = x1 * s + x2 * c;
    }
  }
}
template <bool PERMK, int DVH = 0, class F> DI void transpose_gen(int ncols, int nrows, bf16_t* dst, size_t dstride, F srcf, int koff = 0) {
  int total = ncols * (nrows >> 3);
  for (int idx = gtid(); idx < total; idx += gthreads()) {
    int c = idx % ncols, r0 = (idx / ncols) << 3;
    unsigned short e[8];
#pragma unroll
    for (int j = 0; j < 8; ++j) e[j] = srcf(r0 + j, c);
    const int k0 = koff + r0;
    bf16_t* drow = (DVH > 0) ? dst + (size_t)(c / (DVH > 0 ? DVH : 1)) * dstride + (size_t)(k0 >> 5) * (DVH * 32) + (c % (DVH > 0 ? DVH : 1)) * 32 + (k0 & 16)
                             : dst + (size_t)c * dstride + (k0 & ~15);
    if (PERMK) {
      uint2 q0, q1;
      q0.x = e[0] | ((unsigned)e[1] << 16); q0.y = e[2] | ((unsigned)e[3] << 16);
      q1.x = e[4] | ((unsigned)e[5] << 16); q1.y = e[6] | ((unsigned)e[7] << 16);
      bf16_t* d = drow + ((k0 & 8) ? 4 : 0);
      *(uint2*)d = q0;
      *(uint2*)(d + 8) = q1;
    } else {
      uint4 q;
      q.x = e[0] | ((unsigned)e[1] << 16); q.y = e[2] | ((unsigned)e[3] << 16);
      q.z = e[4] | ((unsigned)e[5] << 16); q.w = e[6] | ((unsigned)e[7] << 16);
      *(uint4*)(drow + (k0 & 8)) = q;
    }
  }
}

namespace pg8 {
#define PG8_LAS __attribute__((address_space(3)))
typedef float f32x4 __attribute__((ext_vector_type(4)));
typedef unsigned u32x4 __attribute__((ext_vector_type(4)));
constexpr int BM = 256, BK = 64, HALF = 128, HTB = HALF * BK * 2, STAGE_BYTES = 8 * HTB, NXCD = 8, WGM = 4;
DI int lds_byte(int r, int c) { const int st = (r >> 4) * 2 + (c >> 5), rr = r & 15, cc = c & 31, ob = rr * 64 + cc * 2; return st * 1024 + (ob ^ (((ob >> 9) & 1) << 5)); }
DI void stage_rc(int b, int& R, int& C) { const int st = b / 1024, sb = b % 1024, swz = sb ^ (((sb >> 9) & 1) << 5); R = (st >> 1) * 16 + swz / 64; C = (st & 1) * 32 + (swz % 64) / 2; }
DI int perm32(int rho) { const int n = rho >> 4, i = rho & 15; return 8 * (i >> 2) + 4 * n + (i & 3); }
struct Unit { int pm, pn, ks; };
struct Gemm { const bf16_t* A; const bf16_t* Bt; int M, N, K; int Kext; };
struct StaticOrder {
  int nM, nN, nwg, G, c;
  DI void init(int M, int N, int G_, int c_) { nM = M / BM; nN = N / BM; nwg = nM * nN; G = G_; c = c_; }
  DI bool next(int i, Unit& u) const {
    const long L = (long)i * G + c; if (L >= nwg) return false;
    int wgid = (int)L; { const int q = nwg / NXCD, r = nwg % NXCD, xcd = wgid % NXCD, off = wgid / NXCD; wgid = (xcd < r ? xcd * (q + 1) : r * (q + 1) + (xcd - r) * q) + off; }
    const int nig = WGM * nN, gid = wgid / nig, fm = gid * WGM, gsz = (nM - fm) < WGM ? (nM - fm) : WGM;
    u.pm = fm + ((wgid % nig) % gsz); u.pn = (wgid % nig) / gsz; u.ks = 0; return true;
  }
  DI void a_ready(const Unit&) const {}
  DI void done(const Unit&) const {}
};
struct SplitK2Order : StaticOrder {
  DI bool next(int i, Unit& u) const {
    const long L = (long)i * G + c; if (L >= 2 * nwg) return false;
    int wgid = (int)(L >> 1); { const int q = nwg / NXCD, r = nwg % NXCD, xcd = wgid % NXCD, off = wgid / NXCD; wgid = (xcd < r ? xcd * (q + 1) : r * (q + 1) + (xcd - r) * q) + off; }
    const int nig = WGM * nN, gid = wgid / nig, fm = gid * WGM, gsz = (nM - fm) < WGM ? (nM - fm) : WGM;
    u.pm = fm + ((wgid % nig) % gsz); u.pn = (wgid % nig) / gsz; u.ks = (int)(L & 1); return true;
  }
};
DI unsigned cvt_pk_bf16(float lo, float hi) { unsigned r; asm volatile("v_cvt_pk_bf16_f32 %0, %1, %2" : "=v"(r) : "v"(lo), "v"(hi)); return r; }
struct EpiStore {
  static constexpr bool PERM = true;
  bf16_t* O; int ldc; bf16_t* O1;
  DI void operator()(const f32x4 (&acc)[2][2][4][2], const Unit& u, int wr, int wc, int fr, int fq) const {
    const int row0 = u.pm * BM + wr * 64 + fr, col0 = u.pn * BM + wc * 32 + 8 * fq;
#pragma unroll
    for (int ai = 0; ai < 2; ++ai)
#pragma unroll
      for (int m = 0; m < 4; ++m) {
        bf16_t* rowp = (u.ks ? O1 : O) + (size_t)(row0 + ai * HALF + m * 16) * ldc + col0;
#pragma unroll
        for (int bj = 0; bj < 2; ++bj) {
          const f32x4 v0 = acc[ai][bj][m][0], v1 = acc[ai][bj][m][1];
          u32x4 w; w.x = cvt_pk_bf16(v0[0], v0[1]); w.y = cvt_pk_bf16(v0[2], v0[3]); w.z = cvt_pk_bf16(v1[0], v1[1]); w.w = cvt_pk_bf16(v1[2], v1[3]);
          *(u32x4*)(rowp + bj * HALF) = w;
        }
      }
  }
};
struct EpiResid {
  static constexpr bool PERM = false;
  const float* xp; const float* xs; float* out; const float* mods_l; int gate_off; int first; float* p1;
  DI void operator()(const f32x4 (&acc)[2][2][4][2], const Unit& u, int wr, int wc, int fr, int fq) const {
    const int rowb = u.pm * BM;
    const float* xin = first ? (rowb < 4096 ? xp + (size_t)rowb * 1024 : xs + (size_t)(rowb - 4096) * 1024) : out + (size_t)rowb * 1024;
    float* xo = (u.ks ? p1 : out) + (size_t)rowb * 1024;
    const int mr = rowb < 4096 ? 0 : (rowb < 6144 ? 1 : 2);
    const float* gate = mods_l + (size_t)mr * 6144 + gate_off;
    const int col0 = u.pn * BM + wc * 32 + 4 * fq;
    f32x4 gv[2][2];
#pragma unroll
    for (int bj = 0; bj < 2; ++bj)
#pragma unroll
      for (int n = 0; n < 2; ++n) gv[bj][n] = *(const f32x4*)(gate + col0 + bj * HALF + n * 16);
#pragma unroll
    for (int ai = 0; ai < 2; ++ai)
#pragma unroll
      for (int m = 0; m < 4; ++m) {
        const unsigned ro = (unsigned)(wr * 64 + fr + ai * HALF + m * 16) * 1024u + col0;
#pragma unroll
        for (int bj = 0; bj < 2; ++bj)
#pragma unroll
          for (int n = 0; n < 2; ++n) {
            const unsigned o = ro + bj * HALF + n * 16;
            if (u.ks) *(f32x4*)(xo + o) = gv[bj][n] * acc[ai][bj][m][n];
            else *(f32x4*)(xo + o) = *(const f32x4*)(xin + o) + gv[bj][n] * acc[ai][bj][m][n];
          }
      }
  }
};

template <class Epi, class Sched>
DI void gemm_phase(PG8_LAS unsigned char* lds, const Gemm g, const Sched& S, const Epi& E) {
  const int tid = otid(), wid = __builtin_amdgcn_readfirstlane(tid >> 6), lane = tid & 63, wr = wid >> 2, wc = wid & 3, fr = lane & 15, fq = lane >> 4;
  const int K = g.K, nt = g.Kext / BK;
  const size_t ksb = (size_t)g.Kext * 2;
  unsigned voffA[2], voffB[2];
#pragma unroll
  for (int i = 0; i < 2; ++i) { int R, C; stage_rc(tid * 16 + i * 8192, R, C); const int Rb = Epi::PERM ? ((R & ~31) + perm32(R & 31)) : R;
    voffA[i] = (unsigned)(R * K + C) * 2u; voffB[i] = (unsigned)(Rb * K + C) * 2u; }
  const size_t kstep = (size_t)(BK * 2);
  const size_t hstep = (size_t)HALF * K * 2;
  const size_t tstep = 2 * hstep;
  const unsigned ldsw = (unsigned)wid * 1024u;
  const int aoff = lds_byte(wr * 64 + fr, fq * 8), boff = lds_byte(wc * 32 + fr, fq * 8);
#define PG8_SA(b, h) (((b) * 2 + (h)) * HTB)
#define PG8_SB(b, h) ((4 + (b) * 2 + (h)) * HTB)
#define PG8_STAGE(bufoff, gbase, voff) do { _Pragma("unroll") for (int _i = 0; _i < 2; ++_i) \
    __builtin_amdgcn_global_load_lds((const unsigned*)((const char*)(gbase) + (voff)[_i]), (PG8_LAS unsigned*)(lds + (bufoff) + ldsw + _i * 8192), 16, 0, 0); } while (0)
#define PG8_LDA(dst, b, h) do { _Pragma("unroll") for (int m = 0; m < 4; ++m) _Pragma("unroll") for (int k = 0; k < 2; ++k) dst[m][k] = *(const PG8_LAS bf16x8*)(lds + PG8_SA(b, h) + aoff + m * 2048 + k * 1024); } while (0)
#define PG8_LDB(dst, b, h) do { _Pragma("unroll") for (int n = 0; n < 2; ++n) _Pragma("unroll") for (int k = 0; k < 2; ++k) dst[n][k] = *(const PG8_LAS bf16x8*)(lds + PG8_SB(b, h) + boff + n * 2048 + k * 1024); } while (0)
#define PG8_MMA(ai, bj, At, Bt) do { __builtin_amdgcn_s_setprio(1); _Pragma("unroll") for (int m = 0; m < 4; ++m) _Pragma("unroll") for (int n = 0; n < 2; ++n) _Pragma("unroll") for (int k = 0; k < 2; ++k) \
    acc[ai][bj][m][n] = __builtin_amdgcn_mfma_f32_16x16x32_bf16(Bt[n][k], At[m][k], acc[ai][bj][m][n], 0, 0, 0); __builtin_amdgcn_s_setprio(0); } while (0)
#define PG8_WAIT_V(n) asm volatile("s_waitcnt vmcnt(" #n ")" ::: "memory")
#define PG8_WAIT_L(n) asm volatile("s_waitcnt lgkmcnt(" #n ")" ::: "memory")
#define PG8_BAR __builtin_amdgcn_s_barrier()
#define PG8_SCHED __builtin_amdgcn_sched_barrier(0)
  Unit cur, nxt; int ui = 0;
  if (!S.next(0, cur)) return;
  f32x4 acc[2][2][4][2];
#pragma unroll
  for (int a = 0; a < 2; ++a)
#pragma unroll
    for (int b = 0; b < 2; ++b)
#pragma unroll
      for (int m = 0; m < 4; ++m)
#pragma unroll
        for (int n = 0; n < 2; ++n) acc[a][b][m][n] = (f32x4){0.f, 0.f, 0.f, 0.f};
  bf16x8 At[4][2], B0[2][2], B1[2][2];
  const char* cA = (const char*)g.A + (size_t)cur.pm * tstep + cur.ks * ksb; const char* cB = (const char*)g.Bt + (size_t)cur.pn * tstep + cur.ks * ksb;
  S.a_ready(cur);
  PG8_STAGE(PG8_SB(0, 0), cB, voffB); PG8_STAGE(PG8_SA(0, 0), cA, voffA); PG8_STAGE(PG8_SB(0, 1), cB + hstep, voffB); PG8_STAGE(PG8_SA(0, 1), cA + hstep, voffA);
  if (wr == 1) PG8_BAR;
  PG8_WAIT_V(4); PG8_BAR;
  PG8_STAGE(PG8_SB(1, 0), cB + kstep, voffB); PG8_STAGE(PG8_SA(1, 0), cA + kstep, voffA); PG8_STAGE(PG8_SB(1, 1), cB + hstep + kstep, voffB);
  PG8_WAIT_V(6); PG8_BAR;
  for (;;) {
    const bool has_next = S.next(ui + 1, nxt);
    const char* nA = has_next ? (const char*)g.A + (size_t)nxt.pm * tstep + nxt.ks * ksb : cA; const char* nB = has_next ? (const char*)g.Bt + (size_t)nxt.pn * tstep + nxt.ks * ksb : cB;
    for (int t = 0; t < nt; t += 2) {
      const bool last = (t == nt - 2);
      const char* a1 = cA + (size_t)(t + 1) * kstep;
      const char* a2 = last ? nA : cA + (size_t)(t + 2) * kstep; const char* b2 = last ? nB : cB + (size_t)(t + 2) * kstep;
      const char* a3 = a2 + kstep; const char* b3 = b2 + kstep;
      if (last && has_next) S.a_ready(nxt);
      PG8_LDB(B0, 0, 0); PG8_SCHED; PG8_LDA(At, 0, 0); PG8_STAGE(PG8_SA(1, 1), a1 + hstep, voffA);
      PG8_WAIT_L(8); PG8_BAR; PG8_WAIT_L(0); PG8_MMA(0, 0, At, B0); PG8_BAR; PG8_SCHED;
      PG8_LDB(B1, 0, 1); PG8_STAGE(PG8_SB(0, 0), b2, voffB);
      PG8_BAR; PG8_WAIT_L(0); PG8_MMA(0, 1, At, B1); PG8_BAR;
      PG8_LDA(At, 0, 1); PG8_STAGE(PG8_SA(0, 0), a2, voffA);
      PG8_BAR; PG8_WAIT_L(0); PG8_MMA(1, 0, At, B0); PG8_BAR; PG8_SCHED;
      PG8_STAGE(PG8_SB(0, 1), b2 + hstep, voffB);
      PG8_WAIT_V(6); PG8_BAR; PG8_MMA(1, 1, At, B1); PG8_BAR;
      PG8_LDB(B0, 1, 0); PG8_SCHED; PG8_LDA(At, 1, 0); PG8_STAGE(PG8_SA(0, 1), a2 + hstep, voffA);
      PG8_WAIT_L(8); PG8_BAR; PG8_WAIT_L(0); PG8_MMA(0, 0, At, B0); PG8_BAR; PG8_SCHED;
      PG8_LDB(B1, 1, 1); PG8_STAGE(PG8_SB(1, 0), b3, voffB);
      PG8_BAR; PG8_WAIT_L(0); PG8_MMA(0, 1, At, B1); PG8_BAR;
      PG8_LDA(At, 1, 1); PG8_STAGE(PG8_SA(1, 0), a3, voffA);
      PG8_BAR; PG8_WAIT_L(0); PG8_MMA(1, 0, At, B0); PG8_BAR; PG8_SCHED;
      PG8_STAGE(PG8_SB(1, 1), b3 + hstep, voffB);
      PG8_WAIT_V(6); PG8_BAR; PG8_MMA(1, 1, At, B1); PG8_BAR;
    }
    E(acc, cur, wr, wc, fr, fq); S.done(cur);
    if (!has_next) break;
#pragma unroll
    for (int a = 0; a < 2; ++a)
#pragma unroll
      for (int b = 0; b < 2; ++b)
#pragma unroll
        for (int m = 0; m < 4; ++m)
#pragma unroll
          for (int n = 0; n < 2; ++n) acc[a][b][m][n] = (f32x4){0.f, 0.f, 0.f, 0.f};
    cur = nxt; cA = nA; cB = nB; ++ui;
  }
  PG8_WAIT_V(0);
  if (wr == 0) PG8_BAR;
  PG8_BAR;
#undef PG8_SA
#undef PG8_SB
#undef PG8_STAGE
#undef PG8_LDA
#undef PG8_LDB
#undef PG8_MMA
#undef PG8_WAIT_V
#undef PG8_WAIT_L
#undef PG8_BAR
#undef PG8_SCHED
}
}

DI void gemm_store_phase(const bf16_t* A, const bf16_t* Bt, int M, int N, int K, bf16_t* C, int ldc, unsigned char* shm) {
  pg8::Gemm g; g.A = A; g.Bt = Bt; g.M = M; g.N = N; g.K = K; g.Kext = K;
  pg8::StaticOrder S; S.init(M, N, (int)gridDim.x, obid());
  pg8::EpiStore E; E.O = C; E.ldc = ldc; E.O1 = C;
  pg8::gemm_phase(( __attribute__((address_space(3))) unsigned char*)shm, g, S, E);
}
DI void gemm_store_sk_phase(const bf16_t* A, const bf16_t* Bt, int M, int N, int K, bf16_t* C, bf16_t* C1, int ldc, unsigned char* shm) {
  pg8::Gemm g; g.A = A; g.Bt = Bt; g.M = M; g.N = N; g.K = K; g.Kext = K / 2;
  pg8::SplitK2Order S; S.init(M, N, (int)gridDim.x, obid());
  pg8::EpiStore E; E.O = C; E.ldc = ldc; E.O1 = C1;
  pg8::gemm_phase(( __attribute__((address_space(3))) unsigned char*)shm, g, S, E);
}
DI void gemm_resid_phase(CPR p, const bf16_t* A, int K, const bf16_t* Bt, int l, int gate_off, bool first, bool splitk, unsigned char* shm, bool dummy = false) {
  pg8::Gemm g; g.A = A; g.Bt = Bt; g.M = 8192; g.N = 1024; g.K = K; g.Kext = splitk ? K / 2 : K;
  pg8::EpiResid E; E.xp = p.in[I_XP]; E.xs = p.in[I_XS]; E.out = p.out; E.mods_l = (const float*)(p.ws + OFF_MODS) + (size_t)l * 3 * 6144; E.gate_off = gate_off; E.first = first ? 1 : 0;
  E.p1 = (float*)(p.ws + OFF_BIG);
  if (dummy) { E.out = (float*)(p.ws + OFF_BIG) + 8388608; E.p1 = E.out; E.first = 0; }
  if (splitk) {
    pg8::SplitK2Order S; S.init(8192, 1024, (int)gridDim.x, obid());
    pg8::gemm_phase(( __attribute__((address_space(3))) unsigned char*)shm, g, S, E);
  } else {
    pg8::StaticOrder S; S.init(8192, 1024, (int)gridDim.x, obid());
    pg8::gemm_phase(( __attribute__((address_space(3))) unsigned char*)shm, g, S, E);
  }
}

DI void mods_item(CPR p, int it, char* smem) {
  const int tid = vtid();
  const int l = it / 96, n0 = (it % 96) * 64;
  float* sc = (float*)smem;
  float* red = sc + 3072;
  for (int i = tid; i < 3072; i += 256) {
    int rr = i >> 10, k = i & 1023;
    float cv = (rr == 0) ? p.in[I_CCTX][k] : p.in[I_C][(rr - 1) * 1024 + k];
    sc[i] = siluf(cv);
  }
  __syncthreads();
  const int cq = tid & 15, ks = tid >> 4;
  float a0[4] = {0, 0, 0, 0}, a1[4] = {0, 0, 0, 0}, a2[4] = {0, 0, 0, 0};
  const float* w = p.in[I_ADAW] + ((size_t)l * 1024 + ks * 64) * 6144 + n0 + cq * 4;
#pragma unroll 8
  for (int kk = 0; kk < 64; ++kk) {
    const pg8::f32x4 t4 = __builtin_nontemporal_load((const pg8::f32x4*)(w + (size_t)kk * 6144)); float4 w4 = make_float4(t4[0], t4[1], t4[2], t4[3]);
    int k = ks * 64 + kk;
    float s0 = sc[k], s1 = sc[1024 + k], s2 = sc[2048 + k];
    a0[0] += s0 * w4.x; a0[1] += s0 * w4.y; a0[2] += s0 * w4.z; a0[3] += s0 * w4.w;
    a1[0] += s1 * w4.x; a1[1] += s1 * w4.y; a1[2] += s1 * w4.z; a1[3] += s1 * w4.w;
    a2[0] += s2 * w4.x; a2[1] += s2 * w4.y; a2[2] += s2 * w4.z; a2[3] += s2 * w4.w;
  }
#pragma unroll
  for (int j = 0; j < 4; ++j) {
    red[(ks * 3 + 0) * 64 + cq * 4 + j] = a0[j];
    red[(ks * 3 + 1) * 64 + cq * 4 + j] = a1[j];
    red[(ks * 3 + 2) * 64 + cq * 4 + j] = a2[j];
  }
  __syncthreads();
  if (tid < 192) {
    int rr = tid >> 6, n = tid & 63;
    float s = 0.f;
#pragma unroll
    for (int k2 = 0; k2 < 16; ++k2) s += red[(k2 * 3 + rr) * 64 + n];
    float* mods = (float*)(p.ws + OFF_MODS);
    mods[(size_t)(l * 3 + rr) * 6144 + n0 + n] = s + p.in[I_ADAB][l * 6144 + n0 + n];
  }
  __syncthreads();
}

DI void conv_tile(CPR p, int t, char* smem) {
  const float* src = nullptr; size_t dsto = 0; int K = 0, N = 0, tt = -1;
  int rem = t;
#define JOB(SRC, DST, KK, NN) { int nt_ = ((KK) / 64) * (((NN) + 63) / 64); if (rem >= 0 && rem < nt_) { src = (SRC); dsto = (DST); K = (KK); N = (NN); tt = rem; } rem -= nt_; }
  JOB(p.in[I_NAQKV], W_NA_QKV, 1024, 3072)
  JOB(p.in[I_NAO], W_NA_O, 1024, 1024)
  JOB(p.in[I_GQKVG], W_GLA_QKVG, 1024, 3072)
  JOB(p.in[I_GG1], W_GLA_QKVG + 3072ull * 1024, 1024, 16)
  JOB(p.in[I_GG1] + 1024 * 16, W_GLA_QKVG + 3088ull * 1024, 1024, 16)
  JOB(p.in[I_GO], W_GLA_O, 1024, 1024)
  JOB(p.in[I_DQKV], W_DIFF_QKV, 1024, 3072)
  JOB(p.in[I_DO], W_DIFF_O, 1024, 1024)
  JOB(p.in[I_MDQ], W_MLA_DQKV, 1024, 384)
  JOB(p.in[I_MDKV], W_MLA_DQKV + 384ull * 1024, 1024, 288)
  JOB(p.in[I_MUQ], W_MLA_UQ, 384, 1536)
  JOB(p.in[I_MUKV], W_MLA_UKV, 256, 2048)
  JOB(p.in[I_MO], W_MLA_O, 1024, 1024)
  JOB(p.in[I_WUP] + 0ull * 1024 * 5632, W_UP + 0ull * 5632 * 1024, 1024, 5632)
  JOB(p.in[I_WUP] + 1ull * 1024 * 5632, W_UP + 1ull * 5632 * 1024, 1024, 5632)
  JOB(p.in[I_WUP] + 2ull * 1024 * 5632, W_UP + 2ull * 5632 * 1024, 1024, 5632)
  JOB(p.in[I_WUP] + 3ull * 1024 * 5632, W_UP + 3ull * 5632 * 1024, 1024, 5632)
  JOB(p.in[I_WDOWN] + 0ull * 2816 * 1024, W_DOWN + 0ull * 2816 * 1024, 2816, 1024)
  JOB(p.in[I_WDOWN] + 1ull * 2816 * 1024, W_DOWN + 1ull * 2816 * 1024, 2816, 1024)
  JOB(p.in[I_WDOWN] + 2ull * 2816 * 1024, W_DOWN + 2ull * 2816 * 1024, 2816, 1024)
  JOB(p.in[I_WDOWN] + 3ull * 2816 * 1024, W_DOWN + 3ull * 2816 * 1024, 2816, 1024)
#undef JOB
  if (tt < 0) return;
  const int tid = vtid();
  const int nnt = (N + 63) / 64;
  const int k0 = (tt / nnt) * 64, n0 = (tt % nnt) * 64;
  float* tl = (float*)smem;
#pragma unroll
  for (int i = 0; i < 4; ++i) {
    int id = tid + 256 * i, kr = id >> 4, c4 = id & 15;
    int n = n0 + c4 * 4;
    float4 v = make_float4(0.f, 0.f, 0.f, 0.f);
    if (n < N) { const pg8::f32x4 t4 = __builtin_nontemporal_load((const pg8::f32x4*)(src + (size_t)(k0 + kr) * N + n)); v = make_float4(t4[0], t4[1], t4[2], t4[3]); }
    tl[kr * 65 + c4 * 4 + 0] = v.x; tl[kr * 65 + c4 * 4 + 1] = v.y; tl[kr * 65 + c4 * 4 + 2] = v.z; tl[kr * 65 + c4 * 4 + 3] = v.w;
  }
  __syncthreads();
  bf16_t* dst = (bf16_t*)p.ws + dsto;
  const int n = tid & 63, kg = tid >> 6;
  if (n0 + n < N) {
#pragma unroll
    for (int g2 = 0; g2 < 2; ++g2) {
      int g = kg + 4 * g2;
      uint4 q;
      q.x = pack2(tl[(g * 8 + 0) * 65 + n], tl[(g * 8 + 1) * 65 + n]);
      q.y = pack2(tl[(g * 8 + 2) * 65 + n], tl[(g * 8 + 3) * 65 + n]);
      q.z = pack2(tl[(g * 8 + 4) * 65 + n], tl[(g * 8 + 5) * 65 + n]);
      q.w = pack2(tl[(g * 8 + 6) * 65 + n], tl[(g * 8 + 7) * 65 + n]);
      *(uint4*)(dst + (size_t)(n0 + n) * K + k0 + g * 8) = q;
    }
  }
  __syncthreads();
}
constexpr int CONV_TILES = 768 + 256 + 768 + 16 + 16 + 256 + 768 + 256 + 96 + 80 + 144 + 128 + 256 + 4 * 1408 + 4 * 704;

DI void phase0(CPR p, char* smem0) {
  char* smem = smem0 + (otid() >> 8) * 65536;
  for (int it = vbid(); it < 384 + 1024; it += nvb()) {
    if (it < 384) mods_item(p, it, smem);
    else conv_tile(p, it - 384, smem);
  }
}
DI void conv_ahead(CPR p, int l, char* smem0, int wg, int nwg) {
  char* smem = smem0 + (otid() >> 8) * 65536;
  const int vb = wg * 2 + (otid() >> 8), nv = nwg * 2;
  const int m0 = l == 0 ? 1024 : l == 1 ? 2080 : 3104, m1 = l == 0 ? 2080 : l == 1 ? 3104 : l == 2 ? 3808 : 3104;
  const int nm = m1 - m0;
  const int nmods = 0;
  const int total = nmods + 1408 + 704 + nm;
  for (int t0 = vb; t0 < total; t0 += nv) {
    if (t0 < nmods) { mods_item(p, 96 + t0, smem); continue; }
    const int t = t0 - nmods;
    int tile = t < 1408 ? 3808 + 1408 * l + t : (t < 2112 ? 9440 + 704 * l + (t - 1408) : m0 + (t - 2112));
    conv_tile(p, tile, smem);
  }
}

DI void norm_phase(CPR p, int l, int which, bool from_input, bool addp1) {
  const int lane = otid() & 63, wave = otid() >> 6;
  const float* g = p.in[which ? I_NFFN : I_NMIX] + l * 1024;
  const float* mods = (const float*)(p.ws + OFF_MODS);
  bf16_t* h = (bf16_t*)(p.ws + OFF_H);
  const int rpw = 8192 / ((int)gridDim.x * 8);
  const int row_begin = (rpw * (int)gridDim.x * 8 == 8192) ? (obid() * 8 + wave) * rpw : obid() * 8 + wave;
  const int row_end = (rpw * (int)gridDim.x * 8 == 8192) ? row_begin + rpw : 8192;
  const int row_step = (rpw * (int)gridDim.x * 8 == 8192) ? 1 : (int)gridDim.x * 8;
  for (int row = row_begin; row < row_end; row += row_step) {
    const float* x = from_input ? (row < 4096 ? p.in[I_XP] + (size_t)row * 1024 : p.in[I_XS] + (size_t)(row - 4096) * 1024) : p.out + (size_t)row * 1024;
    int mr = row < 4096 ? 0 : (row < 6144 ? 1 : 2);
    const float* md = mods + (size_t)(l * 3 + mr) * 6144 + which * 3072;
    float4 v[4];
    float ss = 0.f;
#pragma unroll
    for (int j = 0; j < 4; ++j) {
      v[j] = *(const float4*)(x + j * 256 + lane * 4);
      if (addp1) {
        const pg8::f32x4 q4 = __builtin_nontemporal_load((const pg8::f32x4*)((const float*)(p.ws + OFF_BIG) + (size_t)row * 1024 + j * 256 + lane * 4)); const float4 q = make_float4(q4[0], q4[1], q4[2], q4[3]);
        v[j].x += q.x; v[j].y += q.y; v[j].z += q.z; v[j].w += q.w;
        *(float4*)(p.out + (size_t)row * 1024 + j * 256 + lane * 4) = v[j];
      }
      ss += v[j].x * v[j].x + v[j].y * v[j].y + v[j].z * v[j].z + v[j].w * v[j].w;
    }
#pragma unroll
    for (int o = 32; o >= 1; o >>= 1) ss += __shfl_xor(ss, o);
    float rs = rsqrtf(ss * (1.f / 1024.f) + 1e-6f);
#pragma unroll
    for (int j = 0; j < 4; ++j) {
      int col = j * 256 + lane * 4;
      float4 gg = *(const float4*)(g + col), sh = *(const float4*)(md + col), scl = *(const float4*)(md + 1024 + col);
      float y0 = v[j].x * rs * gg.x * (1.f + scl.x) + sh.x;
      float y1 = v[j].y * rs * gg.y * (1.f + scl.y) + sh.y;
      float y2 = v[j].z * rs * gg.z * (1.f + scl.z) + sh.z;
      float y3 = v[j].w * rs * gg.w * (1.f + scl.w) + sh.w;
      uint2 q; q.x = pack2(y0, y1); q.y = pack2(y2, y3);
      *(uint2*)(h + (size_t)row * 1024 + col) = q;
    }
  }
}

DI void final_add_phase(CPR p) {
  const float* p1 = (const float*)(p.ws + OFF_BIG);
  for (int idx = gtid(); idx < 8192 * 256; idx += gthreads()) {
    const pg8::f32x4 b4 = __builtin_nontemporal_load((const pg8::f32x4*)(p1 + (size_t)idx * 4));
    float4 a = *(const float4*)(p.out + (size_t)idx * 4), b = make_float4(b4[0], b4[1], b4[2], b4[3]);
    a.x += b.x; a.y += b.y; a.z += b.z; a.w += b.w;
    *(float4*)(p.out + (size_t)idx * 4) = a;
  }
}

DI void convgate_phase(CPR p, int l) {
  const bf16_t* u = (const bf16_t*)(p.ws + OFF_BIG);
  bf16_t* a = (bf16_t*)(p.ws + OFF_MIX);
  const float* cw = p.in[I_CONVW] + (size_t)l * 3 * 5632;
  const float* cb = p.in[I_CONVB] + (size_t)l * 5632;
  for (int idx = gtid(); idx < 1024 * 352; idx += gthreads()) {
    int rg = idx / 352, f = (idx % 352) * 8;
    int row0 = rg * 8;
    int T = row0 < 4096 ? 256 : 2048;
    int t0 = row0 < 4096 ? (row0 & 255) : ((row0 - 4096) & 2047);
    float w0g[8], w1g[8], w2g[8], bg[8], w0v[8], w1v[8], w2v[8], bv[8];
#pragma unroll
    for (int e2 = 0; e2 < 8; ++e2) {
      w0g[e2] = cw[f + e2]; w1g[e2] = cw[5632 + f + e2]; w2g[e2] = cw[2 * 5632 + f + e2]; bg[e2] = cb[f + e2];
      w0v[e2] = cw[2816 + f + e2]; w1v[e2] = cw[5632 + 2816 + f + e2]; w2v[e2] = cw[2 * 5632 + 2816 + f + e2]; bv[e2] = cb[2816 + f + e2];
    }
    const bf16_t* ur = u + (size_t)row0 * 5632 + f;
    float gp[8], vp[8], gc[8], vc[8], gn[8], vn[8];
    if (t0 > 0) { load_bf16_row<8>(ur - 5632, gp); load_bf16_row<8>(ur - 5632 + 2816, vp); }
    else {
#pragma unroll
      for (int e2 = 0; e2 < 8; ++e2) { gp[e2] = 0.f; vp[e2] = 0.f; }
    }
    load_bf16_row<8>(ur, gc); load_bf16_row<8>(ur + 2816, vc);
#pragma unroll
    for (int j = 0; j < 8; ++j) {
      if (t0 + j < T - 1) { load_bf16_row<8>(ur + (size_t)(j + 1) * 5632, gn); load_bf16_row<8>(ur + (size_t)(j + 1) * 5632 + 2816, vn); }
      else {
#pragma unroll
        for (int e2 = 0; e2 < 8; ++e2) { gn[e2] = 0.f; vn[e2] = 0.f; }
      }
      float res[8];
#pragma unroll
      for (int e2 = 0; e2 < 8; ++e2) {
        float gg = gp[e2] * w0g[e2] + gc[e2] * w1g[e2] + gn[e2] * w2g[e2] + bg[e2];
        float vv = vp[e2] * w0v[e2] + vc[e2] * w1v[e2] + vn[e2] * w2v[e2] + bv[e2];
        res[e2] = siluf(gg) * vv;
      }
      store_bf16_row<8>(a + (size_t)(row0 + j) * 2816 + f, res);
#pragma unroll
      for (int e2 = 0; e2 < 8; ++e2) { gp[e2] = gc[e2]; vp[e2] = vc[e2]; gc[e2] = gn[e2]; vc[e2] = vn[e2]; }
    }
  }
}

template <int DQK, int DV, class TileF, class ScoreF>
DI void flash_wave(const bf16_t* q0, int ntiles, float scale, TileF tilef, ScoreF scoref, f32x16 (&O)[DV / 32], float& m_run, float& l_run, int r, int hh) {
  constexpr int NK = DQK / 16, NV = DV / 32;
  bf16x8 qf[NK];
#pragma unroll
  for (int kk = 0; kk < NK; ++kk) qf[kk] = *(const bf16x8*)(q0 + (size_t)r * DQK + kk * 16 + hh * 8);
#pragma unroll
  for (int t = 0; t < NV; ++t)
#pragma unroll
    for (int i = 0; i < 16; ++i) O[t][i] = 0.f;
  m_run = 0.f;
  l_run = 0.f;
  constexpr bool PREFV = (DV <= 64);
  bf16x8 kc[NK], vc[2][NV];
  auto loadk = [&](int it, bf16x8 (&k)[NK]) {
    const bf16_t* kp; const bf16_t* vp; int vs;
    tilef(it, kp, vp, vs);
    const unsigned ko = (unsigned)r * DQK + hh * 8;
#pragma unroll
    for (int kk = 0; kk < NK; ++kk) k[kk] = *(const bf16x8*)(kp + (ko + kk * 16));
  };
  auto loadv = [&](int it, bf16x8 (&v)[2][NV]) {
    const bf16_t* kp; const bf16_t* vp; int vs;
    tilef(it, kp, vp, vs);
#pragma unroll
    for (int s2 = 0; s2 < 2; ++s2)
#pragma unroll
      for (int t = 0; t < NV; ++t) v[s2][t] = *(const bf16x8*)(vp + ((unsigned)r * (unsigned)vs + 8u * hh + (unsigned)(t * 32) * (unsigned)vs + 16u * s2));
  };
  loadk(0, kc);
  if (PREFV) loadv(0, vc);
  for (int it = 0; it < ntiles; ++it) {
    bf16x8 kn[NK], vn[2][NV];
    const int nx = min(it + 1, ntiles - 1);
    loadk(nx, kn);
    if (PREFV) loadv(nx, vn); else loadv(it, vc);
    f32x16 s;
#pragma unroll
    for (int i = 0; i < 16; ++i) s[i] = -m_run;
#pragma unroll
    for (int kk = 0; kk < NK; ++kk) s = MFMA32(kc[kk], qf[kk], s);
    float mx = -1e30f;
#pragma unroll
    for (int i = 0; i < 16; ++i) { float v = scoref(it, i, s[i]); s[i] = v; mx = fmaxf(mx, v); }
    if (__any(mx > 8.f)) {
      mx = fmaxf(mx, __shfl_xor(mx, 32));
      const float delta = fmaxf(mx, 0.f);
      const float alpha = __builtin_amdgcn_exp2f(-delta);
      m_run += delta;
      l_run *= alpha;
#pragma unroll
      for (int i = 0; i < 16; ++i) s[i] -= delta;
#pragma unroll
      for (int t = 0; t < NV; ++t)
#pragma unroll
        for (int i = 0; i < 16; ++i) O[t][i] *= alpha;
    }
    float sum = 0.f;
#pragma unroll
    for (int i = 0; i < 16; ++i) { float pv = __builtin_amdgcn_exp2f(s[i]); s[i] = pv; sum += pv; }
    l_run += sum;
#pragma unroll
    for (int s2 = 0; s2 < 2; ++s2) {
      union { uint4 q; bf16x8 v; } pb;
      pb.q.x = pack2(s[8 * s2 + 0], s[8 * s2 + 1]); pb.q.y = pack2(s[8 * s2 + 2], s[8 * s2 + 3]);
      pb.q.z = pack2(s[8 * s2 + 4], s[8 * s2 + 5]); pb.q.w = pack2(s[8 * s2 + 6], s[8 * s2 + 7]);
#pragma unroll
      for (int t = 0; t < NV; ++t) O[t] = MFMA32(vc[s2][t], pb.v, O[t]);
    }
#pragma unroll
    for (int kk = 0; kk < NK; ++kk) kc[kk] = kn[kk];
    if (PREFV) {
#pragma unroll
      for (int s2 = 0; s2 < 2; ++s2)
#pragma unroll
        for (int t = 0; t < NV; ++t) vc[s2][t] = vn[s2][t];
    }
  }
  l_run += __shfl_xor(l_run, 32);
}
template <int DQK, int DV, int NKS, bool PIPE>
DI void flash_block(const bf16_t* q0, int ntiles, float scale, const bf16_t* kb0, const bf16_t* kb1, const bf16_t* vb, int vs, char* lds, int ks,
                    f32x16 (&O)[DV / 32], float& m_run, float& l_run, int tid, int r, int hh) {
  constexpr int NK = DQK / 16, NV = DV / 32;
  constexpr int KROW = DQK * 2 + 16, VROW = 80;
  constexpr int KBYTES = NKS * 32 * KROW, STAGE = KBYTES + DV * VROW;
  constexpr int KCH = 32 * (DQK / 8), NKC = NKS * KCH, TOT = NKC + DV * 4, NJ = (TOT + 255) / 256;
  bf16x8 qf[NK];
#pragma unroll
  for (int kk = 0; kk < NK; ++kk) qf[kk] = *(const bf16x8*)(q0 + (size_t)r * DQK + kk * 16 + hh * 8);
#pragma unroll
  for (int t = 0; t < NV; ++t)
#pragma unroll
    for (int i = 0; i < 16; ++i) O[t][i] = 0.f;
  m_run = 0.f;
  l_run = 0.f;
  static_assert(NJ >= 3 && NJ <= 4, "loader written for 3 or 4 chunks per thread");
  const bf16_t *gp0, *gp1, *gp2, *gp3; int gi0, gi1, gi2, gi3, lo0, lo1, lo2, lo3;
  auto setup = [&](int j, const bf16_t*& gp, int& ginc, int& loff) __attribute__((always_inline)) {
    int c = tid + 256 * j;
    if (c >= TOT) c -= 256;
    if (c < NKC) {
      int s = c / KCH, rem = c % KCH, row = rem / (DQK / 8), c8 = rem % (DQK / 8);
      gp = (s == 0 ? kb0 : kb1) + (size_t)row * DQK + c8 * 8;
      ginc = 32 * DQK;
      loff = s * 32 * KROW + row * KROW + c8 * 16;
    } else {
      int c2 = c - NKC;
      int dv = c2 >> 2, q = c2 & 3;
      gp = vb + c2 * 8;
      ginc = DV * 32;
      loff = KBYTES + dv * VROW + q * 16;
    }
  };
  setup(0, gp0, gi0, lo0); setup(1, gp1, gi1, lo1); setup(2, gp2, gi2, lo2); setup(NJ > 3 ? 3 : 2, gp3, gi3, lo3);
  uint4 sa0, sa1, sa2, sa3, sb0, sb1, sb2, sb3;
#define gload(S, IT) do { S##0 = *(const uint4*)(gp0 + (size_t)(IT) * gi0); S##1 = *(const uint4*)(gp1 + (size_t)(IT) * gi1); S##2 = *(const uint4*)(gp2 + (size_t)(IT) * gi2); \
    if (NJ > 3) S##3 = *(const uint4*)(gp3 + (size_t)(IT) * gi3); } while (0)
#define swrite(S, SI) do { char* sd_ = lds + (SI) * STAGE; *(uint4*)(sd_ + lo0) = S##0; *(uint4*)(sd_ + lo1) = S##1; *(uint4*)(sd_ + lo2) = S##2; if (NJ > 3) *(uint4*)(sd_ + lo3) = S##3; } while (0)
  const int koff = ks * 32 * KROW + r * KROW + hh * 16;
  const int voff = KBYTES + r * VROW + hh * 16;
  int stg = 0;
  if constexpr (PIPE) {
    gload(sa, 0);
    gload(sb, min(1, ntiles - 1));
    __syncthreads();
    swrite(sa, 0);
    swrite(sb, 1);
    gload(sb, min(2, ntiles - 1));
    __syncthreads();
    f32x16 sn;
#pragma unroll
    for (int i = 0; i < 16; ++i) sn[i] = 0.f;
#pragma unroll
    for (int kk = 0; kk < NK; ++kk) { bf16x8 kf = *(const bf16x8*)(lds + koff + kk * 32); sn = MFMA32(kf, qf[kk], sn); }
#define FB_BODY_P(IT, SLOAD, SWRITE) do { \
      gload(SLOAD, min((IT) + 3, ntiles - 1)); \
      const char* sb = lds + stg * STAGE; \
      const int stg1 = (stg == 2) ? 0 : stg + 1; \
      const char* sbnx = lds + stg1 * STAGE; \
      f32x16 s = sn; \
      _Pragma("unroll") for (int i = 0; i < 16; ++i) sn[i] = -m_run; \
      _Pragma("unroll") for (int kk = 0; kk < NK; ++kk) { bf16x8 kf = *(const bf16x8*)(sbnx + koff + kk * 32); sn = MFMA32(kf, qf[kk], sn); } \
      float mx = -1e30f; \
      _Pragma("unroll") for (int i = 0; i < 16; ++i) mx = fmaxf(mx, s[i]); \
      if (__any(mx > 8.f)) { \
        mx = fmaxf(mx, __shfl_xor(mx, 32)); \
        const float delta = fmaxf(mx, 0.f); \
        const float alpha = __builtin_amdgcn_exp2f(-delta); \
        m_run += delta; \
        l_run *= alpha; \
        _Pragma("unroll") for (int i = 0; i < 16; ++i) { s[i] -= delta; sn[i] -= delta; } \
        _Pragma("unroll") for (int t = 0; t < NV; ++t) _Pragma("unroll") for (int i = 0; i < 16; ++i) O[t][i] *= alpha; \
      } \
      float sum = 0.f; \
      _Pragma("unroll") for (int i = 0; i < 16; ++i) { float pv = __builtin_amdgcn_exp2f(s[i]); s[i] = pv; sum += pv; } \
      l_run += sum; \
      _Pragma("unroll") for (int s2 = 0; s2 < 2; ++s2) { \
        union { uint4 q; bf16x8 v; } pb; \
        pb.q.x = pack2(s[8 * s2 + 0], s[8 * s2 + 1]); pb.q.y = pack2(s[8 * s2 + 2], s[8 * s2 + 3]); \
        pb.q.z = pack2(s[8 * s2 + 4], s[8 * s2 + 5]); pb.q.w = pack2(s[8 * s2 + 6], s[8 * s2 + 7]); \
        _Pragma("unroll") for (int t = 0; t < NV; ++t) { bf16x8 vf = *(const bf16x8*)(sb + voff + t * 32 * VROW + s2 * 32); O[t] = MFMA32(vf, pb.v, O[t]); } \
      } \
      swrite(SWRITE, (stg1 == 2) ? 0 : stg1 + 1); \
      stg = stg1; \
      __syncthreads(); \
    } while (0)
    for (int it = 0; it < ntiles; it += 2) {
      FB_BODY_P(it, sa, sb);
      FB_BODY_P(it + 1, sb, sa);
    }
#undef FB_BODY_P
    l_run += __shfl_xor(l_run, 32);
    return;
  }
  gload(sa, 0);
  gload(sb, 1);
  __syncthreads();
  swrite(sa, 0);
  __syncthreads();
#define FB_BODY(IT, SLOAD, SWRITE) do { \
    gload(SLOAD, min((IT) + 2, ntiles - 1)); \
    const char* sb = lds + stg * STAGE; \
    f32x16 s; \
    _Pragma("unroll") for (int i = 0; i < 16; ++i) s[i] = -m_run; \
    _Pragma("unroll") for (int kk = 0; kk < NK; ++kk) { bf16x8 kf = *(const bf16x8*)(sb + koff + kk * 32); s = MFMA32(kf, qf[kk], s); } \
    float mx = -1e30f; \
    _Pragma("unroll") for (int i = 0; i < 16; ++i) mx = fmaxf(mx, s[i]); \
    if (__any(mx > 8.f)) { \
      mx = fmaxf(mx, __shfl_xor(mx, 32)); \
      const float delta = fmaxf(mx, 0.f); \
      const float alpha = __builtin_amdgcn_exp2f(-delta); \
      m_run += delta; \
      l_run *= alpha; \
      _Pragma("unroll") for (int i = 0; i < 16; ++i) s[i] -= delta; \
      _Pragma("unroll") for (int t = 0; t < NV; ++t) _Pragma("unroll") for (int i = 0; i < 16; ++i) O[t][i] *= alpha; \
    } \
    float sum = 0.f; \
    _Pragma("unroll") for (int i = 0; i < 16; ++i) { float pv = __builtin_amdgcn_exp2f(s[i]); s[i] = pv; sum += pv; } \
    l_run += sum; \
    _Pragma("unroll") for (int s2 = 0; s2 < 2; ++s2) { \
      union { uint4 q; bf16x8 v; } pb; \
      pb.q.x = pack2(s[8 * s2 + 0], s[8 * s2 + 1]); pb.q.y = pack2(s[8 * s2 + 2], s[8 * s2 + 3]); \
      pb.q.z = pack2(s[8 * s2 + 4], s[8 * s2 + 5]); pb.q.w = pack2(s[8 * s2 + 6], s[8 * s2 + 7]); \
      _Pragma("unroll") for (int t = 0; t < NV; ++t) { bf16x8 vf = *(const bf16x8*)(sb + voff + t * 32 * VROW + s2 * 32); O[t] = MFMA32(vf, pb.v, O[t]); } \
    } \
    stg = (stg == 2) ? 0 : stg + 1; \
    swrite(SWRITE, stg); \
    __syncthreads(); \
  } while (0)
  for (int it = 0; it < ntiles; it += 2) {
    FB_BODY(it, sa, sb);
    FB_BODY(it + 1, sb, sa);
  }
#undef FB_BODY
  l_run += __shfl_xor(l_run, 32);
}
#undef gload
#undef swrite
template <int NT> DI void store_o(bf16_t* o, int ldo, f32x16 (&O)[NT], float linv, int r, int hh) {
#pragma unroll
  for (int t = 0; t < NT; ++t)
#pragma unroll
    for (int ig = 0; ig < 4; ++ig) {
      uint2 q;
      q.x = pack2(O[t][ig * 4 + 0] * linv, O[t][ig * 4 + 1] * linv);
      q.y = pack2(O[t][ig * 4 + 2] * linv, O[t][ig * 4 + 3] * linv);
      *(uint2*)(o + (size_t)r * ldo + t * 32 + 8 * ig + 4 * hh) = q;
    }
}

template <bool ROPE> DI void headnorm8(float (&v)[8], const float* g, int sub, float extra, int t) {
  float ss = 0.f;
#pragma unroll
  for (int e = 0; e < 8; ++e) ss += v[e] * v[e];
  ss += __shfl_xor(ss, 1); ss += __shfl_xor(ss, 2); ss += __shfl_xor(ss, 4);
  const float rs = rsqrtf(ss * (1.f / 64.f) + 1e-6f) * extra;
  const float4 g0 = *(const float4*)(g + sub * 8), g1 = *(const float4*)(g + sub * 8 + 4);
  v[0] *= rs * g0.x; v[1] *= rs * g0.y; v[2] *= rs * g0.z; v[3] *= rs * g0.w;
  v[4] *= rs * g1.x; v[5] *= rs * g1.y; v[6] *= rs * g1.z; v[7] *= rs * g1.w;
  if (ROPE) {
    const float pos = (sub & 4) ? (float)(t & 63) : (float)(t >> 6);
    const bool second = (sub >> 1) & 1;
#pragma unroll
    for (int e = 0; e < 8; ++e) {
      const float other = __shfl_xor(v[e], 2);
      const int f = (sub & 1) * 8 + e;
      const float ang = pos * exp2f(-(float)f * (13.287712379549449f / 16.f));
      const float c = __cosf(ang), s = __sinf(ang);
      v[e] = second ? (other * s + v[e] * c) : (v[e] * c - other * s);
    }
  }
}

constexpr size_t L0_QB = 0, L0_KB = 16 * MB, L0_VT = 32 * MB, L0_KC = 48 * MB, L0_VCT = 49 * MB;
DI void prep0_phase(CPR p) {
  const bf16_t* big = (const bf16_t*)(p.ws + OFF_BIG);
  char* mix = p.ws + OFF_MIX;
  bf16_t* qb = (bf16_t*)(mix + L0_QB); bf16_t* kb = (bf16_t*)(mix + L0_KB); bf16_t* vT = (bf16_t*)(mix + L0_VT);
  bf16_t* kc = (bf16_t*)(mix + L0_KC); bf16_t* vcT = (bf16_t*)(mix + L0_VCT);
  for (int idx = gtid(); idx < 2 * 8192 * 16 * 8; idx += gthreads()) {
    int sub = idx & 7, hd = (idx >> 3) & 15, row = (idx >> 7) & 8191, which = idx >> 20;
    float v[8];
    load_bf16_row<8>(big + (size_t)row * 3072 + which * 1024 + hd * 64 + sub * 8, v);
    headnorm8<false>(v, p.in[which ? I_NAKN : I_NAQN], sub, which ? 1.f : 0.125f * 1.4426950408889634f, 0);
    store_bf16_row<8>((which ? kb : qb) + ((size_t)hd * 8192 + row) * 64 + sub * 8, v);
    if (which && row < 4096) store_f32_row<8>(p.out + O_L0K + (((size_t)(row >> 8) * 16 + hd) * 256 + (row & 255)) * 64 + sub * 8, v);
  }
  for (int idx = gtid(); idx < 4096 * 128; idx += gthreads()) {
    int row = idx >> 7, c = (idx & 127) * 8;
    float v[8];
    load_bf16_row<8>(big + (size_t)row * 3072 + 2048 + c, v);
    int hd = c >> 6, d = c & 63;
    store_f32_row<8>(p.out + O_L0V + (((size_t)(row >> 8) * 16 + hd) * 256 + (row & 255)) * 64 + d, v);
  }
  transpose_gen<true>(1024, 8192, vT, 8192, [&](int rr, int c) { return big[(size_t)rr * 3072 + 2048 + c]; });
  const float* ck = p.in[I_C0K]; const float* cv = p.in[I_C0V];
  for (int idx = gtid(); idx < 2 * 16 * 256 * 64 / 8; idx += gthreads()) {
    float v[8];
#pragma unroll
    for (int e = 0; e < 8; ++e) v[e] = ck[(size_t)idx * 8 + e];
    store_bf16_row<8>(kc + (size_t)idx * 8, v);
  }
  transpose_gen<true>(2048, 256, vcT, 256, [&](int l_, int c) { return f2bf(cv[((size_t)(c >> 6) * 256 + l_) * 64 + (c & 63)]); });
}

DI void attn0_phase(CPR p, char* smem0) {
  char* smem = smem0 + (otid() >> 8) * 65536;
  const int tid = vtid(), lane = tid & 63, wave = tid >> 6, r = lane & 31, hh = lane >> 5;
  char* mix = p.ws + OFF_MIX;
  const bf16_t* qb = (const bf16_t*)(mix + L0_QB); const bf16_t* kb = (const bf16_t*)(mix + L0_KB); const bf16_t* vT = (const bf16_t*)(mix + L0_VT);
  const bf16_t* kc = (const bf16_t*)(mix + L0_KC); const bf16_t* vcT = (const bf16_t*)(mix + L0_VCT);
  bf16_t* o = (bf16_t*)(p.ws + OFF_O);
  float* sbias = (float*)smem;
  for (int it = vbid(); it < 1024; it += nvb()) {
    f32x16 O[2];
    float m_run, l_run;
    if (it < 512) {
      int b = it >> 8, hd = (it >> 4) & 15, blk = it & 15;
      __syncthreads();
      for (int i = tid; i < 465; i += 256) sbias[i] = p.in[I_NABIAS][hd * 465 + i] * 1.4426950408889634f;
      __syncthreads();
      int gr = blk * 2 + (wave >> 1), cq0 = (wave & 1) * 32;
      int grow_q = 4096 + b * 2048 + gr * 64 + cq0;
      int kr0 = min(max(gr - 4, 0), 24);
      int qc = cq0 + r;
      int win0 = min(max(qc - 8, 0), 48);
      const bf16_t* kcb = kc + (size_t)(b * 16 + hd) * 256 * 64;
      const bf16_t* vcb = vcT + (size_t)(b * 16 + hd) * 64 * 256;
      const bf16_t* kbb = kb + ((size_t)hd * 8192 + 4096 + b * 2048) * 64;
      const bf16_t* vtb = vT + (size_t)hd * 64 * 8192 + 4096 + b * 2048;
      flash_wave<64, 64>(qb + ((size_t)hd * 8192 + grow_q) * 64, 24, 0.125f * 1.4426950408889634f,
        [&](int ti, const bf16_t*& kp, const bf16_t*& vp, int& vs) {
          if (ti < 8) { kp = kcb + ti * 32 * 64; vp = vcb + ti * 32; vs = 256; }
          else { int lt = ti - 8; int tok = (kr0 + (lt >> 1)) * 64 + (lt & 1) * 32; kp = kbb + (size_t)tok * 64; vp = vtb + tok; vs = 8192; }
        },
        [&](int ti, int i, float s) {
          if (ti < 8) return s;
          int lt = ti - 8;
          int kcol = (lt & 1) * 32 + crow(i, hh);
          int roff = kr0 + (lt >> 1) - gr + 7;
          int coff = min(max(kcol - qc + 15, 0), 30);
          bool valid = (kcol >= win0) && (kcol < win0 + 16);
          return valid ? s + sbias[roff * 31 + coff] : -1e30f;
        },
        O, m_run, l_run, r, hh);
      store_o<2>(o + (size_t)grow_q * 1024 + hd * 64, 1024, O, 1.f / l_run, r, hh);
    } else {
      int pi = it - 512;
      int b = pi >> 5, hd = (pi >> 1) & 15, qbk = pi & 1;
      int grow_q = b * 256 + qbk * 128 + wave * 32;
      const bf16_t* kbb = kb + ((size_t)hd * 8192 + b * 256) * 64;
      const bf16_t* vtb = vT + (size_t)hd * 64 * 8192 + b * 256;
      flash_wave<64, 64>(qb + ((size_t)hd * 8192 + grow_q) * 64, 8, 0.125f * 1.4426950408889634f,
        [&](int ti, const bf16_t*& kp, const bf16_t*& vp, int& vs) { kp = kbb + ti * 32 * 64; vp = vtb + ti * 32; vs = 8192; },
        [&](int, int, float s) { return s; }, O, m_run, l_run, r, hh);
      store_o<2>(o + (size_t)grow_q * 1024 + hd * 64, 1024, O, 1.f / l_run, r, hh);
    }
  }
}

constexpr size_t L1_QE = 0, L1_KE = 16 * MB, L1_KDT = 32 * MB, L1_VT = 48 * MB, L1_DTOT = 64 * MB;
constexpr size_t L1_ODIR = 8192ull * 3328 * 2;
DI void prep1_phase(CPR p, char* smem0) {
  char* smem = smem0 + (otid() >> 8) * 65536;
  const int tid = vtid();
  const bf16_t* big = (const bf16_t*)(p.ws + OFF_BIG);
  char* mix = p.ws + OFF_MIX;
  bf16_t* qe = (bf16_t*)(mix + L1_QE); bf16_t* ke = (bf16_t*)(mix + L1_KE); bf16_t* kdT = (bf16_t*)(mix + L1_KDT);
  bf16_t* vT = (bf16_t*)(mix + L1_VT); float* dtot = (float*)(mix + L1_DTOT);
  float* rr = (float*)smem;
  bf16_t* qs = (bf16_t*)(smem + 8192);
  bf16_t* ks = (bf16_t*)(smem + 8192 + 16384);
  for (int it = vbid(); it < 128 * 4; it += nvb()) {
    int ch = it >> 2, hd = it & 3;
    int grow0 = ch * 64;
    __syncthreads();
    for (int i = tid; i < 64 * 32; i += 256) rr[i] = bf2f(big[(size_t)(grow0 + (i >> 5)) * 3328 + 3072 + (i & 31)]);
#pragma unroll
    for (int j = 0; j < 4; ++j) {
      int c = tid + 256 * j, row = c >> 4, pc = c & 15;
      *(uint4*)(qs + row * 128 + pc * 8) = *(const uint4*)(big + (size_t)(grow0 + row) * 3328 + hd * 128 + pc * 8);
      *(uint4*)(ks + row * 128 + pc * 8) = *(const uint4*)(big + (size_t)(grow0 + row) * 3328 + 512 + hd * 128 + pc * 8);
    }
    __syncthreads();
    int dir = tid >> 7, k = tid & 127;
    float w2[16];
#pragma unroll
    for (int j = 0; j < 16; ++j) w2[j] = p.in[I_GG2][((size_t)dir * 16 + j) * 512 + hd * 128 + k];
    float bg = p.in[I_GBG][dir * 512 + hd * 128 + k];
    float lgv[64];
    float btot = 0.f;
#pragma unroll
    for (int t = 0; t < 64; ++t) {
      float x = bg;
      const float4* r4 = (const float4*)(rr + t * 32 + dir * 16);
#pragma unroll
      for (int j4 = 0; j4 < 4; ++j4) { float4 rv = r4[j4]; x += rv.x * w2[j4 * 4] + rv.y * w2[j4 * 4 + 1] + rv.z * w2[j4 * 4 + 2] + rv.w * w2[j4 * 4 + 3]; }
      float ls = fminf(x, 0.f) - __logf(1.f + __expf(-fabsf(x)));
      lgv[t] = ls * (1.f / 16.f);
      btot += lgv[t];
    }
    float bc = 0.f;
    size_t dbase = ((size_t)dir * 4 + hd) * 8192;
    bf16_t* kdt_row = kdT + ((((size_t)dir * 4 + hd) * 128 + ch) * 128 + k) * 64;
#pragma unroll
    for (int tt = 0; tt < 64; ++tt) {
      const int tf = tt, tb = 63 - tt;
      bc += dir ? lgv[tb] : lgv[tf];
      const int t = dir ? tb : tf;
      float qv = bf2f(qs[t * 128 + k]);
      float kv = bf2f(ks[t * 128 + k]);
      qe[(dbase + grow0 + t) * 128 + k] = f2bf(qv * 0.08838834764831845f * __expf(bc));
      ke[(dbase + grow0 + t) * 128 + k] = f2bf(kv * __expf(-bc));
      kdt_row[t] = f2bf(kv * __expf(btot - bc));
    }
    dtot[(((size_t)dir * 4 + hd) * 128 + ch) * 128 + k] = __expf(btot);
  }
  transpose_gen<false>(1024, 8192, vT, 8192, [&](int r_, int c) { return big[(size_t)r_ * 3328 + 1024 + c]; });
}

DI void scan1_phase(CPR p, char* smem0) {
  char* smem = smem0 + (otid() >> 8) * 65536;
  const int tid = vtid(), lane = tid & 63, wave = tid >> 6, r = lane & 31, hh = lane >> 5;
  char* mix = p.ws + OFF_MIX;
  const bf16_t* qe = (const bf16_t*)(mix + L1_QE); const bf16_t* ke = (const bf16_t*)(mix + L1_KE); const bf16_t* kdT = (const bf16_t*)(mix + L1_KDT);
  const bf16_t* vT = (const bf16_t*)(mix + L1_VT); const float* dtot = (const float*)(mix + L1_DTOT);
  bf16_t* odir = (bf16_t*)(p.ws + OFF_BIG + L1_ODIR);
  bf16_t* St = (bf16_t*)smem;
  bf16_t* al = (bf16_t*)(smem + 8704);
  char* vls = smem + 17920;
  float* dts = (float*)(smem + 27136);
  char* qes = smem + 28160;
  char* kes = smem + 45568;
  const int wg_ = obid(), half_ = otid() >> 8, nwg_ = (int)gridDim.x;
  const bool spread = nwg_ >= 256;
  int it0, itstep, nsync_target = 0;
  if (spread) {
    if (wg_ < 128 && half_ == 0) { it0 = wg_; itstep = 1 << 20; }
    else {
      const int lam = wg_ < 128 ? wg_ : 128 + 2 * (wg_ - 128) + half_;
      it0 = 128 + lam; itstep = 128 + 2 * (nwg_ - 128);
    }
    if (wg_ < 128) nsync_target = 1 + 3 * 32;
  } else { it0 = vbid(); itstep = nvb(); }
  int nsync_done = 0;
  for (int it = it0; it < 1152; it += itstep) {
    bool samp = it < 128;
    int q_ = samp ? it : it - 128;
    int b = q_ >> 6, hd = (q_ >> 4) & 3, dir = (q_ >> 3) & 1, vsl = q_ & 7;
    int grow0 = samp ? 4096 + b * 2048 : b * 256;
    int nc = samp ? 32 : 4;
    const int ti = wave >> 1, xi = wave & 1;
    f32x16 S;
    if (samp) {
      const float* s0 = p.in[dir ? I_SB : I_SF] + ((size_t)(b * 4 + hd) * 128) * 256;
#pragma unroll
      for (int i = 0; i < 16; ++i) S[i] = s0[(size_t)(wave * 32 + crow(i, hh)) * 256 + vsl * 32 + r];
    } else {
#pragma unroll
      for (int i = 0; i < 16; ++i) S[i] = 0.f;
    }
    auto write_St = [&]() {
#pragma unroll
      for (int ig = 0; ig < 4; ++ig) {
        uint2 q;
        q.x = pack2(S[ig * 4 + 0], S[ig * 4 + 1]);
        q.y = pack2(S[ig * 4 + 2], S[ig * 4 + 3]);
        *(uint2*)(St + r * 136 + wave * 32 + 8 * ig + 4 * hh) = q;
      }
    };
    const size_t dbase = ((size_t)dir * 4 + hd) * 8192;
    const bf16_t* vsrc = vT + ((size_t)hd * 256 + vsl * 32 + (tid >> 3)) * 8192 + (tid & 7) * 8;
    const int vdst = (tid >> 3) * 144 + (tid & 7) * 16;
    const float* dsrc = dtot + (((size_t)dir * 4 + hd) * 128) * 128 + (tid & 127);
    const bf16_t* qsrc = qe + dbase * 128 + tid * 8;
    const bf16_t* ksrc = ke + dbase * 128 + tid * 8;
    const int tdst = (tid >> 4) * 272 + (tid & 15) * 16;
    bf16x8 kd[4], kdN[4];
    uint4 vst, qst0, qst1, qst2, qst3, kst0, kst1, kst2, kst3; float dtst;
#define SC_GROW(CC) (grow0 + ((dir ? nc - 1 - (CC) : (CC)) << 6))
#define SC_LOADKD(CC, KD) do { const bf16_t* kd_p = kdT + ((((size_t)dir * 4 + hd) * 128 + (SC_GROW(CC) >> 6)) * 128 + wave * 32 + r) * 64 + hh * 8; \
      _Pragma("unroll") for (int kk = 0; kk < 4; ++kk) KD[kk] = *(const bf16x8*)(kd_p + kk * 16); } while (0)
#define SC_LOADST(CC) do { const int g_ = SC_GROW(CC); vst = *(const uint4*)(vsrc + g_); dtst = dsrc[(size_t)(g_ >> 6) * 128]; \
      const bf16_t* q_p = qsrc + (size_t)g_ * 128; const bf16_t* k_p = ksrc + (size_t)g_ * 128; \
      qst0 = *(const uint4*)(q_p); qst1 = *(const uint4*)(q_p + 2048); qst2 = *(const uint4*)(q_p + 4096); qst3 = *(const uint4*)(q_p + 6144); \
      kst0 = *(const uint4*)(k_p); kst1 = *(const uint4*)(k_p + 2048); kst2 = *(const uint4*)(k_p + 4096); kst3 = *(const uint4*)(k_p + 6144); } while (0)
#define SC_WRITEST(BUF) do { *(uint4*)(vls + (BUF) * 4608 + vdst) = vst; if (tid < 128) dts[(BUF) * 128 + tid] = dtst; \
      *(uint4*)(qes + tdst) = qst0; *(uint4*)(qes + tdst + 16 * 272) = qst1; *(uint4*)(qes + tdst + 32 * 272) = qst2; *(uint4*)(qes + tdst + 48 * 272) = qst3; \
      *(uint4*)(kes + tdst) = kst0; *(uint4*)(kes + tdst + 16 * 272) = kst1; *(uint4*)(kes + tdst + 32 * 272) = kst2; *(uint4*)(kes + tdst + 48 * 272) = kst3; } while (0)
    SC_LOADST(0);
    SC_LOADKD(0, kd);
    __syncthreads();
    write_St();
    SC_WRITEST(0);
    for (int cc = 0; cc < nc; ++cc) {
      const int ccn = min(cc + 1, nc - 1);
      const int growc = SC_GROW(cc);
      const char* vcur = vls + (cc & 1) * 4608;
      const float* dcur = dts + (cc & 1) * 128;
      SC_LOADST(ccn);
      SC_LOADKD(ccn, kdN);
      __syncthreads();
      bf16x8 qf[8];
      f32x16 acc;
#pragma unroll
      for (int i = 0; i < 16; ++i) acc[i] = 0.f;
#pragma unroll
      for (int kk = 0; kk < 8; ++kk) {
        qf[kk] = *(const bf16x8*)(qes + (ti * 32 + r) * 272 + kk * 32 + hh * 16);
        bf16x8 kf = *(const bf16x8*)(kes + (xi * 32 + r) * 272 + kk * 32 + hh * 16);
        acc = MFMA32(qf[kk], kf, acc);
      }
#pragma unroll
      for (int i = 0; i < 16; ++i) {
        int t = ti * 32 + crow(i, hh), s = xi * 32 + r;
        bool keep = dir ? (s >= t) : (s <= t);
        al[t * 72 + s] = f2bf(keep ? acc[i] : 0.f);
      }
      __syncthreads();
      if (xi == 0) {
#pragma unroll
        for (int i = 0; i < 16; ++i) acc[i] = 0.f;
#pragma unroll
        for (int kk = 0; kk < 8; ++kk) {
          bf16x8 sf = *(const bf16x8*)(St + r * 136 + kk * 16 + hh * 8);
          acc = MFMA32(qf[kk], sf, acc);
        }
#pragma unroll
        for (int kk = 0; kk < 4; ++kk) {
          bf16x8 af = *(const bf16x8*)(al + (ti * 32 + r) * 72 + kk * 16 + hh * 8);
          bf16x8 vf = *(const bf16x8*)(vcur + r * 144 + kk * 32 + hh * 16);
          acc = MFMA32(af, vf, acc);
        }
#pragma unroll
        for (int i = 0; i < 16; ++i)
          odir[((size_t)dir * 8192 + growc + ti * 32 + crow(i, hh)) * 1024 + hd * 256 + vsl * 32 + r] = f2bf(acc[i]);
      }
#pragma unroll
      for (int i = 0; i < 16; ++i) S[i] *= dcur[wave * 32 + crow(i, hh)];
#pragma unroll
      for (int kk = 0; kk < 4; ++kk) {
        bf16x8 vf = *(const bf16x8*)(vcur + r * 144 + kk * 32 + hh * 16);
        S = MFMA32(kd[kk], vf, S);
      }
      __syncthreads();
      write_St();
      SC_WRITEST((cc + 1) & 1);
#pragma unroll
      for (int kk = 0; kk < 4; ++kk) kd[kk] = kdN[kk];
    }
#undef SC_GROW
#undef SC_LOADKD
#undef SC_LOADST
#undef SC_WRITEST
    nsync_done += 1 + 3 * nc;
    if (!samp) {
      const int t2 = vtid(), r2 = t2 & 31, h2 = (t2 >> 5) & 1, w2 = t2 >> 6;
      float* so = p.out + (dir ? O_L1B : O_L1F) + ((size_t)(b * 4 + hd) * 128) * 256 + (size_t)(w2 * 32 + 4 * h2) * 256 + vsl * 32 + r2;
#pragma unroll
      for (int i = 0; i < 16; ++i) so[((i & 3) + 8 * (i >> 2)) * 256] = S[i];
    }
  }
  for (; nsync_done < nsync_target; ++nsync_done) __syncthreads();
}

DI void gla_out_phase(CPR p) {
  const bf16_t* big = (const bf16_t*)(p.ws + OFF_BIG);
  const bf16_t* odir = (const bf16_t*)(p.ws + OFF_BIG + L1_ODIR);
  bf16_t* o = (bf16_t*)(p.ws + OFF_O);
  const float* gn = p.in[I_GON];
  for (int idx = gtid(); idx < 8192 * 4 * 32; idx += gthreads()) {
    int sub = idx & 31, hd = (idx >> 5) & 3, row = idx >> 7;
    int col = hd * 256 + sub * 8;
    float a[8], b2[8], g[8];
    load_bf16_row<8>(odir + (size_t)row * 1024 + col, a);
    load_bf16_row<8>(odir + ((size_t)8192 + row) * 1024 + col, b2);
    load_bf16_row<8>(big + (size_t)row * 3328 + 2048 + col, g);
    float ss = 0.f;
#pragma unroll
    for (int e = 0; e < 8; ++e) { a[e] += b2[e]; ss += a[e] * a[e]; }
#pragma unroll
    for (int ofs = 16; ofs >= 1; ofs >>= 1) ss += __shfl_xor(ss, ofs);
    float rs = rsqrtf(ss * (1.f / 256.f) + 1e-6f);
#pragma unroll
    for (int e = 0; e < 8; ++e) a[e] = a[e] * rs * gn[sub * 8 + e] * siluf(g[e]);
    store_bf16_row<8>(o + (size_t)row * 1024 + col, a);
  }
}

constexpr size_t L2_QD = 0, L2_KDP = 16 * MB, L2_KDS = 24 * MB, L2_VTP = 34 * MB, L2_VTS = 42 * MB;
DI void prep2_phase(CPR p) {
  const bf16_t* big = (const bf16_t*)(p.ws + OFF_BIG);
  char* mix = p.ws + OFF_MIX;
  bf16_t* qd = (bf16_t*)(mix + L2_QD); bf16_t* kdp = (bf16_t*)(mix + L2_KDP); bf16_t* kds = (bf16_t*)(mix + L2_KDS);
  bf16_t* vtp = (bf16_t*)(mix + L2_VTP); bf16_t* vts = (bf16_t*)(mix + L2_VTS);
  for (int idx = gtid(); idx < 2 * 8192 * 16 * 8; idx += gthreads()) {
    int sub = idx & 7, hd = (idx >> 3) & 15, row = (idx >> 7) & 8191, which = idx >> 20;
    float v[8];
    load_bf16_row<8>(big + (size_t)row * 3072 + which * 1024 + hd * 64 + sub * 8, v);
    const float extra = which ? 1.f : 0.125f * 1.4426950408889634f;
    if (row >= 4096) headnorm8<true>(v, p.in[which ? I_DKN : I_DQN], sub, extra, (row - 4096) & 2047);
    else headnorm8<false>(v, p.in[which ? I_DKN : I_DQN], sub, extra, 0);
    if (!which) store_bf16_row<8>(qd + ((size_t)hd * 8192 + row) * 64 + sub * 8, v);
    else if (row < 4096) {
      store_bf16_row<8>(kdp + ((size_t)hd * 4096 + row) * 64 + sub * 8, v);
      store_f32_row<8>(p.out + O_L2K + (((size_t)(row >> 8) * 16 + hd) * 256 + (row & 255)) * 64 + sub * 8, v);
    } else {
      int b = (row - 4096) >> 11, t = (row - 4096) & 2047;
      store_bf16_row<8>(kds + (((size_t)b * 16 + hd) * 2304 + 256 + t) * 64 + sub * 8, v);
    }
  }
  for (int idx = gtid(); idx < 4096 * 128; idx += gthreads()) {
    int row = idx >> 7, c = (idx & 127) * 8;
    float v[8];
    load_bf16_row<8>(big + (size_t)row * 3072 + 2048 + c, v);
    int hd = c >> 7, d = c & 127;
    store_f32_row<8>(p.out + O_L2V + (((size_t)(row >> 8) * 8 + hd) * 256 + (row & 255)) * 128 + d, v);
  }
  transpose_gen<true, 128>(1024, 4096, vtp, (size_t)128 * 4096, [&](int r_, int c) { return big[(size_t)r_ * 3072 + 2048 + c]; }, 0);
  for (int b = 0; b < 2; ++b)
    transpose_gen<true, 128>(1024, 2048, vts + (size_t)b * 1024 * 2304, (size_t)128 * 2304, [&](int r_, int c) { return big[(size_t)(4096 + b * 2048 + r_) * 3072 + 2048 + c]; }, 256);
  const float* ck = p.in[I_C2K]; const float* cv = p.in[I_C2V];
  for (int idx = gtid(); idx < 2 * 16 * 256 * 8; idx += gthreads()) {
    int bh = idx >> 11, rem = idx & 2047;
    float v[8];
#pragma unroll
    for (int e = 0; e < 8; ++e) v[e] = ck[(size_t)idx * 8 + e];
    store_bf16_row<8>(kds + (size_t)bh * 2304 * 64 + (size_t)rem * 8, v);
  }
  transpose_gen<true, 128>(2048, 256, vts, (size_t)128 * 2304, [&](int l_, int c) { return f2bf(cv[((size_t)(c >> 7) * 256 + l_) * 128 + (c & 127)]); }, 0);
}

DI void attn2_phase(CPR p, char* smem0) {
  char* smem = smem0 + (otid() >> 8) * 65536;
  const int tid = vtid(), lane = tid & 63, wave = tid >> 6, r = lane & 31, hh = lane >> 5;
  float* xch = (float*)smem;
  float lam;
  {
    const float* dl = p.in[I_DLAM];
    float a = dl[lane] * dl[64 + lane], b2 = dl[128 + lane] * dl[192 + lane];
#pragma unroll
    for (int ofs = 32; ofs >= 1; ofs >>= 1) { a += __shfl_xor(a, ofs); b2 += __shfl_xor(b2, ofs); }
    lam = __expf(a) - __expf(b2) + 0.47071301834435835f;
  }
  const int qs = wave >> 1, comp = wave & 1;
  for (int it = vbid(); it < 1024; it += nvb()) {
    CPP pl = (CPP)__builtin_amdgcn_kernarg_segment_ptr();
    asm volatile("" : "+s"(pl));
    char* mix = pl->ws + OFF_MIX;
    const bf16_t* qd = (const bf16_t*)(mix + L2_QD); const bf16_t* kdp = (const bf16_t*)(mix + L2_KDP); const bf16_t* kds = (const bf16_t*)(mix + L2_KDS);
    const bf16_t* vtp = (const bf16_t*)(mix + L2_VTP); const bf16_t* vts = (const bf16_t*)(mix + L2_VTS);
    bf16_t* o = (bf16_t*)(pl->ws + OFF_O);
    f32x16 O[4];
    float m_run, l_run;
    int grow_q, hd;
    {
      const bf16_t *k0, *k1, *vb_; int vs_, nt_;
      if (it < 512) {
        int b = it >> 8; hd = (it >> 5) & 7; int blk = it & 31;
        grow_q = 4096 + b * 2048 + blk * 64 + qs * 32;
        k0 = kds + ((size_t)b * 16 + hd) * 2304 * 64; k1 = kds + ((size_t)b * 16 + 8 + hd) * 2304 * 64;
        vb_ = vts + ((size_t)b * 8 + hd) * 128 * 2304; vs_ = 2304; nt_ = 72;
      } else {
        int pi = it - 512;
        int b = pi >> 5; hd = (pi >> 2) & 7; int blk = pi & 3;
        grow_q = b * 256 + blk * 64 + qs * 32;
        k0 = kdp + ((size_t)hd * 4096 + b * 256) * 64; k1 = kdp + ((size_t)(8 + hd) * 4096 + b * 256) * 64;
        vb_ = vtp + (size_t)hd * 128 * 4096 + (size_t)b * 256 * 128; vs_ = 4096; nt_ = 8;
      }
      flash_block<64, 128, 2, false>(qd + ((size_t)(comp * 8 + hd) * 8192 + grow_q) * 64, nt_, 0.125f * 1.4426950408889634f, k0, k1, vb_, vs_, smem, comp, O, m_run, l_run, tid, r, hh);
    }
    float linv = 1.f / l_run;
    __syncthreads();
    if (comp == 1) {
#pragma unroll
      for (int t = 0; t < 4; ++t)
#pragma unroll
        for (int i = 0; i < 16; ++i) xch[(qs * 64 + t * 16 + i) * 64 + lane] = O[t][i] * linv;
    }
    __syncthreads();
    if (comp == 0) {
      float ss = 0.f;
#pragma unroll
      for (int t = 0; t < 4; ++t)
#pragma unroll
        for (int i = 0; i < 16; ++i) {
          float v = O[t][i] * linv - lam * xch[(qs * 64 + t * 16 + i) * 64 + lane];
          O[t][i] = v;
          ss += v * v;
        }
      ss += __shfl_xor(ss, 32);
      float rs = rsqrtf(ss * (1.f / 128.f) + 1e-6f) * 0.52928698165564165f;
      const float* gs = p.in[I_DSUB];
#pragma unroll
      for (int t = 0; t < 4; ++t)
#pragma unroll
        for (int i = 0; i < 16; ++i) O[t][i] *= rs * gs[t * 32 + crow(i, hh)];
      store_o<4>(o + (size_t)grow_q * 1024 + hd * 128, 1024, O, 1.f, r, hh);
    }
  }
}

constexpr size_t L3_QAN = 0, L3_CKVN = 6 * MB, L3_QM = 11 * MB, L3_KMP = 35 * MB, L3_KMS = 47 * MB, L3_VTP = 61 * MB, L3_VTS = 69 * MB;
constexpr size_t L3_Q1 = 8192ull * 768 * 2, L3_KV1 = L3_Q1 + 8192ull * 1536 * 2, L3_DQ2 = L3_KV1 + 8704ull * 2048 * 2;
DI void prep3a_phase(CPR p) {
  const int lane = otid() & 63, wave = otid() >> 6;
  const bf16_t* big = (const bf16_t*)(p.ws + OFF_BIG);
  char* mix = p.ws + OFF_MIX;
  bf16_t* qan = (bf16_t*)(mix + L3_QAN); bf16_t* ckvn = (bf16_t*)(mix + L3_CKVN);
  for (int row = obid() * 8 + wave; row < 8192; row += gridDim.x * 8) {
    bf16_t* br = (bf16_t*)(p.ws + OFF_BIG) + (size_t)row * 768;
    const bf16_t* br2 = (const bf16_t*)(p.ws + OFF_BIG + L3_DQ2) + (size_t)row * 768;
    float q[6], ss = 0.f;
#pragma unroll
    for (int j = 0; j < 6; ++j) { q[j] = bf2f(br[j * 64 + lane]) + bf2f(br2[j * 64 + lane]); ss += q[j] * q[j]; }
#pragma unroll
    for (int ofs = 32; ofs >= 1; ofs >>= 1) ss += __shfl_xor(ss, ofs);
    float rs = rsqrtf(ss * (1.f / 384.f) + 1e-6f);
#pragma unroll
    for (int j = 0; j < 6; ++j) qan[(size_t)row * 384 + j * 64 + lane] = f2bf(q[j] * rs * p.in[I_MQAN][j * 64 + lane]);
    float c[4]; ss = 0.f;
#pragma unroll
    for (int j = 0; j < 4; ++j) { c[j] = bf2f(br[384 + j * 64 + lane]) + bf2f(br2[384 + j * 64 + lane]); ss += c[j] * c[j]; }
#pragma unroll
    for (int ofs = 32; ofs >= 1; ofs >>= 1) ss += __shfl_xor(ss, ofs);
    rs = rsqrtf(ss * (1.f / 256.f) + 1e-6f);
#pragma unroll
    for (int j = 0; j < 4; ++j) {
      float y = c[j] * rs * p.in[I_MKVAN][j * 64 + lane];
      ckvn[(size_t)row * 256 + j * 64 + lane] = f2bf(y);
      if (row < 4096) p.out[O_L3C + (size_t)row * 256 + j * 64 + lane] = y;
    }
    if (lane < 32) {
      const float kr = bf2f(br[640 + lane]) + bf2f(br2[640 + lane]);
      br[640 + lane] = f2bf(kr);
      if (row < 4096) p.out[O_L3R + (size_t)row * 32 + lane] = kr;
    }
  }
  for (int idx = gtid(); idx < 512 * 256; idx += gthreads()) ckvn[(size_t)8192 * 256 + idx] = f2bf(p.in[I_C3C][idx]);
}

DI void prep3b_phase(CPR p) {
  const bf16_t* big = (const bf16_t*)(p.ws + OFF_BIG);
  const bf16_t* q1 = (const bf16_t*)(p.ws + OFF_BIG + L3_Q1);
  const bf16_t* kv1 = (const bf16_t*)(p.ws + OFF_BIG + L3_KV1);
  char* mix = p.ws + OFF_MIX;
  bf16_t* qm = (bf16_t*)(mix + L3_QM); bf16_t* kmp = (bf16_t*)(mix + L3_KMP); bf16_t* kms = (bf16_t*)(mix + L3_KMS);
  bf16_t* vtp = (bf16_t*)(mix + L3_VTP); bf16_t* vts = (bf16_t*)(mix + L3_VTS);
  for (int idx = gtid(); idx < 8192 * 16 * 2; idx += gthreads()) {
    int half = idx & 1, hd = (idx >> 1) & 15, row = idx >> 5;
    float v[48];
    load_bf16_row<48>(q1 + (size_t)row * 1536 + hd * 96 + half * 48, v);
    float ss = 0.f;
#pragma unroll
    for (int j = 0; j < 48; ++j) ss += v[j] * v[j];
    ss += __shfl_xor(ss, 1);
    float rs = rsqrtf(ss * (1.f / 96.f) + 1e-6f);
    const float* g = p.in[I_MQN] + half * 48;
    rs *= 0.10206207261596577f * 1.4426950408889634f;
#pragma unroll
    for (int j = 0; j < 48; ++j) v[j] = v[j] * rs * g[j];
    if (half && row >= 4096) rope_apply<48, 16, 32>(v, (row - 4096) & 2047);
    store_bf16_row<48>(qm + ((size_t)hd * 8192 + row) * 96 + half * 48, v);
  }
  for (int idx = gtid(); idx < 8704 * 16 * 2; idx += gthreads()) {
    int half = idx & 1, hd = (idx >> 1) & 15, row = idx >> 5;
    float v[48];
    if (!half) {
      load_bf16_row<48>(kv1 + (size_t)row * 2048 + hd * 128, v);
    } else {
      float t16[16];
      load_bf16_row<16>(kv1 + (size_t)row * 2048 + hd * 128 + 48, t16);
#pragma unroll
      for (int j = 0; j < 16; ++j) v[j] = t16[j];
      if (row < 8192) {
        float t32[32];
        load_bf16_row<32>(big + (size_t)row * 768 + 640, t32);
#pragma unroll
        for (int j = 0; j < 32; ++j) v[16 + j] = t32[j];
      } else {
#pragma unroll
        for (int j = 0; j < 32; ++j) v[16 + j] = p.in[I_C3R][(size_t)(row - 8192) * 32 + j];
      }
    }
    float ss = 0.f;
#pragma unroll
    for (int j = 0; j < 48; ++j) ss += v[j] * v[j];
    ss += __shfl_xor(ss, 1);
    float rs = rsqrtf(ss * (1.f / 96.f) + 1e-6f);
    const float* g = p.in[I_MKN] + half * 48;
#pragma unroll
    for (int j = 0; j < 48; ++j) v[j] = v[j] * rs * g[j];
    if (row < 4096) store_bf16_row<48>(kmp + ((size_t)hd * 4096 + row) * 96 + half * 48, v);
    else if (row < 8192) {
      int b = (row - 4096) >> 11, t = (row - 4096) & 2047;
      if (half) rope_apply<48, 16, 32>(v, t);
      store_bf16_row<48>(kms + (((size_t)b * 16 + hd) * 2304 + 256 + t) * 96 + half * 48, v);
    } else {
      int b = (row - 8192) >> 8, l_ = (row - 8192) & 255;
      store_bf16_row<48>(kms + (((size_t)b * 16 + hd) * 2304 + l_) * 96 + half * 48, v);
    }
  }
  transpose_gen<true, 64>(1024, 4096, vtp, (size_t)64 * 4096, [&](int r_, int c) { return kv1[(size_t)r_ * 2048 + (c >> 6) * 128 + 64 + (c & 63)]; }, 0);
  for (int b = 0; b < 2; ++b) {
    transpose_gen<true, 64>(1024, 2048, vts + (size_t)b * 1024 * 2304, (size_t)64 * 2304, [&](int r_, int c) { return kv1[(size_t)(4096 + b * 2048 + r_) * 2048 + (c >> 6) * 128 + 64 + (c & 63)]; }, 256);
    transpose_gen<true, 64>(1024, 256, vts + (size_t)b * 1024 * 2304, (size_t)64 * 2304, [&](int r_, int c) { return kv1[(size_t)(8192 + b * 256 + r_) * 2048 + (c >> 6) * 128 + 64 + (c & 63)]; }, 0);
  }
}

DI void attn3_phase(CPR p, char* smem0) {
  char* smem = smem0 + (otid() >> 8) * 65536;
  const int tid = vtid(), lane = tid & 63, wave = tid >> 6, r = lane & 31, hh = lane >> 5;
  char* mix = p.ws + OFF_MIX;
  const bf16_t* qm = (const bf16_t*)(mix + L3_QM); const bf16_t* kmp = (const bf16_t*)(mix + L3_KMP); const bf16_t* kms = (const bf16_t*)(mix + L3_KMS);
  const bf16_t* vtp = (const bf16_t*)(mix + L3_VTP); const bf16_t* vts = (const bf16_t*)(mix + L3_VTS);
  bf16_t* o = (bf16_t*)(p.ws + OFF_O);
  const float scale = 0.10206207261596577f * 1.4426950408889634f;
  for (int it = vbid(); it < 1024; it += nvb()) {
    f32x16 O[2];
    float m_run, l_run;
    int grow_q, hd;
    const bf16_t *k0, *vb_; int vs_, nt_;
    if (it < 512) {
      int b = it >> 8; hd = (it >> 4) & 15; int blk = it & 15;
      grow_q = 4096 + b * 2048 + blk * 128 + wave * 32;
      k0 = kms + ((size_t)b * 16 + hd) * 2304 * 96;
      vb_ = vts + ((size_t)b * 16 + hd) * 64 * 2304; vs_ = 2304; nt_ = 72;
    } else {
      int pi = it - 512;
      int b = pi >> 5; hd = (pi >> 1) & 15; int blk = pi & 1;
      grow_q = b * 256 + blk * 128 + wave * 32;
      k0 = kmp + ((size_t)hd * 4096 + b * 256) * 96;
      vb_ = vtp + (size_t)hd * 64 * 4096 + (size_t)b * 256 * 64; vs_ = 4096; nt_ = 8;
    }
    flash_block<96, 64, 1, true>(qm + ((size_t)hd * 8192 + grow_q) * 96, nt_, scale, k0, k0, vb_, vs_, smem, 0, O, m_run, l_run, tid, r, hh);
    store_o<2>(o + (size_t)grow_q * 1024 + hd * 64, 1024, O, 1.f / l_run, r, hh);
  }
}

#define XB_TMO      128
#define XB_XCNT(j)  (256  + 64 * (j))
#define XB_XSUB(j)  (1280 + 64 * (j))
#define XB_XGEN(j)  (2304 + 64 * (j))
#define XB_TOP      3328
#define XB_TOPGEN   3392
#define XCD_BAR_WORDS 3456
#define XB_SPIN_CAP (1u << 18)
#define LAS __attribute__((address_space(3)))
DI unsigned xb_ld(unsigned* p) { return __hip_atomic_load(p, __ATOMIC_RELAXED, __HIP_MEMORY_SCOPE_AGENT); }
DI unsigned xb_add(unsigned* p, unsigned v) { return __hip_atomic_fetch_add(p, v, __ATOMIC_RELAXED, __HIP_MEMORY_SCOPE_AGENT); }
DI unsigned xb_xcc_id() { return (unsigned)__builtin_amdgcn_s_getreg((3 << 11) | 20) & 0xFu; }
#define XB_SPIN(cond, bar) do { unsigned _sp = 0; while (cond) { __builtin_amdgcn_s_sleep(1); \
    if ((++_sp & 255u) == 0u) { if (xb_ld(&(bar)[XB_TMO])) break; if (_sp > XB_SPIN_CAP) { atomicAdd(&(bar)[XB_TMO], 1u); break; } } } } while (0)
DI void xcd_barrier_complete(unsigned* bar, unsigned x, unsigned& nloc, unsigned& nx) {
  const unsigned G = gridDim.x;
  unsigned sum, cnt, mine, sp = 0u;
  for (;;) {
    sum = 0u; cnt = 0u; mine = 0u;
#pragma unroll
    for (unsigned j = 0; j < 16; ++j) { const unsigned c = xb_ld(&bar[XB_XCNT(j)]); sum += c; cnt += (c > 0u) ? 1u : 0u; mine = (j == x) ? c : mine; }
    if (sum == G) break;
    __builtin_amdgcn_s_sleep(1);
    if ((++sp & 255u) == 0u) { if (xb_ld(&bar[XB_TMO])) break; if (sp > XB_SPIN_CAP) { atomicAdd(&bar[XB_TMO], 1u); break; } }
  }
  nloc = mine > 0u ? mine : 1u; nx = cnt > 0u ? cnt : 1u;
}
DI void xcd_barrier(unsigned* bar, volatile LAS unsigned* st) {
  asm volatile("s_waitcnt vmcnt(0)" ::: "memory");
  __syncthreads();
  if (__builtin_amdgcn_workitem_id_x() == 0) {
    const unsigned x = xb_xcc_id();
    __builtin_amdgcn_s_waitcnt(0);
    unsigned nloc = st[0], nx = st[1];
    if (nloc == 0u) { xcd_barrier_complete(bar, x, nloc, nx); st[0] = nloc; st[1] = nx; }
    const unsigned old = xb_add(&bar[XB_XSUB(x)], 1u);
    const unsigned gen = old / nloc;
    if (old + 1u == (gen + 1u) * nloc) {
      __builtin_amdgcn_fence(__ATOMIC_RELEASE, "agent");
      asm volatile("s_waitcnt vmcnt(0)" ::: "memory");
      const unsigned og = xb_add(&bar[XB_TOP], 1u);
      const unsigned tg = og / nx;
      if (og + 1u == (tg + 1u) * nx) xb_add(&bar[XB_TOPGEN], 1u);
      else XB_SPIN(xb_ld(&bar[XB_TOPGEN]) == tg, bar);
      __builtin_amdgcn_fence(__ATOMIC_ACQUIRE, "agent");
      xb_add(&bar[XB_XGEN(x)], 1u);
      asm volatile("s_waitcnt vmcnt(0)" ::: "memory");
    } else {
      XB_SPIN(xb_ld(&bar[XB_XGEN(x)]) == gen, bar);
      __builtin_amdgcn_fence(__ATOMIC_ACQUIRE, "agent");
      asm volatile("s_waitcnt vmcnt(0)" ::: "memory");
    }
  }
  __syncthreads();
}

constexpr int LDS_BYTES = 131072 + 64;
__global__ void __launch_bounds__(512, 2) mega(Params p_unused) {
  extern __shared__ __attribute__((aligned(16))) unsigned char shm[];
  char* smem = (char*)shm;
  volatile LAS unsigned* xbw = (volatile LAS unsigned*)(shm + 131072);
  {
    CPP pq = (CPP)__builtin_amdgcn_kernarg_segment_ptr();
    unsigned* bar0 = (unsigned*)(pq->ws + OFF_BAR);
    const unsigned xid = xb_xcc_id();
    if (__builtin_amdgcn_workitem_id_x() == 0) {
      xbw[0] = 0u; xbw[1] = 0u;
      (void)xb_add(&bar0[XB_XCNT(xid)], 1u);
    }
  }
  __syncthreads();
  for (int ph = 0; ph < 46; ++ph) {
    CPP pp = (CPP)__builtin_amdgcn_kernarg_segment_ptr();
    asm volatile("" : "+s"(pp));
    CPR p = *pp;
    bf16_t* W = (bf16_t*)p.ws;
    bf16_t* H = (bf16_t*)(p.ws + OFF_H);
    bf16_t* BIG = (bf16_t*)(p.ws + OFF_BIG);
    bf16_t* OB = (bf16_t*)(p.ws + OFF_O);
    bf16_t* AB = (bf16_t*)(p.ws + OFF_MIX);
    char* mix = p.ws + OFF_MIX;
    if (ph == 0) {
      phase0(p, smem);
      if (REPMASK & 16) phase0(p, smem);
    } else if (ph == 45) {
      final_add_phase(p);
    } else {
      const int l = (ph - 1) / 11, step = (ph - 1) % 11;
      if ((step == 4 && (l == 0 || l == 2)) || (step == 5 && l != 3)) continue;
      int reps = 1;
      {
        const bool is_attn = (step == 3 && l != 3) || step == 5;
        const bool is_gemm_store = step == 1 || step == 8 || (step == 3 && l == 3);
        const bool is_misc = step == 0 || step == 2 || step == 7 || step == 9 || (step == 4);
        if ((REPMASK & 2) && is_gemm_store) reps = 2;
        if ((REPMASK & 4) && is_attn) reps = 2;
        if ((REPMASK & 8) && is_misc) reps = 2;
        if ((REPMASK & 32) && step == 3 && l == 0) reps = 2;
        if ((REPMASK & 64) && step == 3 && l == 1) reps = 2;
        if ((REPMASK & 128) && step == 3 && l == 2) reps = 2;
        if ((REPMASK & 256) && step == 5) reps = 2;
        if ((REPMASK & 512) && (step == 0 || step == 7)) reps = 2;
        if ((REPMASK & 1024) && step == 9) reps = 2;
        if ((REPMASK & 2048) && (step == 2 || step == 4)) reps = 2;
        if ((REPMASK & 16384) && step == 2 && l == 0) reps = 2;
        if ((REPMASK & 32768) && step == 2 && l == 1) reps = 2;
        if ((REPMASK & 65536) && step == 2 && l == 2) reps = 2;
        if ((REPMASK & 131072) && (step == 2 || step == 4) && l == 3) reps = 2;
        if ((REPMASK & 262144) && step == 4 && l == 1) reps = 2;
      }
      for (int rep = 0; rep < reps; ++rep)
      switch (step) {
        case 0: norm_phase(p, l, 0, l == 0, l > 0); break;
        case 1:
          if (l == 0) gemm_store_phase(H, W + W_NA_QKV, 8192, 3072, 1024, BIG, 3072, shm);
          else if (l == 1) gemm_store_phase(H, W + W_GLA_QKVG, 8192, 3328, 1024, BIG, 3328, shm);
          else if (l == 2) gemm_store_phase(H, W + W_DIFF_QKV, 8192, 3072, 1024, BIG, 3072, shm);
          else gemm_store_sk_phase(H, W + W_MLA_DQKV, 8192, 768, 1024, BIG, (bf16_t*)(p.ws + OFF_BIG + L3_DQ2), 768, shm);
          break;
        case 2:
          if (l == 0) prep0_phase(p);
          else if (l == 1) prep1_phase(p, smem);
          else if (l == 2) prep2_phase(p);
          else prep3a_phase(p);
          break;
        case 3:
          if (l == 0) attn0_phase(p, smem);
          else if (l == 1) scan1_phase(p, smem);
          else if (l == 2) attn2_phase(p, smem);
          else {
            const bf16_t* qan = (const bf16_t*)(mix + L3_QAN); const bf16_t* ckvn = (const bf16_t*)(mix + L3_CKVN);
            bf16_t* q1 = (bf16_t*)(p.ws + OFF_BIG + L3_Q1); bf16_t* kv1 = (bf16_t*)(p.ws + OFF_BIG + L3_KV1);
            gemm_store_phase(qan, W + W_MLA_UQ, 8192, 1536, 384, q1, 1536, shm);
            gemm_store_phase(ckvn, W + W_MLA_UKV, 8704, 2048, 256, kv1, 2048, shm);
          }
          break;
        case 4:
          if (l == 1) gla_out_phase(p);
          else prep3b_phase(p);
          break;
        case 5: attn3_phase(p, smem); break;
        case 6: {
          const bf16_t* wo = W + (l == 0 ? W_NA_O : l == 1 ? W_GLA_O : l == 2 ? W_DIFF_O : W_MLA_O);
          if ((int)gridDim.x >= 256 && obid() >= 128) conv_ahead(p, l, smem, obid() - 128, (int)gridDim.x - 128);
          else {
            if ((int)gridDim.x < 256 ) conv_ahead(p, l, smem, obid(), (int)gridDim.x);
            gemm_resid_phase(p, OB, 1024, wo, l, 2048, l == 0, false, shm);
          }
          if (REPMASK & 4096) gemm_resid_phase(p, OB, 1024, wo, l, 2048, l == 0, false, shm, true);
        } break;
        case 7: norm_phase(p, l, 1, false, false); break;
        case 8: gemm_store_phase(H, W + W_UP + (size_t)l * 5632 * 1024, 8192, 5632, 1024, BIG, 5632, shm); break;
        case 9: convgate_phase(p, l); break;
        default: gemm_resid_phase(p, AB, 2816, W + W_DOWN + (size_t)l * 1024 * 2816, l, 5120, false, true, shm);
          if (REPMASK & 8192) gemm_resid_phase(p, AB, 2816, W + W_DOWN + (size_t)l * 1024 * 2816, l, 5120, false, true, shm, true);
          break;
      }
    }
    if (ph < 45) {
      xcd_barrier((unsigned*)(p.ws + OFF_BAR), xbw);
      if (REPMASK & 1) xcd_barrier((unsigned*)(p.ws + OFF_BAR), xbw);
    }
  }
}

extern "C" void kernel_launch(void* const* d_in, const int* in_sizes, int n_in, void* d_out, int out_size, void* d_ws, size_t ws_size, hipStream_t stream) {
  static int grid_blocks = 0;
  if (!grid_blocks) {
    int dev = 0, cus = 0, per_cu = 0;
    (void)hipGetDevice(&dev);
    (void)hipDeviceGetAttribute(&cus, hipDeviceAttributeMultiprocessorCount, dev);
    (void)hipFuncSetAttribute((const void*)mega, hipFuncAttributeMaxDynamicSharedMemorySize, LDS_BYTES);
    (void)hipOccupancyMaxActiveBlocksPerMultiprocessor(&per_cu, mega, 512, LDS_BYTES);
    (void)hipGetLastError();
    grid_blocks = cus;
    if (per_cu < 1) grid_blocks = cus;
  }
  Params p{};
  for (int i = 0; i < 46; ++i) p.in[i] = (const float*)d_in[i];
  p.out = (float*)d_out;
  p.ws = (char*)d_ws;
  (void)hipMemsetAsync((char*)d_ws + OFF_BAR, 0, XCD_BAR_WORDS * 4, stream);
  void* args[] = {&p};
  (void)hipLaunchCooperativeKernel((void*)mega, dim3(grid_blocks), dim3(512), args, LDS_BYTES, stream);
}
```
